# Optimizing an MI355X kernel written in HIP

```python
import math
import jax, jax.numpy as jnp
from jax import lax
import numpy as np

D_MODEL = 1024
BATCH = 8
SEQ = 2048
DEPTH = 1

CHUNK = 64
Q_BLOCK = 128
NORM_EPS = 1e-5
POOL_WIDTH = D_MODEL // 2
POOL_WINDOWS = (2, 4, 8, 16)
POOL_GROUPS = len(POOL_WINDOWS)
POOL_GROUP_DIM = POOL_WIDTH // POOL_GROUPS
DIFF_HEADS = 4
DIFF_HEAD_DIM = 64
DIFF_V_DIM = 2 * DIFF_HEAD_DIM
DIFF_WIDTH = DIFF_HEADS * DIFF_V_DIM
QK_WIDTH = DIFF_HEADS * 2 * DIFF_HEAD_DIM
MIX_WIDTH = POOL_WIDTH + DIFF_WIDTH
IN_WIDTH = POOL_WIDTH + 2 * QK_WIDTH + DIFF_WIDTH
ROT_DIM = DIFF_HEAD_DIM // 4
ROPE_THETA = 500000.0
MEM_LEN = 256
X_HEADS = 4
X_HEAD_DIM = D_MODEL // X_HEADS
N_EXPERTS = 32
TOP_K = 4
D_EXPERT = D_MODEL
SWIGLU_ALPHA = 1.702
SWIGLU_LIMIT = 7.0
EXPERT_BLOCK = 128

kernel_name = 'hybrid_pool_diffattn_moe_block'


def rms_norm(x, g):
    xf = x.astype(jnp.float32)
    y = xf * lax.rsqrt(jnp.mean(xf * xf, axis=-1, keepdims=True) + NORM_EPS)
    return (y * g.astype(jnp.float32)).astype(x.dtype)


def multiscale_pool(u, w_pool, pool_scale):
    B, S, _ = u.shape
    uf = u.astype(jnp.float32).reshape(B, S, POOL_GROUPS, POOL_GROUP_DIM)
    csum = jnp.pad(jnp.cumsum(uf, axis=1), ((0, 0), (1, 0), (0, 0), (0, 0)))
    t = jnp.arange(S)[:, None]
    win = jnp.array(POOL_WINDOWS, dtype=jnp.int32)[None, :]
    lo = jnp.maximum(t + 1 - win, 0)
    gidx = jnp.arange(POOL_GROUPS)[None, :]
    window_sum = csum[:, 1:] - csum[:, lo, gidx]
    count = (t + 1 - lo).astype(jnp.float32)
    mixed = (window_sum / count[None, :, :, None] - uf).astype(u.dtype)
    y = jnp.einsum('bsgc,gcd->bsgd', mixed, w_pool)
    y = y * pool_scale.reshape(POOL_GROUPS, POOL_GROUP_DIM)
    return y.reshape(B, S, POOL_WIDTH)


def rotary_tables(positions):
    inv_freq = ROPE_THETA ** (-jnp.arange(0, ROT_DIM, 2, dtype=jnp.float32) / ROT_DIM)
    ang = positions.astype(jnp.float32)[..., None] * inv_freq
    return jnp.cos(ang)[:, :, None, None, :], jnp.sin(ang)[:, :, None, None, :]


def partial_rotary(x, cos, sin):
    half = ROT_DIM // 2
    xr = x[..., :ROT_DIM].astype(jnp.float32)
    x1, x2 = xr[..., :half], xr[..., half:]
    rot = jnp.concatenate([x1 * cos - x2 * sin, x2 * cos + x1 * sin], axis=-1)
    return jnp.concatenate([rot.astype(x.dtype), x[..., ROT_DIM:]], axis=-1)


def diff_attention(q, k, v, lam):
    S = q.shape[3]
    scale = DIFF_HEAD_DIM ** -0.5
    outs = []
    for qb in range(S // Q_BLOCK):
        q0 = qb * Q_BLOCK
        kend = q0 + Q_BLOCK
        s = jnp.einsum('bhmqd,bhmkd->bhmqk', q[:, :, :, q0:kend], k[:, :, :, :kend],
                       preferred_element_type=jnp.float32) * scale
        q_chunk = (q0 + jnp.arange(Q_BLOCK)) // CHUNK
        k_chunk = jnp.arange(kend) // CHUNK
        mask = k_chunk[None, :] <= q_chunk[:, None]
        p = jax.nn.softmax(jnp.where(mask, s, -jnp.inf), axis=-1)
        a = p[:, :, 0] - lam * p[:, :, 1]
        outs.append(jnp.einsum('bhqk,bhkv->bhqv', a.astype(v.dtype), v[:, :, :kend]))
    return jnp.concatenate(outs, axis=2)


def cross_attention(h, mem_n, w_cq, w_ckv, w_co):
    B, S, _ = h.shape
    M = mem_n.shape[1]
    q = (h @ w_cq).reshape(B, S, X_HEADS, X_HEAD_DIM)
    kv = (mem_n @ w_ckv).reshape(B, M, 2, X_HEADS, X_HEAD_DIM)
    k, v = kv[:, :, 0], kv[:, :, 1]
    s = jnp.einsum('bshd,bmhd->bhsm', q, k, preferred_element_type=jnp.float32) * (X_HEAD_DIM ** -0.5)
    p = jax.nn.softmax(s, axis=-1)
    o = jnp.einsum('bhsm,bmhd->bshd', p.astype(v.dtype), v).reshape(B, S, D_MODEL)
    return o @ w_co


def clamped_swiglu(gu):
    gate, up = gu[..., :D_EXPERT], gu[..., D_EXPERT:]
    gate = jnp.minimum(gate, SWIGLU_LIMIT)
    up = jnp.clip(up, -SWIGLU_LIMIT, SWIGLU_LIMIT)
    return (up + 1.0) * gate * jax.nn.sigmoid(SWIGLU_ALPHA * gate)


def moe_ffn(h, w_router, b_router, w_gu, b_gu, w_down, b_down):
    B, S, D = h.shape
    T = B * S
    xt = h.reshape(T, D)
    logits = (xt @ w_router + b_router).astype(jnp.float32)
    top_val, top_idx = lax.top_k(logits, TOP_K)
    gates = jax.nn.softmax(top_val, axis=-1)
    flat_e = top_idx.reshape(-1)
    flat_tok = jnp.repeat(jnp.arange(T, dtype=jnp.int32), TOP_K)
    flat_g = gates.reshape(-1)
    order = jnp.argsort(flat_e)
    se = flat_e[order]
    counts = jnp.bincount(flat_e, length=N_EXPERTS)
    start = jnp.cumsum(counts) - counts
    pcounts = (counts + EXPERT_BLOCK - 1) // EXPERT_BLOCK * EXPERT_BLOCK
    pend = jnp.cumsum(pcounts)
    pstart = pend - pcounts
    dest = pstart[se] + jnp.arange(T * TOP_K) - start[se]
    n_rows = T * TOP_K + N_EXPERTS * EXPERT_BLOCK
    n_blocks = n_rows // EXPERT_BLOCK
    row_tok = jnp.zeros((n_rows,), jnp.int32).at[dest].set(flat_tok[order])
    row_gate = jnp.zeros((n_rows,), jnp.float32).at[dest].set(flat_g[order])
    block_e = jnp.minimum(jnp.searchsorted(pend, jnp.arange(n_blocks) * EXPERT_BLOCK, side='right'),
                          N_EXPERTS - 1)

    def expert_block(args):
        tok, g, e = args
        xb = xt[tok]
        hb = clamped_swiglu(xb @ w_gu[e] + b_gu[e])
        yb = hb @ w_down[e] + b_down[e]
        return yb * g[:, None].astype(yb.dtype)

    y_rows = lax.map(expert_block, (row_tok.reshape(n_blocks, EXPERT_BLOCK),
                                    row_gate.reshape(n_blocks, EXPERT_BLOCK), block_e))
    y = jnp.zeros((T, D), h.dtype).at[row_tok].add(y_rows.reshape(n_rows, D).astype(h.dtype))
    return y.reshape(B, S, D)


def setup_inputs(seed: int = 0) -> dict:
    key = jax.random.key(seed)
    ks = jax.random.split(key, 32)
    f32 = jnp.float32
    L = DEPTH

    def nrm(k, shape, scale):
        return jax.random.normal(k, shape, f32) * scale

    def gain(k, shape):
        return 1.0 + 0.02 * jax.random.normal(k, shape, f32)

    offsets = jax.random.randint(ks[1], (BATCH, 1), 0, 4096, dtype=jnp.int32)
    return {
        'x': nrm(ks[0], (BATCH, SEQ, D_MODEL), 1.0),
        'positions': offsets + jnp.arange(SEQ, dtype=jnp.int32)[None, :],
        'mem': nrm(ks[2], (BATCH, MEM_LEN, D_MODEL), 1.0),
        'attn_norm_g': gain(ks[3], (L, D_MODEL)),
        'w_in': nrm(ks[4], (L, D_MODEL, IN_WIDTH), D_MODEL ** -0.5),
        'w_pool': nrm(ks[5], (L, POOL_GROUPS, POOL_GROUP_DIM, POOL_GROUP_DIM), POOL_GROUP_DIM ** -0.5),
        'pool_scale': gain(ks[6], (L, POOL_WIDTH)),
        'lambda_q1': nrm(ks[7], (L, DIFF_HEAD_DIM), 0.1),
        'lambda_k1': nrm(ks[8], (L, DIFF_HEAD_DIM), 0.1),
        'lambda_q2': nrm(ks[9], (L, DIFF_HEAD_DIM), 0.1),
        'lambda_k2': nrm(ks[10], (L, DIFF_HEAD_DIM), 0.1),
        'subln_g': gain(ks[11], (L, DIFF_V_DIM)),
        'w_out': nrm(ks[12], (L, MIX_WIDTH, D_MODEL), MIX_WIDTH ** -0.5),
        'xattn_norm_g': gain(ks[13], (L, D_MODEL)),
        'mem_norm_g': gain(ks[14], (L, D_MODEL)),
        'w_cq': nrm(ks[15], (L, D_MODEL, D_MODEL), D_MODEL ** -0.5),
        'w_ckv': nrm(ks[16], (L, D_MODEL, 2 * D_MODEL), D_MODEL ** -0.5),
        'w_co': nrm(ks[17], (L, D_MODEL, D_MODEL), D_MODEL ** -0.5),
        'ffn_norm_g': gain(ks[18], (L, D_MODEL)),
        'w_router': nrm(ks[19], (L, D_MODEL, N_EXPERTS), D_MODEL ** -0.5),
        'b_router': nrm(ks[20], (L, N_EXPERTS), 0.01),
        'w_gu': nrm(ks[21], (L, N_EXPERTS, D_MODEL, 2 * D_EXPERT), D_MODEL ** -0.5),
        'b_gu': nrm(ks[22], (L, N_EXPERTS, 2 * D_EXPERT), 0.01),
        'w_down': nrm(ks[23], (L, N_EXPERTS, D_EXPERT, D_MODEL), D_EXPERT ** -0.5),
        'b_down': nrm(ks[24], (L, N_EXPERTS, D_MODEL), 0.01),
        'final_norm_g': gain(ks[25], (D_MODEL,)),
    }


def reference(x, positions, mem, attn_norm_g, w_in, w_pool, pool_scale, lambda_q1, lambda_k1,
              lambda_q2, lambda_k2, subln_g, w_out, xattn_norm_g, mem_norm_g, w_cq, w_ckv, w_co,
              ffn_norm_g, w_router, b_router, w_gu, b_gu, w_down, b_down, final_norm_g):
    B, S, _ = x.shape
    cos, sin = rotary_tables(positions)
    for l in range(DEPTH):
        h = rms_norm(x, attn_norm_g[l])
        u = h @ w_in[l]
        u_pool, u_q, u_k, u_v = jnp.split(
            u, [POOL_WIDTH, POOL_WIDTH + QK_WIDTH, POOL_WIDTH + 2 * QK_WIDTH], axis=-1)
        y_pool = multiscale_pool(u_pool, w_pool[l], pool_scale[l])

        q = partial_rotary(u_q.reshape(B, S, DIFF_HEADS, 2, DIFF_HEAD_DIM), cos, sin)
        k = partial_rotary(u_k.reshape(B, S, DIFF_HEADS, 2, DIFF_HEAD_DIM), cos, sin)
        q = q.transpose(0, 2, 3, 1, 4)
        k = k.transpose(0, 2, 3, 1, 4)
        v = u_v.reshape(B, S, DIFF_HEADS, DIFF_V_DIM).transpose(0, 2, 1, 3)
        lam_init = 0.8 - 0.6 * math.exp(-0.3 * l)
        lam = (jnp.exp(jnp.sum(lambda_q1[l].astype(jnp.float32) * lambda_k1[l].astype(jnp.float32)))
               - jnp.exp(jnp.sum(lambda_q2[l].astype(jnp.float32) * lambda_k2[l].astype(jnp.float32)))
               + lam_init)
        o = diff_attention(q, k, v, lam)
        o = rms_norm(o, subln_g[l]) * (1.0 - lam_init)
        y_diff = o.transpose(0, 2, 1, 3).reshape(B, S, DIFF_WIDTH)
        x = x + jnp.concatenate([y_pool, y_diff], axis=-1) @ w_out[l]

        x = x + cross_attention(rms_norm(x, xattn_norm_g[l]), rms_norm(mem, mem_norm_g[l]),
                                w_cq[l], w_ckv[l], w_co[l])

        x = x + moe_ffn(rms_norm(x, ffn_norm_g[l]), w_router[l], b_router[l], w_gu[l], b_gu[l],
                        w_down[l], b_down[l])
    return rms_norm(x, final_norm_g)
```

```cpp
#include <hip/hip_runtime.h>
#include <cstdio>
#include <cstdint>

#ifndef MK_N_LAUNCHES
#define MK_N_LAUNCHES 1
#endif

#ifndef PMASK
#define PMASK 0x3ff
#endif
#define LAS __attribute__((address_space(3)))
#define GAS __attribute__((address_space(1)))

typedef unsigned short bf16_t;
typedef short bf16x8 __attribute__((ext_vector_type(8)));
typedef short s16x4 __attribute__((ext_vector_type(4)));
typedef float f32x4 __attribute__((ext_vector_type(4)));
typedef float f32x2 __attribute__((ext_vector_type(2)));
typedef float f32x16 __attribute__((ext_vector_type(16)));
typedef unsigned u32x4 __attribute__((ext_vector_type(4)));
typedef unsigned u32x2 __attribute__((ext_vector_type(2)));

constexpr int NB = 8, SEQ = 2048, T = NB * SEQ, D = 1024, INW = 2048, MEM = 256, NMEM = NB * MEM;
constexpr int NE = 32, TOPK = 4, CAP = 16384, MAXRT = 288;
constexpr float EPS = 1e-5f;
constexpr float LOG2E = 1.4426950408889634f;
constexpr float QSCALE_D = 0.125f * LOG2E;
constexpr float QSCALE_X = 0.0625f * LOG2E;

constexpr size_t MiB = 1u << 20;
constexpr size_t WS_CTL = 0, CTL_BYTES = 1 * MiB;
constexpr size_t WS_CS = 1 * MiB;
constexpr size_t WS_SSP = 2 * MiB;
constexpr size_t WS_RSTD2 = 3 * MiB;
constexpr size_t WS_TOKSLOT = 3 * MiB + 256 * 1024;
constexpr size_t WS_LTOK = 4 * MiB;
constexpr size_t WS_LGATE = 6 * MiB;
constexpr size_t WS_WIN = 8 * MiB;
constexpr size_t WS_WOUT = 12 * MiB;
constexpr size_t WS_WCQ = 14 * MiB;
constexpr size_t WS_WCKV = 16 * MiB;
constexpr size_t WS_WCO = 20 * MiB;
constexpr size_t WS_WGU = 24 * MiB;
constexpr size_t WS_WDN = 152 * MiB;
constexpr size_t WS_H0 = 216 * MiB;
constexpr size_t WS_MEMN = 248 * MiB;
constexpr size_t WS_KC = 252 * MiB;
constexpr size_t WS_VT = 256 * MiB;
constexpr size_t WS_U = 260 * MiB;
constexpr size_t WS_CAT = 324 * MiB;
constexpr size_t WS_X1 = 356 * MiB;
constexpr size_t WS_X1B = 420 * MiB;
constexpr size_t WS_QC = 452 * MiB;
constexpr size_t WS_PC = 484 * MiB;
constexpr size_t WS_OC = 516 * MiB;
constexpr size_t WS_X2 = 548 * MiB;
constexpr size_t WS_X2B = 612 * MiB;
constexpr size_t WS_HID = 644 * MiB;
constexpr size_t WS_Y = 788 * MiB;
constexpr size_t WS_END = 932 * MiB;
constexpr int CW_CNT = 64;
constexpr int CW_BAR = 4096;

constexpr int RING_BYTES = 131072;
constexpr int XTAB_OFF = RING_BYTES;
constexpr int ECNT_OFF = RING_BYTES + 1024;
constexpr int RT_OFF = RING_BYTES + 1536;
constexpr int MISC_OFF = RING_BYTES + 4096;
static_assert(RT_OFF + 2560 <= MISC_OFF, "LDS map");
constexpr int LDS_BYTES = 147456;

#define LDS_WAIT() asm volatile("s_waitcnt lgkmcnt(0)" ::: "memory")
#define VM_WAIT() asm volatile("s_waitcnt vmcnt(0)" ::: "memory")
__device__ __forceinline__ unsigned f2bf(float f) { unsigned u = __builtin_bit_cast(unsigned, f); return (u + 0x7fffu + ((u >> 16) & 1u)) >> 16; }
__device__ __forceinline__ unsigned pk2(float lo, float hi) { return f2bf(lo) | (f2bf(hi) << 16); }
__device__ __forceinline__ float bf2f(unsigned short v) { return __builtin_bit_cast(float, (unsigned)v << 16); }
__device__ __forceinline__ unsigned cvt_pk_bf16(float lo, float hi) { unsigned r; asm volatile("v_cvt_pk_bf16_f32 %0, %1, %2" : "=v"(r) : "v"(lo), "v"(hi)); return r; }
__device__ __forceinline__ float wave_sum(float v) {
#pragma unroll
    for (int o = 1; o < 64; o <<= 1) v += __shfl_xor(v, o);
    return v;
}

#define XB_TMO      128
#define XB_XCNT(j)  (256  + 64 * (j))
#define XB_XSUB(j)  (1280 + 64 * (j))
#define XB_XGEN(j)  (2304 + 64 * (j))
#define XB_TOP      3328
#define XB_TOPGEN   3392
#define XCD_BAR_WORDS 3456
#define XB_SPIN_CAP (1u << 18)
__device__ __forceinline__ unsigned xb_ld(unsigned* p)              { return __hip_atomic_load(p, __ATOMIC_RELAXED, __HIP_MEMORY_SCOPE_AGENT); }
__device__ __forceinline__ unsigned xb_add(unsigned* p, unsigned v) { return __hip_atomic_fetch_add(p, v, __ATOMIC_RELAXED, __HIP_MEMORY_SCOPE_AGENT); }
__device__ __forceinline__ unsigned xb_xcc_id() { return (unsigned)__builtin_amdgcn_s_getreg((3 << 11) | 20) & 0xFu; }
#define XB_SPIN(cond, bar) do { unsigned _sp = 0; while (cond) { __builtin_amdgcn_s_sleep(1); \
    if ((++_sp & 255u) == 0u) { if (xb_ld(&(bar)[XB_TMO])) break; if (_sp > XB_SPIN_CAP) { atomicAdd(&(bar)[XB_TMO], 1u); break; } } } } while (0)
struct XcdBarrier { unsigned* bar; unsigned x; volatile LAS unsigned* st; };
__device__ __forceinline__ XcdBarrier xcd_barrier_post(unsigned* bar, volatile LAS unsigned* st) {
    XcdBarrier b; b.bar = bar; b.x = xb_xcc_id(); b.st = st;
    if (threadIdx.x == 0) (void)xb_add(&bar[XB_XCNT(b.x)], 1u);
    return b;
}
__device__ __forceinline__ void xcd_barrier_complete(unsigned* bar, unsigned x, unsigned& nloc, unsigned& nx) {
    const unsigned G = gridDim.x * gridDim.y * gridDim.z;
    unsigned sum, cnt, mine, sp = 0u;
    for (;;) {
        sum = 0u; cnt = 0u; mine = 0u;
#pragma unroll
        for (unsigned j = 0; j < 16; ++j) { const unsigned c = xb_ld(&bar[XB_XCNT(j)]); sum += c; cnt += (c > 0u) ? 1u : 0u; mine = (j == x) ? c : mine; }
        if (sum == G) break;
        __builtin_amdgcn_s_sleep(1);
        if ((++sp & 255u) == 0u) { if (xb_ld(&bar[XB_TMO])) break; if (sp > XB_SPIN_CAP) { atomicAdd(&bar[XB_TMO], 1u); break; } }
    }
    nloc = mine > 0u ? mine : 1u; nx = cnt > 0u ? cnt : 1u;
}
__device__ __forceinline__ void xcd_barrier(const XcdBarrier& b) {
    asm volatile("s_waitcnt vmcnt(0)" ::: "memory");
    __syncthreads();
    if (threadIdx.x == 0) {
        unsigned* bar = b.bar;
        __builtin_amdgcn_s_waitcnt(0);
        unsigned nloc = b.st[0], nx = b.st[1];
        if (nloc == 0u) { xcd_barrier_complete(bar, b.x, nloc, nx); b.st[0] = nloc; b.st[1] = nx; }
        const unsigned old = xb_add(&bar[XB_XSUB(b.x)], 1u);
        const unsigned gen = old / nloc;
        if (old + 1u == (gen + 1u) * nloc) {
            __builtin_amdgcn_fence(__ATOMIC_RELEASE, "agent");
            asm volatile("s_waitcnt vmcnt(0)" ::: "memory");
            const unsigned og = xb_add(&bar[XB_TOP], 1u);
            const unsigned tg = og / nx;
            if (og + 1u == (tg + 1u) * nx) xb_add(&bar[XB_TOPGEN], 1u);
            else XB_SPIN(xb_ld(&bar[XB_TOPGEN]) == tg, bar);
            __builtin_amdgcn_fence(__ATOMIC_ACQUIRE, "agent");
            xb_add(&bar[XB_XGEN(b.x)], 1u);
            asm volatile("s_waitcnt vmcnt(0)" ::: "memory");
        } else {
            XB_SPIN(xb_ld(&bar[XB_XGEN(b.x)]) == gen, bar);
            __builtin_amdgcn_fence(__ATOMIC_ACQUIRE, "agent");
            asm volatile("s_waitcnt vmcnt(0)" ::: "memory");
        }
    }
    __syncthreads();
}
__device__ __forceinline__ void wg_global_sync() {
    asm volatile("s_waitcnt vmcnt(0)" ::: "memory");
    __syncthreads();
    if (threadIdx.x == 0) { __builtin_amdgcn_fence(__ATOMIC_ACQUIRE, "agent"); asm volatile("s_waitcnt vmcnt(0)" ::: "memory"); }
    __syncthreads();
}

namespace pg8 {
constexpr int BM = 256, BK = 64, HALF = 128, HTB = HALF * BK * 2, STAGE_BYTES = 8 * HTB, NXCD = 8, WGM = 8;
__host__ __device__ __forceinline__ int lds_byte(int r, int c) { const int st = (r >> 4) * 2 + (c >> 5), rr = r & 15, cc = c & 31, ob = rr * 64 + cc * 2; return st * 1024 + (ob ^ (((ob >> 9) & 1) << 5)); }
__host__ __device__ __forceinline__ void stage_rc(int b, int& R, int& C) { const int st = b / 1024, sb = b % 1024, swz = sb ^ (((sb >> 9) & 1) << 5); R = (st >> 1) * 16 + swz / 64; C = (st & 1) * 32 + (swz % 64) / 2; }
__host__ __device__ __forceinline__ int perm32(int rho) { const int n = rho >> 4, i = rho & 15; return 8 * (i >> 2) + 4 * n + (i & 3); }

struct Unit { int pm, pn, e, nvalid; const char* pa; const char* pb; };

struct StaticOrder {
    int nM, nN, nwg, G, c; const char* A; const char* Bt; size_t atile, btile;
    __device__ void init(const void* A_, const void* Bt_, int M, int N, int lda, int ldb, int G_, int c_) { nM = M / BM; nN = N / BM; nwg = nM * nN; G = G_; c = c_; A = (const char*)A_; Bt = (const char*)Bt_; atile = (size_t)BM * lda * 2; btile = (size_t)BM * ldb * 2; }
    __device__ bool next(int i, Unit& u) const {
        const long L = (long)i * G + c; if (L >= nwg) return false;
        int wgid = (int)L; { const int q = nwg / NXCD, r = nwg % NXCD, xcd = wgid % NXCD, off = wgid / NXCD; wgid = (xcd < r ? xcd * (q + 1) : r * (q + 1) + (xcd - r) * q) + off; }
        const int nig = WGM * nN, gid = wgid / nig, fm = gid * WGM, gsz = (nM - fm) < WGM ? (nM - fm) : WGM;
        u.pm = fm + ((wgid % nig) % gsz); u.pn = (wgid % nig) / gsz; u.e = 0; u.nvalid = 256;
        u.pa = A + (size_t)u.pm * atile; u.pb = Bt + (size_t)u.pn * btile; return true;
    }
    __device__ __forceinline__ unsigned row_off(const Unit&, int) const { return 0u; }
};
struct SingleUnit {
    Unit u;
    __device__ bool next(int i, Unit& o) const { if (i != 0) return false; o = u; return true; }
    __device__ __forceinline__ unsigned row_off(const Unit&, int) const { return 0u; }
};
struct GatherUnit {
    Unit u; const int* toks; unsigned rowbytes;
    __device__ bool next(int i, Unit& o) const { if (i != 0) return false; o = u; return true; }
    __device__ __forceinline__ unsigned row_off(const Unit& uu, int r) const { const int t = (r < uu.nvalid) ? toks[r] : 0; return (unsigned)t * rowbytes; }
};

template <class Epi, class Sched, bool ALIGN_EPI, bool GATHER>
__device__ __forceinline__ void gemm_phase(LAS unsigned char* lds, const int K, const int lda, const int ldb, const Sched& S, const Epi& E) {
    int tid_ = threadIdx.x; asm volatile("" : "+v"(tid_));
    const int tid = tid_, wid = __builtin_amdgcn_readfirstlane(tid >> 6), lane = tid & 63, wr = wid >> 2, wc = wid & 3, fr = lane & 15, fq = lane >> 4;
    const int nt = K / BK;
    Unit cur, nxt; int ui = 0;
    if (!S.next(0, cur)) return;
    unsigned voffA[GATHER ? 2 : 1][2], voffB[2];
#pragma unroll
    for (int i = 0; i < 2; ++i) { int R, C; stage_rc(tid * 16 + i * 8192, R, C); const int Rb = Epi::PERM ? ((R & ~31) + perm32(R & 31)) : R;
        if constexpr (GATHER) { voffA[0][i] = S.row_off(cur, R) + (unsigned)C * 2u; voffA[1][i] = S.row_off(cur, R + HALF) + (unsigned)C * 2u; }
        else { voffA[0][i] = (unsigned)(R * lda + C) * 2u; }
        voffB[i] = (unsigned)(Rb * ldb + C) * 2u; }
    const size_t kstep = (size_t)(BK * 2);
    const size_t hstepA = GATHER ? (size_t)0 : (size_t)HALF * lda * 2, hstepB = (size_t)HALF * ldb * 2;
    const unsigned ldsw = (unsigned)wid * 1024u;
    const int aoff = lds_byte(wr * 64 + fr, fq * 8), boff = lds_byte(wc * 32 + fr, fq * 8);
#define PG8_SA(b, h) (((b) * 2 + (h)) * HTB)
#define PG8_SB(b, h) ((4 + (b) * 2 + (h)) * HTB)
#define PG8_STAGE(bufoff, gbase, voff) do { _Pragma("unroll") for (int _i = 0; _i < 2; ++_i) \
        __builtin_amdgcn_global_load_lds((const unsigned*)((const char*)(gbase) + (voff)[_i]), (LAS unsigned*)(lds + (bufoff) + ldsw + _i * 8192), 16, 0, 0); } while (0)
#define PG8_STAGEA(bufoff, gbase, h) PG8_STAGE(bufoff, (gbase) + (h) * hstepA, voffA[GATHER ? (h) : 0])
#define PG8_STAGEB(bufoff, gbase, h) PG8_STAGE(bufoff, (gbase) + (h) * hstepB, voffB)
#define PG8_LDA(dst, b, h) do { _Pragma("unroll") for (int m = 0; m < 4; ++m) _Pragma("unroll") for (int k = 0; k < 2; ++k) dst[m][k] = *(const LAS bf16x8*)(lds + PG8_SA(b, h) + aoff + m * 2048 + k * 1024); } while (0)
#define PG8_LDB(dst, b, h) do { _Pragma("unroll") for (int n = 0; n < 2; ++n) _Pragma("unroll") for (int k = 0; k < 2; ++k) dst[n][k] = *(const LAS bf16x8*)(lds + PG8_SB(b, h) + boff + n * 2048 + k * 1024); } while (0)
#define PG8_MMA(ai, bj, At, Bt) do { __builtin_amdgcn_s_setprio(1); _Pragma("unroll") for (int m = 0; m < 4; ++m) _Pragma("unroll") for (int n = 0; n < 2; ++n) _Pragma("unroll") for (int k = 0; k < 2; ++k) \
        acc[ai][bj][m][n] = __builtin_amdgcn_mfma_f32_16x16x32_bf16(Bt[n][k], At[m][k], acc[ai][bj][m][n], 0, 0, 0); __builtin_amdgcn_s_setprio(0); } while (0)
#define PG8_WAIT_V(n) asm volatile("s_waitcnt vmcnt(" #n ")" ::: "memory")
#define PG8_WAIT_L(n) asm volatile("s_waitcnt lgkmcnt(" #n ")" ::: "memory")
#define PG8_BAR __builtin_amdgcn_s_barrier()
#define PG8_SCHED __builtin_amdgcn_sched_barrier(0)
    f32x4 acc[2][2][4][2];
#pragma unroll
    for (int a = 0; a < 2; ++a)
#pragma unroll
        for (int b = 0; b < 2; ++b)
#pragma unroll
            for (int m = 0; m < 4; ++m)
#pragma unroll
                for (int n = 0; n < 2; ++n) acc[a][b][m][n] = (f32x4){0.f, 0.f, 0.f, 0.f};
    bf16x8 At[4][2], B0[2][2], B1[2][2];
    const char* cA = cur.pa; const char* cB = cur.pb;
    PG8_STAGEB(PG8_SB(0, 0), cB, 0); PG8_STAGEB(PG8_SB(0, 1), cB, 1); PG8_STAGEA(PG8_SA(0, 0), cA, 0); PG8_STAGEA(PG8_SA(0, 1), cA, 1);
    if (wr == 1) PG8_BAR;
    PG8_WAIT_V(2); PG8_BAR;
    PG8_STAGEB(PG8_SB(1, 0), cB + kstep, 0); PG8_STAGEA(PG8_SA(1, 0), cA + kstep, 0); PG8_STAGEB(PG8_SB(1, 1), cB + kstep, 1);
    PG8_WAIT_V(6); PG8_BAR;
    for (;;) {
        const bool has_next = GATHER ? false : S.next(ui + 1, nxt);
        const char* nA = has_next ? nxt.pa : cA; const char* nB = has_next ? nxt.pb : cB;
        for (int t = 0; t < nt; t += 2) {
            const bool last = (t == nt - 2);
            const char* a1 = cA + (size_t)(t + 1) * kstep;
            const char* a2 = last ? nA : cA + (size_t)(t + 2) * kstep; const char* b2 = last ? nB : cB + (size_t)(t + 2) * kstep;
            const char* a3 = a2 + kstep; const char* b3 = b2 + kstep;
            PG8_LDB(B0, 0, 0); PG8_LDB(B1, 0, 1); PG8_SCHED; PG8_LDA(At, 0, 0); PG8_STAGEA(PG8_SA(1, 1), a1, 1);
            PG8_WAIT_V(8); PG8_WAIT_L(0); PG8_BAR; PG8_MMA(0, 0, At, B0); PG8_MMA(0, 1, At, B1); PG8_BAR; PG8_SCHED;
            PG8_LDA(At, 0, 1); PG8_STAGEB(PG8_SB(0, 0), b2, 0); PG8_STAGEB(PG8_SB(0, 1), b2, 1); PG8_STAGEA(PG8_SA(0, 0), a2, 0);
            PG8_WAIT_V(8); PG8_WAIT_L(0); PG8_BAR; PG8_MMA(1, 0, At, B0); PG8_MMA(1, 1, At, B1); PG8_BAR; PG8_SCHED;
            PG8_LDB(B0, 1, 0); PG8_LDB(B1, 1, 1); PG8_SCHED; PG8_LDA(At, 1, 0); PG8_STAGEA(PG8_SA(0, 1), a2, 1);
            PG8_WAIT_V(8); PG8_WAIT_L(0); PG8_BAR; PG8_MMA(0, 0, At, B0); PG8_MMA(0, 1, At, B1); PG8_BAR; PG8_SCHED;
            PG8_LDA(At, 1, 1); PG8_STAGEB(PG8_SB(1, 0), b3, 0); PG8_STAGEB(PG8_SB(1, 1), b3, 1); PG8_STAGEA(PG8_SA(1, 0), a3, 0);
            PG8_WAIT_V(8); PG8_WAIT_L(0); PG8_BAR; PG8_MMA(1, 0, At, B0); PG8_MMA(1, 1, At, B1); PG8_BAR; PG8_SCHED;
        }
        if constexpr (ALIGN_EPI) { if (wr == 0) PG8_BAR; }
        if constexpr (!Epi::AFTER_DRAIN) { E(acc, cur, wr, wc, fr, fq); }
        if (!has_next) break;
#pragma unroll
        for (int a = 0; a < 2; ++a)
#pragma unroll
            for (int b = 0; b < 2; ++b)
#pragma unroll
                for (int m = 0; m < 4; ++m)
#pragma unroll
                    for (int n = 0; n < 2; ++n) acc[a][b][m][n] = (f32x4){0.f, 0.f, 0.f, 0.f};
        cur = nxt; cA = nA; cB = nB; ++ui;
        if constexpr (ALIGN_EPI) { if (wr == 1) PG8_BAR; }
    }
    PG8_WAIT_V(0);
    if constexpr (!ALIGN_EPI) { if (wr == 0) PG8_BAR; }
    PG8_BAR;
    if constexpr (Epi::AFTER_DRAIN) { E.fused(acc, cur, wr, wc, fr, fq, lds, wid, lane); }
#undef PG8_SA
#undef PG8_SB
#undef PG8_STAGE
#undef PG8_STAGEA
#undef PG8_STAGEB
#undef PG8_LDA
#undef PG8_LDB
#undef PG8_MMA
#undef PG8_WAIT_V
#undef PG8_WAIT_L
#undef PG8_BAR
#undef PG8_SCHED
}

typedef const f32x4 (&AccC)[2][2][4][2];
typedef f32x4 (&AccM)[2][2][4][2];

struct EpiInProj {
    static constexpr bool PERM = true, AFTER_DRAIN = false;
    bf16_t* U; const float* cs;
    __device__ __forceinline__ void operator()(AccC acc, const Unit& u, int wr, int wc, int fr, int fq) const {
        const int row0 = u.pm * BM + wr * 64 + fr, col0 = u.pn * BM + wc * 32 + 8 * fq;
        const bool rot = (u.pn >= 2) && (u.pn < 6) && ((wc & 1) == 0) && (fq < 2);
        const float sc = (u.pn == 2 || u.pn == 3) ? QSCALE_D : 1.f;
#pragma unroll
        for (int ai = 0; ai < 2; ++ai)
#pragma unroll
            for (int m = 0; m < 4; ++m) {
                const int row = row0 + ai * HALF + m * 16;
                f32x4 c0 = (f32x4){1.f, 0.f, 1.f, 0.f}, c1 = (f32x4){1.f, 0.f, 1.f, 0.f};
                if (rot) { const f32x4* cp = (const f32x4*)(cs + (size_t)row * 16 + 8 * fq); c0 = cp[0]; c1 = cp[1]; }
                bf16_t* rowp = U + (size_t)row * INW + col0;
#pragma unroll
                for (int bj = 0; bj < 2; ++bj) {
                    f32x4 v0 = acc[ai][bj][m][0], v1 = acc[ai][bj][m][1];
                    f32x4 w0, w1;
                    w0[0] = v0[0] * c0[0] - v0[1] * c0[1]; w0[1] = v0[1] * c0[0] + v0[0] * c0[1];
                    w0[2] = v0[2] * c0[2] - v0[3] * c0[3]; w0[3] = v0[3] * c0[2] + v0[2] * c0[3];
                    w1[0] = v1[0] * c1[0] - v1[1] * c1[1]; w1[1] = v1[1] * c1[0] + v1[0] * c1[1];
                    w1[2] = v1[2] * c1[2] - v1[3] * c1[3]; w1[3] = v1[3] * c1[2] + v1[2] * c1[3];
                    w0 = w0 * sc; w1 = w1 * sc;
                    u32x4 w; w.x = cvt_pk_bf16(w0[0], w0[1]); w.y = cvt_pk_bf16(w0[2], w0[3]); w.z = cvt_pk_bf16(w1[0], w1[1]); w.w = cvt_pk_bf16(w1[2], w1[3]);
                    *(u32x4*)(rowp + bj * HALF) = w; }
            }
    }
};
struct EpiBf16 {
    static constexpr bool PERM = true, AFTER_DRAIN = false;
    bf16_t* O; int ldc; const LAS float* rs; float mul;
    __device__ __forceinline__ void operator()(AccC acc, const Unit& u, int wr, int wc, int fr, int fq) const {
        const int rt0 = wr * 64 + fr, col0 = u.pn * BM + wc * 32 + 8 * fq;
#pragma unroll
        for (int ai = 0; ai < 2; ++ai)
#pragma unroll
            for (int m = 0; m < 4; ++m) {
                const int rt = rt0 + ai * HALF + m * 16;
                const float s = rs ? rs[rt] * mul : mul;
                bf16_t* rowp = O + (size_t)(u.pm * BM + rt) * ldc + col0;
#pragma unroll
                for (int bj = 0; bj < 2; ++bj) { const f32x4 v0 = acc[ai][bj][m][0] * s, v1 = acc[ai][bj][m][1] * s;
                    u32x4 w; w.x = cvt_pk_bf16(v0[0], v0[1]); w.y = cvt_pk_bf16(v0[2], v0[3]); w.z = cvt_pk_bf16(v1[0], v1[1]); w.w = cvt_pk_bf16(v1[2], v1[3]);
                    *(u32x4*)(rowp + bj * HALF) = w; }
            }
    }
};
struct EpiRes {
    static constexpr bool PERM = false, AFTER_DRAIN = false;
    const float* resid; float* xo; bf16_t* xb; float* ssp;
    __device__ __forceinline__ void operator()(AccC acc, const Unit& u, int wr, int wc, int fr, int fq) const {
        const int row0 = u.pm * BM + wr * 64 + fr, col0 = u.pn * BM + wc * 32 + 4 * fq;
#pragma unroll
        for (int ai = 0; ai < 2; ++ai)
#pragma unroll
            for (int m = 0; m < 4; ++m) {
                const int row = row0 + ai * HALF + m * 16; const size_t off = (size_t)row * D + col0; float ss = 0.f;
#pragma unroll
                for (int bj = 0; bj < 2; ++bj)
#pragma unroll
                    for (int n = 0; n < 2; ++n) { const size_t o2 = off + bj * HALF + n * 16; const f32x4 v = *(const f32x4*)(resid + o2) + acc[ai][bj][m][n];
                        *(f32x4*)(xo + o2) = v; ss += (v[0] * v[0] + v[1] * v[1]) + (v[2] * v[2] + v[3] * v[3]);
                        u32x2 w; w.x = cvt_pk_bf16(v[0], v[1]); w.y = cvt_pk_bf16(v[2], v[3]); *(u32x2*)(xb + o2) = w; }
                if (ssp) { ss += __shfl_xor(ss, 16); ss += __shfl_xor(ss, 32); if (fq == 0) ssp[(size_t)(u.pn * 4 + wc) * T + row] = ss; }
            }
    }
};
struct EpiSoftmax {
    static constexpr bool PERM = true, AFTER_DRAIN = true;
    bf16_t* O; int ldc;
    __device__ __forceinline__ void fused(AccM acc, const Unit& u, int wr, int wc, int fr, int fq, LAS unsigned char* lds, int wid, int lane) const {
        LAS float* PM = (LAS float*)lds; LAS float* PS = (LAS float*)(lds + 4096);
#pragma unroll
        for (int ai = 0; ai < 2; ++ai)
#pragma unroll
            for (int m = 0; m < 4; ++m) { float v = -INFINITY;
#pragma unroll
                for (int bj = 0; bj < 2; ++bj)
#pragma unroll
                    for (int n = 0; n < 2; ++n) { const f32x4 x = acc[ai][bj][m][n]; v = fmaxf(v, fmaxf(fmaxf(x[0], x[1]), fmaxf(x[2], x[3]))); }
                v = fmaxf(v, __shfl_xor(v, 16)); v = fmaxf(v, __shfl_xor(v, 32));
                if (fq == 0) PM[(ai * HALF + wr * 64 + m * 16 + fr) * 4 + wc] = v; }
        LDS_WAIT(); __builtin_amdgcn_s_barrier(); asm volatile("" ::: "memory");
#pragma unroll
        for (int ai = 0; ai < 2; ++ai)
#pragma unroll
            for (int m = 0; m < 4; ++m) { const int rt = ai * HALF + wr * 64 + m * 16 + fr; const f32x4 q = *(const LAS f32x4*)(PM + rt * 4);
                const float mx = fmaxf(fmaxf(q[0], q[1]), fmaxf(q[2], q[3])); float s = 0.f;
#pragma unroll
                for (int bj = 0; bj < 2; ++bj)
#pragma unroll
                    for (int n = 0; n < 2; ++n) { f32x4 x = acc[ai][bj][m][n];
                        x[0] = __builtin_amdgcn_exp2f(x[0] - mx); x[1] = __builtin_amdgcn_exp2f(x[1] - mx); x[2] = __builtin_amdgcn_exp2f(x[2] - mx); x[3] = __builtin_amdgcn_exp2f(x[3] - mx);
                        s += (x[0] + x[1]) + (x[2] + x[3]); acc[ai][bj][m][n] = x; }
                s += __shfl_xor(s, 16); s += __shfl_xor(s, 32);
                if (fq == 0) PS[rt * 4 + wc] = s; }
        LDS_WAIT(); __builtin_amdgcn_s_barrier(); asm volatile("" ::: "memory");
        const int col0 = u.pn * BM + wc * 32 + 8 * fq;
#pragma unroll
        for (int ai = 0; ai < 2; ++ai)
#pragma unroll
            for (int m = 0; m < 4; ++m) { const int rt = ai * HALF + wr * 64 + m * 16 + fr; const f32x4 q = *(const LAS f32x4*)(PS + rt * 4);
                const float inv = 1.0f / ((q[0] + q[1]) + (q[2] + q[3]));
                bf16_t* rowp = O + (size_t)(u.pm * BM + rt) * ldc + col0;
#pragma unroll
                for (int bj = 0; bj < 2; ++bj) { const f32x4 v0 = acc[ai][bj][m][0] * inv, v1 = acc[ai][bj][m][1] * inv;
                    u32x4 w; w.x = cvt_pk_bf16(v0[0], v0[1]); w.y = cvt_pk_bf16(v0[2], v0[3]); w.z = cvt_pk_bf16(v1[0], v1[1]); w.w = cvt_pk_bf16(v1[2], v1[3]);
                    *(u32x4*)(rowp + bj * HALF) = w; }
            }
        LDS_WAIT(); __builtin_amdgcn_s_barrier(); asm volatile("" ::: "memory");
    }
};
struct EpiSwiGLU {
    static constexpr bool PERM = true, AFTER_DRAIN = false;
    bf16_t* H; const float* bgu; const float* rstd; const int* toks; int hrow0;
    __device__ __forceinline__ void operator()(AccC acc, const Unit& u, int wr, int wc, int fr, int fq) const {
        const int rt0 = wr * 64 + fr, c0 = u.pn * HALF + wc * 32 + 8 * fq;
        f32x4 bg[2], bu[2];
#pragma unroll
        for (int n = 0; n < 2; ++n) { bg[n] = *(const f32x4*)(bgu + c0 + 4 * n); bu[n] = *(const f32x4*)(bgu + 1024 + c0 + 4 * n); }
#pragma unroll
        for (int ai = 0; ai < 2; ++ai)
#pragma unroll
            for (int m = 0; m < 4; ++m) {
                const int rt = rt0 + ai * HALF + m * 16;
                const int tok = (rt < u.nvalid) ? toks[rt] : 0; const float rs = rstd[tok];
                unsigned w[4];
#pragma unroll
                for (int n = 0; n < 2; ++n) { const f32x4 g4 = acc[ai][0][m][n] * rs + bg[n], u4 = acc[ai][1][m][n] * rs + bu[n]; float h[4];
#pragma unroll
                    for (int j = 0; j < 4; ++j) { const float g = fminf(g4[j], 7.0f), up = fminf(fmaxf(u4[j], -7.0f), 7.0f);
                        const float sg = __builtin_amdgcn_rcpf(1.0f + __builtin_amdgcn_exp2f(-1.702f * LOG2E * g)); h[j] = (up + 1.0f) * g * sg; }
                    w[2 * n] = cvt_pk_bf16(h[0], h[1]); w[2 * n + 1] = cvt_pk_bf16(h[2], h[3]); }
                *(u32x4*)(H + (size_t)(hrow0 + rt) * 1024 + c0) = (u32x4){w[0], w[1], w[2], w[3]};
            }
    }
};
struct EpiDown {
    static constexpr bool PERM = true, AFTER_DRAIN = false;
    bf16_t* Y; const float* bd; const float* gates; int hrow0;
    __device__ __forceinline__ void operator()(AccC acc, const Unit& u, int wr, int wc, int fr, int fq) const {
        const int rt0 = wr * 64 + fr, col0 = u.pn * BM + wc * 32 + 8 * fq;
        f32x4 bv[2][2];
#pragma unroll
        for (int bj = 0; bj < 2; ++bj)
#pragma unroll
            for (int n = 0; n < 2; ++n) bv[bj][n] = *(const f32x4*)(bd + col0 + bj * HALF + 4 * n);
#pragma unroll
        for (int ai = 0; ai < 2; ++ai)
#pragma unroll
            for (int m = 0; m < 4; ++m) {
                const int rt = rt0 + ai * HALF + m * 16;
                const float g = (rt < u.nvalid) ? gates[rt] : 0.f;
                bf16_t* rowp = Y + (size_t)(hrow0 + rt) * 1024 + col0;
#pragma unroll
                for (int bj = 0; bj < 2; ++bj) { const f32x4 v0 = (acc[ai][bj][m][0] + bv[bj][0]) * g, v1 = (acc[ai][bj][m][1] + bv[bj][1]) * g;
                    u32x4 w; w.x = cvt_pk_bf16(v0[0], v0[1]); w.y = cvt_pk_bf16(v0[2], v0[3]); w.z = cvt_pk_bf16(v1[0], v1[1]); w.w = cvt_pk_bf16(v1[2], v1[3]);
                    *(u32x4*)(rowp + bj * HALF) = w; }
            }
    }
};
}

struct Args {
    const float* x; const int* pos; const float* mem; const float* attn_g; const float* w_in; const float* w_pool; const float* pool_scale;
    const float* lq1; const float* lk1; const float* lq2; const float* lk2; const float* subln_g; const float* w_out; const float* xattn_g; const float* mem_g;
    const float* w_cq; const float* w_ckv; const float* w_co; const float* ffn_g; const float* w_router; const float* b_router; const float* w_gu; const float* b_gu;
    const float* w_down; const float* b_down; const float* final_g;
    float* out; unsigned char* ws; int ph_lo, ph_hi;
};

template <int MAP>
__device__ __forceinline__ int rowmap(int c) {
    if (MAP == 1) { if (c >= 512 && c < 1536) { const int d = c & 63; if (d < 16) return (c & ~63) + ((d < 8) ? 2 * d : 2 * (d - 8) + 1); } return c; }
    if (MAP == 2) { const int j = c & 1023; return ((j >> 7) << 8) + ((c >> 10) << 7) + (j & 127); }
    return c;
}
template <int MAP>
__device__ __forceinline__ void p0_transpose_item(const float* W, int N, bf16_t* WT, int ldt, int kdst0, const float* g, LAS float* scr, int item, int lane) {
    const int nblk = N / 32, kb = item / nblk, nb = item % nblk, k0 = 64 * kb, n0 = 32 * nb;
#pragma unroll 8
    for (int i = 0; i < 32; ++i) { const int kk = 2 * i + (lane >> 5); float v = W[(size_t)(k0 + kk) * N + n0 + (lane & 31)]; if (g) v *= g[k0 + kk]; scr[kk * 33 + (lane & 31)] = v; }
    LDS_WAIT(); asm volatile("" ::: "memory");
    const int c = lane & 7;
#pragma unroll
    for (int j = 0; j < 4; ++j) { const int n = (lane >> 3) + 8 * j; const LAS float* s = scr + (8 * c) * 33 + n;
        u32x4 o; o.x = pk2(s[0 * 33], s[1 * 33]); o.y = pk2(s[2 * 33], s[3 * 33]); o.z = pk2(s[4 * 33], s[5 * 33]); o.w = pk2(s[6 * 33], s[7 * 33]);
        *(u32x4*)(WT + (size_t)rowmap<MAP>(n0 + n) * ldt + kdst0 + k0 + 8 * c) = o; }
    LDS_WAIT(); asm volatile("" ::: "memory");
}
__device__ __forceinline__ void rms_row_to_bf16(const float* xrow, const float* g, bf16_t* orow, int lane) {
    const f32x4* xr = (const f32x4*)xrow + lane; const f32x4* gr = (const f32x4*)g + lane;
    f32x4 v[4]; float s = 0.f;
#pragma unroll
    for (int j = 0; j < 4; ++j) { v[j] = xr[64 * j]; s += (v[j][0] * v[j][0] + v[j][1] * v[j][1]) + (v[j][2] * v[j][2] + v[j][3] * v[j][3]); }
    const float rstd = 1.0f / sqrtf(wave_sum(s) * (1.0f / D) + EPS);
    u32x2* o8 = (u32x2*)orow + lane;
#pragma unroll
    for (int j = 0; j < 4; ++j) { const f32x4 gg = gr[64 * j]; u32x2 w; w.x = pk2(v[j][0] * rstd * gg[0], v[j][1] * rstd * gg[1]); w.y = pk2(v[j][2] * rstd * gg[2], v[j][3] * rstd * gg[3]); o8[64 * j] = w; }
}

namespace dattn {
constexpr int KP = 144, VP = 320;
constexpr int K_BYTES = 2 * 64 * KP, V_BYTES = 64 * VP, STG = K_BYTES + V_BYTES;
__device__ __forceinline__ s16x4 vtr(const LAS unsigned char* p) { typedef short v4i16_t __attribute__((ext_vector_type(4))); return __builtin_bit_cast(s16x4, __builtin_amdgcn_ds_read_tr16_b64_v4i16((LAS v4i16_t*)p)); }
__device__ __forceinline__ void unit(LAS unsigned char* lds, const bf16_t* U, bf16_t* CAT, const float* subln_g, float lam, int b, int hh, int j) {
    const int tid = threadIdx.x, lane = tid & 63, r32 = lane & 31, hi = lane >> 5; const int wid = __builtin_amdgcn_readfirstlane(tid >> 6);
    const int mp = wid & 1, rg = wid >> 1;
    const size_t tok0 = (size_t)b * SEQ;
    const int q0 = j * 128 + rg * 32;
    const int nt_all = 2 * j + 2, nt_mine = (rg < 2) ? nt_all - 1 : nt_all;
    bf16x8 qf[4];
    { const bf16_t* qp = U + (tok0 + q0 + r32) * INW + 512 + hh * 128 + mp * 64 + hi * 8;
#pragma unroll
      for (int ks = 0; ks < 4; ++ks) qf[ks] = *(const bf16x8*)(qp + ks * 16); }
    const int prow = tid >> 3, pc0 = (tid & 7) * 2;
    const bf16_t* kg = U + (tok0 + prow) * INW + 1024 + hh * 128 + pc0 * 8;
    const bf16_t* vg = U + (tok0 + prow) * INW + 1536 + hh * 128 + pc0 * 8;
    unsigned kdst[2], vdst[2];
#pragma unroll
    for (int i = 0; i < 2; ++i) { const int c16 = pc0 + i; kdst[i] = (unsigned)((c16 >> 3) * (64 * KP) + prow * KP + (c16 & 7) * 16); vdst[i] = (unsigned)(K_BYTES + prow * VP + c16 * 16); }
    u32x4 kr[2], vr[2];
#define DA_LOAD(t) do { const size_t go = (size_t)(t) * 64 * INW; kr[0] = *(const u32x4*)(kg + go); kr[1] = *(const u32x4*)(kg + go + 8); vr[0] = *(const u32x4*)(vg + go); vr[1] = *(const u32x4*)(vg + go + 8); } while (0)
#define DA_WRITE(s) do { LAS unsigned char* sb = lds + (s) * STG; *(LAS u32x4*)(sb + kdst[0]) = kr[0]; *(LAS u32x4*)(sb + kdst[1]) = kr[1]; *(LAS u32x4*)(sb + vdst[0]) = vr[0]; *(LAS u32x4*)(sb + vdst[1]) = vr[1]; } while (0)
    f32x16 o[4];
#pragma unroll
    for (int d0 = 0; d0 < 4; ++d0)
#pragma unroll
        for (int r = 0; r < 16; ++r) o[d0][r] = 0.f;
    float mrun = -INFINITY, lrun = 0.f;
    const int i16 = lane & 15, g16 = (lane >> 4) & 1;
    const unsigned kbase = (unsigned)(mp * (64 * KP) + r32 * KP + hi * 16);
    const unsigned vbase = (unsigned)(K_BYTES + (4 * hi + (i16 >> 2)) * VP + (16 * g16 + 4 * (i16 & 3)) * 2);
    DA_LOAD(0); DA_WRITE(0);
    __syncthreads();
    for (int kt = 0; kt < nt_all; ++kt) {
        const bool more = (kt + 1 < nt_all);
        if (more) DA_LOAD(kt + 1);
        if (kt < nt_mine) {
            const LAS unsigned char* sb = lds + (kt & 1) * STG;
            f32x16 p0, p1;
#pragma unroll
            for (int r = 0; r < 16; ++r) { p0[r] = 0.f; p1[r] = 0.f; }
#pragma unroll
            for (int ks = 0; ks < 4; ++ks) {
                const bf16x8 k0 = *(const LAS bf16x8*)(sb + kbase + ks * 32), k1 = *(const LAS bf16x8*)(sb + kbase + 32 * KP + ks * 32);
                p0 = __builtin_amdgcn_mfma_f32_32x32x16_bf16(k0, qf[ks], p0, 0, 0, 0);
                p1 = __builtin_amdgcn_mfma_f32_32x32x16_bf16(k1, qf[ks], p1, 0, 0, 0);
            }
            float mx = fmaxf(p0[0], p1[0]);
#pragma unroll
            for (int r = 1; r < 16; ++r) mx = fmaxf(mx, fmaxf(p0[r], p1[r]));
            mx = fmaxf(mx, __shfl_xor(mx, 32));
            const float mnew = fmaxf(mrun, mx), alpha = __builtin_amdgcn_exp2f(mrun - mnew); mrun = mnew;
            float ls = 0.f;
#pragma unroll
            for (int r = 0; r < 16; ++r) { p0[r] = __builtin_amdgcn_exp2f(p0[r] - mnew); p1[r] = __builtin_amdgcn_exp2f(p1[r] - mnew); ls += p0[r] + p1[r]; }
            lrun = lrun * alpha + ls;
#pragma unroll
            for (int d0 = 0; d0 < 4; ++d0)
#pragma unroll
                for (int r = 0; r < 16; ++r) o[d0][r] *= alpha;
            bf16x8 pf[4];
#pragma unroll
            for (int s = 0; s < 4; ++s) { u32x4 w;
                if (s < 2) { w.x = cvt_pk_bf16(p0[8 * s + 0], p0[8 * s + 1]); w.y = cvt_pk_bf16(p0[8 * s + 2], p0[8 * s + 3]); w.z = cvt_pk_bf16(p0[8 * s + 4], p0[8 * s + 5]); w.w = cvt_pk_bf16(p0[8 * s + 6], p0[8 * s + 7]); }
                else { const int s2 = s - 2; w.x = cvt_pk_bf16(p1[8 * s2 + 0], p1[8 * s2 + 1]); w.y = cvt_pk_bf16(p1[8 * s2 + 2], p1[8 * s2 + 3]); w.z = cvt_pk_bf16(p1[8 * s2 + 4], p1[8 * s2 + 5]); w.w = cvt_pk_bf16(p1[8 * s2 + 6], p1[8 * s2 + 7]); }
                pf[s] = __builtin_bit_cast(bf16x8, w); }
#pragma unroll
            for (int d0 = 0; d0 < 4; ++d0)
#pragma unroll
                for (int s = 0; s < 4; ++s) {
                    const s16x4 lo = vtr(sb + vbase + s * 16 * VP + d0 * 64), hv = vtr(sb + vbase + s * 16 * VP + 8 * VP + d0 * 64);
                    const bf16x8 vf = (bf16x8){lo[0], lo[1], lo[2], lo[3], hv[0], hv[1], hv[2], hv[3]};
                    o[d0] = __builtin_amdgcn_mfma_f32_32x32x16_bf16(vf, pf[s], o[d0], 0, 0, 0);
                }
        }
        if (more) DA_WRITE((kt + 1) & 1);
        __syncthreads();
    }
#undef DA_LOAD
#undef DA_WRITE
    const float ltot = lrun + __shfl_xor(lrun, 32), inv = 1.0f / ltot;
    LAS float* X = (LAS float*)lds + rg * 4096;
    if (mp == 1) {
#pragma unroll
        for (int d0 = 0; d0 < 4; ++d0)
#pragma unroll
            for (int r = 0; r < 16; ++r) { const int dv = 32 * d0 + (r & 3) + 8 * (r >> 2) + 4 * hi; X[dv * 32 + r32] = o[d0][r] * inv; }
    }
    __syncthreads();
    if (mp == 0) {
        float ss = 0.f;
#pragma unroll
        for (int d0 = 0; d0 < 4; ++d0)
#pragma unroll
            for (int r = 0; r < 16; ++r) { const int dv = 32 * d0 + (r & 3) + 8 * (r >> 2) + 4 * hi; const float v = o[d0][r] * inv - lam * X[dv * 32 + r32]; o[d0][r] = v; ss += v * v; }
        ss += __shfl_xor(ss, 32);
        const float rstd = 0.8f / sqrtf(ss * (1.0f / 128.0f) + EPS);
        bf16_t* op = CAT + (tok0 + q0 + r32) * D + 512 + hh * 128;
#pragma unroll
        for (int d0 = 0; d0 < 4; ++d0)
#pragma unroll
            for (int r4 = 0; r4 < 4; ++r4) { const int dv = 32 * d0 + 8 * r4 + 4 * hi; const f32x4 gg = *(const f32x4*)(subln_g + dv);
                u32x2 w; w.x = cvt_pk_bf16(o[d0][4 * r4 + 0] * rstd * gg[0], o[d0][4 * r4 + 1] * rstd * gg[1]); w.y = cvt_pk_bf16(o[d0][4 * r4 + 2] * rstd * gg[2], o[d0][4 * r4 + 3] * rstd * gg[3]);
                *(u32x2*)(op + dv) = w; }
    }
    __syncthreads();
}
}

typedef const __attribute__((address_space(4))) Args* KArgsP;
__device__ __forceinline__ KArgsP kargs() { KArgsP p = (KArgsP)__builtin_amdgcn_kernarg_segment_ptr(); asm volatile("" : "+s"(p)); return p; }
#define PH_PTRS() KArgsP ap = kargs(); unsigned char* ws = ap->ws; (void)ws; \
    float* cs = (float*)(ws + WS_CS); float* ssp = (float*)(ws + WS_SSP); float* rstd2 = (float*)(ws + WS_RSTD2); \
    int* tokslot = (int*)(ws + WS_TOKSLOT); int* ltok = (int*)(ws + WS_LTOK); float* lgate = (float*)(ws + WS_LGATE); \
    bf16_t* Win_t = (bf16_t*)(ws + WS_WIN); bf16_t* Wout_t = (bf16_t*)(ws + WS_WOUT); bf16_t* Wcq_t = (bf16_t*)(ws + WS_WCQ); bf16_t* Wckv_t = (bf16_t*)(ws + WS_WCKV); \
    bf16_t* Wco_t = (bf16_t*)(ws + WS_WCO); bf16_t* Wgu_t = (bf16_t*)(ws + WS_WGU); bf16_t* Wdn_t = (bf16_t*)(ws + WS_WDN); \
    bf16_t* H0 = (bf16_t*)(ws + WS_H0); bf16_t* MEMN = (bf16_t*)(ws + WS_MEMN); bf16_t* KC = (bf16_t*)(ws + WS_KC); bf16_t* VT = (bf16_t*)(ws + WS_VT); \
    bf16_t* U = (bf16_t*)(ws + WS_U); bf16_t* CAT = (bf16_t*)(ws + WS_CAT); float* X1 = (float*)(ws + WS_X1); bf16_t* X1B = (bf16_t*)(ws + WS_X1B); \
    bf16_t* QC = (bf16_t*)(ws + WS_QC); bf16_t* PC = (bf16_t*)(ws + WS_PC); bf16_t* OC = (bf16_t*)(ws + WS_OC); float* X2 = (float*)(ws + WS_X2); bf16_t* X2B = (bf16_t*)(ws + WS_X2B); \
    bf16_t* HID = (bf16_t*)(ws + WS_HID); bf16_t* YR = (bf16_t*)(ws + WS_Y); \
    (void)cs; (void)ssp; (void)rstd2; (void)tokslot; (void)ltok; (void)lgate; (void)Win_t; (void)Wout_t; (void)Wcq_t; (void)Wckv_t; (void)Wco_t; (void)Wgu_t; (void)Wdn_t; (void)H0; (void)MEMN; (void)KC; (void)VT; \
    (void)U; (void)CAT; (void)X1; (void)X1B; (void)QC; (void)PC; (void)OC; (void)X2; (void)X2B; (void)HID; (void)YR

constexpr int NWAVES = 8;
constexpr int N_PHASES = 10;

__global__ void __launch_bounds__(NWAVES * 64, 2) fwd_kernel(Args a) {
    extern __shared__ __attribute__((aligned(16))) unsigned char lds_raw[];
    LAS unsigned char* lds = (LAS unsigned char*)lds_raw;
    const int tid = threadIdx.x, lane = tid & 63, wave = __builtin_amdgcn_readfirstlane(tid >> 6);
    const int G = gridDim.x, bx = blockIdx.x;
    const int gw = bx * NWAVES + wave, NGW = G * NWAVES;
    unsigned* ctl; { unsigned char* ws0 = a.ws; ctl = (unsigned*)(ws0 + WS_CTL); }
    volatile LAS unsigned* MISC = (volatile LAS unsigned*)(lds + MISC_OFF);
    for (int u = tid; u < (LDS_BYTES - MISC_OFF) / 4; u += NWAVES * 64) ((LAS unsigned*)(lds + MISC_OFF))[u] = 0u;
    __syncthreads();
    XcdBarrier bar; bar.bar = ctl + CW_BAR; bar.x = 0; bar.st = nullptr;
    if (MK_N_LAUNCHES == 1) bar = xcd_barrier_post(ctl + CW_BAR, MISC + 8);
    const int lo = a.ph_lo, hi = a.ph_hi;
#define IN(k) (((PMASK >> (k)) & 1) && lo <= (k) && (k) < hi)
#define SEAM(k) do { if (IN(k) && IN((k) + 1)) xcd_barrier(bar); } while (0)

    if (IN(0)) { PH_PTRS();
        LAS float* scr = (LAS float*)(lds + wave * 16384);
        constexpr int I_IN = 16 * 64, I_OUT = 8 * 32, I_CQ = 16 * 32, I_CKV = 16 * 64, I_CO = 16 * 32, I_GU1 = 16 * 64, I_GU = NE * I_GU1, I_DN1 = 16 * 32, I_DN = NE * I_DN1;
        constexpr int I_WEFF = 1024, I_XR = T, I_MR = NMEM, I_ROPE = T * 8 / 64;
        constexpr int NITEMS = I_GU + I_DN + I_IN + I_OUT + I_CQ + I_CKV + I_CO + I_WEFF + I_XR + I_MR + I_ROPE;
        for (int it = gw; it < NITEMS; it += NGW) {
            int r = it;
            if (r < I_GU) { const int e = r / I_GU1; p0_transpose_item<2>(ap->w_gu + (size_t)e * 1024 * 2048, 2048, Wgu_t + (size_t)e * 2048 * 1024, 1024, 0, ap->ffn_g, scr, r % I_GU1, lane); continue; } r -= I_GU;
            if (r < I_DN) { const int e = r / I_DN1; p0_transpose_item<0>(ap->w_down + (size_t)e * 1024 * 1024, 1024, Wdn_t + (size_t)e * 1024 * 1024, 1024, 0, nullptr, scr, r % I_DN1, lane); continue; } r -= I_DN;
            if (r < I_IN) { p0_transpose_item<1>(ap->w_in, 2048, Win_t, 1024, 0, nullptr, scr, r, lane); continue; } r -= I_IN;
            if (r < I_OUT) { p0_transpose_item<0>(ap->w_out + (size_t)512 * 1024, 1024, Wout_t, 1024, 512, nullptr, scr, r, lane); continue; } r -= I_OUT;
            if (r < I_CQ) { p0_transpose_item<0>(ap->w_cq, 1024, Wcq_t, 1024, 0, ap->xattn_g, scr, r, lane); continue; } r -= I_CQ;
            if (r < I_CKV) { p0_transpose_item<0>(ap->w_ckv, 2048, Wckv_t, 1024, 0, nullptr, scr, r, lane); continue; } r -= I_CKV;
            if (r < I_CO) { p0_transpose_item<0>(ap->w_co, 1024, Wco_t, 1024, 0, nullptr, scr, r, lane); continue; } r -= I_CO;
            if (r < I_WEFF) {
                const int nb = r & 15, cb = r >> 4, n = nb * 64 + lane, kk0 = cb * 8, g = kk0 >> 7;
                float accv[8];
#pragma unroll
                for (int q = 0; q < 8; ++q) accv[q] = 0.f;
                for (int d = 0; d < 128; ++d) { const float wo = ap->w_out[(size_t)(g * 128 + d) * 1024 + n] * ap->pool_scale[g * 128 + d];
#pragma unroll
                    for (int q = 0; q < 8; ++q) accv[q] += ap->w_pool[(size_t)(kk0 + q) * 128 + d] * wo; }
                u32x4 o4; o4.x = pk2(accv[0], accv[1]); o4.y = pk2(accv[2], accv[3]); o4.z = pk2(accv[4], accv[5]); o4.w = pk2(accv[6], accv[7]);
                *(u32x4*)(Wout_t + (size_t)n * 1024 + kk0) = o4; continue; } r -= I_WEFF;
            if (r < I_XR) { rms_row_to_bf16(ap->x + (size_t)r * D, ap->attn_g, H0 + (size_t)r * D, lane); continue; } r -= I_XR;
            if (r < I_MR) { rms_row_to_bf16(ap->mem + (size_t)r * D, ap->mem_g, MEMN + (size_t)r * D, lane); continue; } r -= I_MR;
            {
                const int idx = r * 64 + lane, t = idx >> 3, i = idx & 7;
                const double inv_freq = exp2(-(double)i * (18.931568569324174 / 8.0));
                const double rev = (double)ap->pos[t] * inv_freq * 0.15915494309189535;
                const float fr = (float)(rev - floor(rev));
                cs[(size_t)idx * 2] = __builtin_amdgcn_cosf(fr); cs[(size_t)idx * 2 + 1] = __builtin_amdgcn_sinf(fr);
            }
        }
    }
    SEAM(0);

    if (IN(1)) { PH_PTRS();
        { pg8::StaticOrder S; S.init(H0, Win_t, T, INW, D, D, G, bx); pg8::EpiInProj E{U, cs};
          pg8::gemm_phase<pg8::EpiInProj, pg8::StaticOrder, true, false>(lds, D, D, D, S, E); }
        { pg8::StaticOrder S; S.init(MEMN, Wckv_t, NMEM, 1024, D, D, G, bx); pg8::EpiBf16 E{KC, 1024, nullptr, 1.0f};
          pg8::gemm_phase<pg8::EpiBf16, pg8::StaticOrder, true, false>(lds, D, D, D, S, E); }
        { pg8::StaticOrder S; S.init(Wckv_t + (size_t)1024 * 1024, MEMN, 1024, NMEM, D, D, G, (bx + 32) % G); pg8::EpiBf16 E{VT, NMEM, nullptr, 1.0f};
          pg8::gemm_phase<pg8::EpiBf16, pg8::StaticOrder, true, false>(lds, D, D, D, S, E); }
    }
    SEAM(1);

    if (IN(2)) { PH_PTRS();
        float d1 = (lane < 64) ? ap->lq1[lane] * ap->lk1[lane] : 0.f, d2 = ap->lq2[lane] * ap->lk2[lane];
        d1 = wave_sum(d1); d2 = wave_sum(d2);
        const float lam = expf(d1) - expf(d2) + 0.2f;
        for (int un = bx; un < 256; un += G) {
            const int bh = un >> 3, jp = un & 7;
            dattn::unit(lds, U, CAT, ap->subln_g, lam, bh >> 2, bh & 3, jp);
            dattn::unit(lds, U, CAT, ap->subln_g, lam, bh >> 2, bh & 3, 15 - jp);
        }
        for (int it = gw; it < T / 8; it += NGW) {
            const int b = it >> 8, t0 = (it & 255) * 8, wnd = 2 << (lane >> 4);
            const bf16_t* up = U + (size_t)b * SEQ * INW + lane * 8;
#pragma unroll 1
            for (int tt = 0; tt < 8; ++tt) { const int t = t0 + tt; float s[8], c[8];
#pragma unroll
                for (int q = 0; q < 8; ++q) s[q] = 0.f;
                for (int jj = 0; jj < 16; ++jj) { if (jj < wnd && jj <= t) { const bf16x8 v = *(const bf16x8*)(up + (size_t)(t - jj) * INW);
#pragma unroll
                        for (int q = 0; q < 8; ++q) { const float f = bf2f((unsigned short)v[q]); s[q] += f; if (jj == 0) c[q] = f; } } }
                const float ic = 1.0f / (float)((t + 1 < wnd) ? t + 1 : wnd);
                u32x4 o4; o4.x = pk2(s[0] * ic - c[0], s[1] * ic - c[1]); o4.y = pk2(s[2] * ic - c[2], s[3] * ic - c[3]); o4.z = pk2(s[4] * ic - c[4], s[5] * ic - c[5]); o4.w = pk2(s[6] * ic - c[6], s[7] * ic - c[7]);
                *(u32x4*)(CAT + ((size_t)b * SEQ + t) * D + lane * 8) = o4; }
        }
    }
    SEAM(2);

    if (IN(3)) { PH_PTRS();
        pg8::StaticOrder S; S.init(CAT, Wout_t, T, D, D, D, G, bx); pg8::EpiRes E{ap->x, X1, X1B, ssp};
        pg8::gemm_phase<pg8::EpiRes, pg8::StaticOrder, true, false>(lds, D, D, D, S, E);
    }
    SEAM(3);

    if (IN(4)) { PH_PTRS();
        LAS float* rs = (LAS float*)(lds + XTAB_OFF);
        for (int un = bx; un < 256; un += G) {
            const int pm = un >> 2, h = un & 3, b = pm >> 3;
            if (tid < 256) { const int row = pm * 256 + tid; float s = 0.f;
#pragma unroll
                for (int p = 0; p < 16; ++p) s += ssp[(size_t)p * T + row];
                rs[tid] = 1.0f / sqrtf(s * (1.0f / D) + EPS); }
            __syncthreads();
            { pg8::SingleUnit S; S.u = pg8::Unit{pm, h, 0, 256, (const char*)(X1B + (size_t)pm * 256 * D), (const char*)(Wcq_t + (size_t)h * 256 * D)};
              pg8::EpiBf16 E{QC, D, rs, QSCALE_X};
              pg8::gemm_phase<pg8::EpiBf16, pg8::SingleUnit, false, false>(lds, D, D, D, S, E); }
            wg_global_sync();
            { pg8::SingleUnit S; S.u = pg8::Unit{pm, h, 0, 256, (const char*)(QC + (size_t)pm * 256 * D + h * 256), (const char*)(KC + (size_t)b * 256 * D + h * 256)};
              pg8::EpiSoftmax E{PC, D};
              pg8::gemm_phase<pg8::EpiSoftmax, pg8::SingleUnit, false, false>(lds, 256, D, D, S, E); }
            wg_global_sync();
            { pg8::SingleUnit S; S.u = pg8::Unit{pm, h, 0, 256, (const char*)(PC + (size_t)pm * 256 * D + h * 256), (const char*)(VT + (size_t)h * 256 * NMEM + b * 256)};
              pg8::EpiBf16 E{OC, D, nullptr, 1.0f};
              pg8::gemm_phase<pg8::EpiBf16, pg8::SingleUnit, false, false>(lds, 256, D, NMEM, S, E); }
            __syncthreads();
        }
    }
    SEAM(4);

    if (IN(5)) { PH_PTRS();
        pg8::StaticOrder S; S.init(OC, Wco_t, T, D, D, D, G, bx); pg8::EpiRes E{X1, X2, X2B, nullptr};
        pg8::gemm_phase<pg8::EpiRes, pg8::StaticOrder, true, false>(lds, D, D, D, S, E);
    }
    SEAM(5);

    if (IN(6)) { PH_PTRS();
        LAS float* WR = (LAS float*)lds;
        LAS int* lcnt = (LAS int*)(lds + RT_OFF);
        LAS int* sel = (LAS int*)(lds + RT_OFF + 512);
        LAS float* selg = (LAS float*)(lds + RT_OFF + 512 + 1024);
        for (int tb = bx; tb < T / 64; tb += G) {
            for (int i = tid; i < 1024 * 32; i += NWAVES * 64) WR[i] = ap->w_router[i] * ap->ffn_g[i >> 5];
            if (tid < 32) lcnt[tid] = 0;
            __syncthreads();
            const int e = lane & 31, kh = lane >> 5;
            for (int tt = 0; tt < 8; ++tt) {
                const int tl = wave * 8 + tt, tok = tb * 64 + tl;
                const f32x4* xr = (const f32x4*)(X2 + (size_t)tok * D + kh * 512);
                float accl = 0.f, ss = 0.f;
                for (int k4 = 0; k4 < 128; ++k4) { const f32x4 xv = xr[k4]; const LAS float* wp = WR + (kh * 512 + k4 * 4) * 32 + e;
                    accl += xv[0] * wp[0] + xv[1] * wp[32] + xv[2] * wp[64] + xv[3] * wp[96];
                    ss += (xv[0] * xv[0] + xv[1] * xv[1]) + (xv[2] * xv[2] + xv[3] * xv[3]); }
                accl += __shfl_xor(accl, 32); ss += __shfl_xor(ss, 32);
                const float rstd = 1.0f / sqrtf(ss * (1.0f / D) + EPS);
                float lg = accl * rstd + ap->b_router[e];
                if (lane == 0) rstd2[tok] = rstd;
                float tv[4]; int ti[4];
#pragma unroll
                for (int k = 0; k < 4; ++k) { float bv = lg; int bi = e;
#pragma unroll
                    for (int o = 1; o < 32; o <<= 1) { const float ov = __shfl_xor(bv, o); const int oi = __shfl_xor(bi, o); if (ov > bv || (ov == bv && oi < bi)) { bv = ov; bi = oi; } }
                    tv[k] = bv; ti[k] = bi; if (e == bi) lg = -INFINITY; }
                const float e0 = 1.0f, e1 = expf(tv[1] - tv[0]), e2 = expf(tv[2] - tv[0]), e3 = expf(tv[3] - tv[0]), isum = 1.0f / (e0 + e1 + e2 + e3);
                if (lane < 4) { const int ee = (lane == 0) ? ti[0] : (lane == 1) ? ti[1] : (lane == 2) ? ti[2] : ti[3];
                    const float gg = ((lane == 0) ? e0 : (lane == 1) ? e1 : (lane == 2) ? e2 : e3) * isum;
                    const int lr = atomicAdd((int*)&lcnt[ee], 1);
                    sel[tl * 4 + lane] = (ee << 16) | lr; selg[tl * 4 + lane] = gg; }
            }
            __syncthreads();
            if (tid < 32) { const int c = lcnt[tid]; lcnt[32 + tid] = (c > 0) ? (int)atomicAdd(ctl + CW_CNT + tid, (unsigned)c) : 0; }
            __syncthreads();
            if (tid < 256) { const int tl = tid >> 2, tok = tb * 64 + tl, sv = sel[tid], ee = sv >> 16, pos = lcnt[32 + ee] + (sv & 0xffff);
                ltok[ee * CAP + pos] = tok; lgate[ee * CAP + pos] = selg[tid]; tokslot[tok * 4 + (tid & 3)] = (ee << 16) | pos; }
            __syncthreads();
        }
    }
    SEAM(6);

    LAS int* ecnt = (LAS int*)(lds + ECNT_OFF);
    LAS int* etp = (LAS int*)(lds + ECNT_OFF + 128);
    if (IN(7) || IN(8) || IN(9)) {
        __syncthreads();
        if (tid == 0) { int acc = 0; for (int e = 0; e < NE; ++e) { const int c = (int)__hip_atomic_load(ctl + CW_CNT + e, __ATOMIC_RELAXED, __HIP_MEMORY_SCOPE_AGENT); ecnt[e] = c; etp[e] = acc; acc += (c + 255) >> 8; } etp[NE] = acc; }
        __syncthreads();
    }

    if (IN(7)) { PH_PTRS();
        const int ntile = etp[NE], nunits = ntile * 8;
        for (int L = bx; L < nunits; L += G) {
            int e = 0; while (e < NE - 1 && L >= etp[e + 1] * 8) ++e;
            const int rem = L - etp[e] * 8, nrt = etp[e + 1] - etp[e], pn = rem / nrt, r = rem % nrt;
            const int nvalid = min(256, ecnt[e] - r * 256), hrow0 = (etp[e] + r) * 256;
            pg8::GatherUnit S; S.u = pg8::Unit{0, pn, e, nvalid, (const char*)X2B, (const char*)(Wgu_t + ((size_t)e * 2048 + (size_t)pn * 256) * 1024)};
            S.toks = ltok + e * CAP + r * 256; S.rowbytes = D * 2;
            pg8::EpiSwiGLU E{HID, ap->b_gu + (size_t)e * 2048, rstd2, ltok + e * CAP + r * 256, hrow0};
            pg8::gemm_phase<pg8::EpiSwiGLU, pg8::GatherUnit, false, true>(lds, D, D, D, S, E);
            __syncthreads();
        }
    }
    SEAM(7);

    if (IN(8)) { PH_PTRS();
        const int ntile = etp[NE], nunits = ntile * 4;
        for (int L = bx; L < nunits; L += G) {
            int e = 0; while (e < NE - 1 && L >= etp[e + 1] * 4) ++e;
            const int rem = L - etp[e] * 4, nrt = etp[e + 1] - etp[e], pn = rem / nrt, r = rem % nrt;
            const int nvalid = min(256, ecnt[e] - r * 256), hrow0 = (etp[e] + r) * 256;
            pg8::SingleUnit S; S.u = pg8::Unit{0, pn, e, nvalid, (const char*)(HID + (size_t)hrow0 * 1024), (const char*)(Wdn_t + ((size_t)e * 1024 + (size_t)pn * 256) * 1024)};
            pg8::EpiDown E{YR, ap->b_down + (size_t)e * 1024, lgate + e * CAP + r * 256, hrow0};
            pg8::gemm_phase<pg8::EpiDown, pg8::SingleUnit, false, false>(lds, D, D, D, S, E);
            __syncthreads();
        }
    }
    SEAM(8);

    if (IN(9)) { PH_PTRS();
        for (int tok = gw; tok < T; tok += NGW) {
            int rowk[4];
#pragma unroll
            for (int k = 0; k < 4; ++k) { const int sv = tokslot[tok * 4 + k], ee = sv >> 16; rowk[k] = etp[ee] * 256 + (sv & 0xffff); }
            const f32x4* xr = (const f32x4*)(X2 + (size_t)tok * D) + lane;
            f32x4 v[4]; float s = 0.f;
#pragma unroll
            for (int j = 0; j < 4; ++j) { v[j] = xr[64 * j];
#pragma unroll
                for (int k = 0; k < 4; ++k) { const u32x2 y = *((const u32x2*)(YR + (size_t)rowk[k] * 1024) + lane + 64 * j);
                    v[j][0] += __builtin_bit_cast(float, y.x << 16); v[j][1] += __builtin_bit_cast(float, y.x & 0xffff0000u);
                    v[j][2] += __builtin_bit_cast(float, y.y << 16); v[j][3] += __builtin_bit_cast(float, y.y & 0xffff0000u); }
                s += (v[j][0] * v[j][0] + v[j][1] * v[j][1]) + (v[j][2] * v[j][2] + v[j][3] * v[j][3]); }
            const float rstd = 1.0f / sqrtf(wave_sum(s) * (1.0f / D) + EPS);
            f32x4* op = (f32x4*)(ap->out + (size_t)tok * D) + lane; const f32x4* gr = (const f32x4*)ap->final_g + lane;
#pragma unroll
            for (int j = 0; j < 4; ++j) op[64 * j] = v[j] * rstd * gr[64 * j];
        }
    }
#undef IN
#undef SEAM
}

extern "C" void kernel_launch(void* const* d_in, const int* in_sizes, int n_in, void* d_out, int out_size, void* d_ws, size_t ws_size, hipStream_t stream) {
    static int grid = 0;
    if (grid == 0) {
        if (n_in != 26 || in_sizes[0] != T * D || out_size != T * D || ws_size < WS_END) { fprintf(stderr, "kernel_launch: unexpected shapes (n_in %d, in0 %d, out %d, ws %zu); nothing launched\n", n_in, n_in > 0 ? in_sizes[0] : -1, out_size, ws_size); grid = -1; return; }
        int dev = 0, cus = 0, per_cu = 0;
        if (hipGetDevice(&dev) != hipSuccess || hipDeviceGetAttribute(&cus, hipDeviceAttributeMultiprocessorCount, dev) != hipSuccess) { grid = -1; return; }
        if (hipFuncSetAttribute((const void*)fwd_kernel, hipFuncAttributeMaxDynamicSharedMemorySize, LDS_BYTES) != hipSuccess) { fprintf(stderr, "kernel_launch: hipFuncSetAttribute failed\n"); grid = -1; return; }
        if (hipOccupancyMaxActiveBlocksPerMultiprocessor(&per_cu, (const void*)fwd_kernel, NWAVES * 64, LDS_BYTES) != hipSuccess || per_cu < 1) { fprintf(stderr, "kernel_launch: occupancy query says %d\n", per_cu); per_cu = 1; }
        (void)hipGetLastError();
        grid = cus;
    }
    if (grid < 0) return;
    (void)hipMemsetAsync((char*)d_ws + WS_CTL, 0, CTL_BYTES, stream);
    Args a{};
    a.x = (const float*)d_in[0]; a.pos = (const int*)d_in[1]; a.mem = (const float*)d_in[2]; a.attn_g = (const float*)d_in[3]; a.w_in = (const float*)d_in[4];
    a.w_pool = (const float*)d_in[5]; a.pool_scale = (const float*)d_in[6]; a.lq1 = (const float*)d_in[7]; a.lk1 = (const float*)d_in[8]; a.lq2 = (const float*)d_in[9];
    a.lk2 = (const float*)d_in[10]; a.subln_g = (const float*)d_in[11]; a.w_out = (const float*)d_in[12]; a.xattn_g = (const float*)d_in[13]; a.mem_g = (const float*)d_in[14];
    a.w_cq = (const float*)d_in[15]; a.w_ckv = (const float*)d_in[16]; a.w_co = (const float*)d_in[17]; a.ffn_g = (const float*)d_in[18]; a.w_router = (const float*)d_in[19];
    a.b_router = (const float*)d_in[20]; a.w_gu = (const float*)d_in[21]; a.b_gu = (const float*)d_in[22]; a.w_down = (const float*)d_in[23]; a.b_down = (const float*)d_in[24];
    a.final_g = (const float*)d_in[25]; a.out = (float*)d_out; a.ws = (unsigned char*)d_ws;
    if (MK_N_LAUNCHES == 1) {
        a.ph_lo = 0; a.ph_hi = N_PHASES;
        void* args[] = {&a};
        hipError_t e = hipLaunchCooperativeKernel((const void*)fwd_kernel, dim3(grid), dim3(NWAVES * 64), args, LDS_BYTES, stream);
        if (e != hipSuccess) fprintf(stderr, "kernel_launch: cooperative launch failed: %s (grid %d)\n", hipGetErrorString(e), grid);
    } else {
        for (int p = 0; p < N_PHASES; ++p) { a.ph_lo = p; a.ph_hi = p + 1; hipLaunchKernelGGL(fwd_kernel, dim3(grid), dim3(NWAVES * 64), LDS_BYTES, stream, a); }
    }
}
```

```cpp
#include <hip/hip_runtime.h>
#include <cstdio>
#include <cstdint>

#ifndef MK_N_LAUNCHES
#define MK_N_LAUNCHES 1
#endif

#ifndef REPMASK
#define REPMASK 0
#endif
#define REPS(k) (((REPMASK >> (k)) & 1) ? 2 : 1)
#ifndef PMASK
#define PMASK 0x3ff
#endif
#define LAS __attribute__((address_space(3)))
#define GAS __attribute__((address_space(1)))

typedef unsigned short bf16_t;
typedef short bf16x8 __attribute__((ext_vector_type(8)));
typedef short s16x4 __attribute__((ext_vector_type(4)));
typedef float f32x4 __attribute__((ext_vector_type(4)));
typedef float f32x2 __attribute__((ext_vector_type(2)));
typedef float f32x16 __attribute__((ext_vector_type(16)));
typedef unsigned u32x4 __attribute__((ext_vector_type(4)));
typedef unsigned u32x2 __attribute__((ext_vector_type(2)));

constexpr int NB = 8, SEQ = 2048, T = NB * SEQ, D = 1024, INW = 2048, MEM = 256, NMEM = NB * MEM;
constexpr int NE = 32, TOPK = 4, CAP = 16384, MAXRT = 288;
constexpr float EPS = 1e-5f;
constexpr float LOG2E = 1.4426950408889634f;
constexpr float QSCALE_D = 0.125f * LOG2E;
constexpr float QSCALE_X = 0.0625f * LOG2E;

constexpr size_t MiB = 1u << 20;
constexpr size_t WS_CTL = 0, CTL_BYTES = 1 * MiB;
constexpr size_t WS_CS = 1 * MiB;
constexpr size_t WS_SSP = 2 * MiB;
constexpr size_t WS_RSTD2 = 3 * MiB;
constexpr size_t WS_TOKSLOT = 3 * MiB + 256 * 1024;
constexpr size_t WS_LTOK = 4 * MiB;
constexpr size_t WS_LGATE = 6 * MiB;
constexpr size_t WS_WIN = 8 * MiB;
constexpr size_t WS_WOUT = 12 * MiB;
constexpr size_t WS_WCQ = 14 * MiB;
constexpr size_t WS_WCKV = 16 * MiB;
constexpr size_t WS_WCO = 20 * MiB;
constexpr size_t WS_WGU = 24 * MiB;
constexpr size_t WS_WDN = 152 * MiB;
constexpr size_t WS_H0 = 216 * MiB;
constexpr size_t WS_MEMN = 248 * MiB;
constexpr size_t WS_KC = 252 * MiB;
constexpr size_t WS_VT = 256 * MiB;
constexpr size_t WS_U = 260 * MiB;
constexpr size_t WS_CAT = 324 * MiB;
constexpr size_t WS_X1 = 356 * MiB;
constexpr size_t WS_X1B = 420 * MiB;
constexpr size_t WS_QC = 452 * MiB;
constexpr size_t WS_PC = 484 * MiB;
constexpr size_t WS_OC = 516 * MiB;
constexpr size_t WS_X2 = 548 * MiB;
constexpr size_t WS_X2B = 612 * MiB;
constexpr size_t WS_HID = 644 * MiB;
constexpr size_t WS_Y = 788 * MiB;
constexpr size_t WS_END = 932 * MiB;
constexpr int CW_CNT = 64;
constexpr int CW_BAR = 4096;

constexpr int RING_BYTES = 131072;
constexpr int XTAB_OFF = RING_BYTES;
constexpr int ECNT_OFF = RING_BYTES + 1024;
constexpr int RT_OFF = RING_BYTES + 1536;
constexpr int MISC_OFF = RING_BYTES + 4096;
static_assert(RT_OFF + 2560 <= MISC_OFF, "LDS map");
constexpr int LDS_BYTES = 147456;

#define LDS_WAIT() asm volatile("s_waitcnt lgkmcnt(0)" ::: "memory")
#define VM_WAIT() asm volatile("s_waitcnt vmcnt(0)" ::: "memory")
__device__ __forceinline__ unsigned f2bf(float f) { unsigned u = __builtin_bit_cast(unsigned, f); return (u + 0x7fffu + ((u >> 16) & 1u)) >> 16; }
__device__ __forceinline__ unsigned pk2(float lo, float hi) { return f2bf(lo) | (f2bf(hi) << 16); }
__device__ __forceinline__ float bf2f(unsigned short v) { return __builtin_bit_cast(float, (unsigned)v << 16); }
__device__ __forceinline__ unsigned cvt_pk_bf16(float lo, float hi) { unsigned r; asm volatile("v_cvt_pk_bf16_f32 %0, %1, %2" : "=v"(r) : "v"(lo), "v"(hi)); return r; }
__device__ __forceinline__ float wave_sum(float v) {
#pragma unroll
    for (int o = 1; o < 64; o <<= 1) v += __shfl_xor(v, o);
    return v;
}

#define XB_TMO      128
#define XB_XCNT(j)  (256  + 64 * (j))
#define XB_XSUB(j)  (1280 + 64 * (j))
#define XB_XGEN(j)  (2304 + 64 * (j))
#define XB_TOP      3328
#define XB_TOPGEN   3392
#define XCD_BAR_WORDS 3456
#define XB_SPIN_CAP (1u << 18)
__device__ __forceinline__ unsigned xb_ld(unsigned* p)              { return __hip_atomic_load(p, __ATOMIC_RELAXED, __HIP_MEMORY_SCOPE_AGENT); }
__device__ __forceinline__ unsigned xb_add(unsigned* p, unsigned v) { return __hip_atomic_fetch_add(p, v, __ATOMIC_RELAXED, __HIP_MEMORY_SCOPE_AGENT); }
__device__ __forceinline__ unsigned xb_xcc_id() { return (unsigned)__builtin_amdgcn_s_getreg((3 << 11) | 20) & 0xFu; }
#define XB_SPIN(cond, bar) do { unsigned _sp = 0; while (cond) { __builtin_amdgcn_s_sleep(1); \
    if ((++_sp & 255u) == 0u) { if (xb_ld(&(bar)[XB_TMO])) break; if (_sp > XB_SPIN_CAP) { atomicAdd(&(bar)[XB_TMO], 1u); break; } } } } while (0)
struct XcdBarrier { unsigned* bar; unsigned x; volatile LAS unsigned* st; };
__device__ __forceinline__ XcdBarrier xcd_barrier_post(unsigned* bar, volatile LAS unsigned* st) {
    XcdBarrier b; b.bar = bar; b.x = xb_xcc_id(); b.st = st;
    if (threadIdx.x == 0) (void)xb_add(&bar[XB_XCNT(b.x)], 1u);
    return b;
}
__device__ __forceinline__ void xcd_barrier_complete(unsigned* bar, unsigned x, unsigned& nloc, unsigned& nx) {
    const unsigned G = gridDim.x * gridDim.y * gridDim.z;
    unsigned sum, cnt, mine, sp = 0u;
    for (;;) {
        sum = 0u; cnt = 0u; mine = 0u;
#pragma unroll
        for (unsigned j = 0; j < 16; ++j) { const unsigned c = xb_ld(&bar[XB_XCNT(j)]); sum += c; cnt += (c > 0u) ? 1u : 0u; mine = (j == x) ? c : mine; }
        if (sum == G) break;
        __builtin_amdgcn_s_sleep(1);
        if ((++sp & 255u) == 0u) { if (xb_ld(&bar[XB_TMO])) break; if (sp > XB_SPIN_CAP) { atomicAdd(&bar[XB_TMO], 1u); break; } }
    }
    nloc = mine > 0u ? mine : 1u; nx = cnt > 0u ? cnt : 1u;
}
__device__ __forceinline__ void xcd_barrier(const XcdBarrier& b) {
    asm volatile("s_waitcnt vmcnt(0)" ::: "memory");
    __syncthreads();
    if (threadIdx.x == 0) {
        unsigned* bar = b.bar;
        __builtin_amdgcn_s_waitcnt(0);
        unsigned nloc = b.st[0], nx = b.st[1];
        if (nloc == 0u) { xcd_barrier_complete(bar, b.x, nloc, nx); b.st[0] = nloc; b.st[1] = nx; }
        const unsigned old = xb_add(&bar[XB_XSUB(b.x)], 1u);
        const unsigned gen = old / nloc;
        if (old + 1u == (gen + 1u) * nloc) {
            __builtin_amdgcn_fence(__ATOMIC_RELEASE, "agent");
            asm volatile("s_waitcnt vmcnt(0)" ::: "memory");
            const unsigned og = xb_add(&bar[XB_TOP], 1u);
            const unsigned tg = og / nx;
            if (og + 1u == (tg + 1u) * nx) xb_add(&bar[XB_TOPGEN], 1u);
            else XB_SPIN(xb_ld(&bar[XB_TOPGEN]) == tg, bar);
            __builtin_amdgcn_fence(__ATOMIC_ACQUIRE, "agent");
            xb_add(&bar[XB_XGEN(b.x)], 1u);
            asm volatile("s_waitcnt vmcnt(0)" ::: "memory");
        } else {
            XB_SPIN(xb_ld(&bar[XB_XGEN(b.x)]) == gen, bar);
            __builtin_amdgcn_fence(__ATOMIC_ACQUIRE, "agent");
            asm volatile("s_waitcnt vmcnt(0)" ::: "memory");
        }
    }
    __syncthreads();
}
__device__ __forceinline__ void wg_global_sync() {
    asm volatile("s_waitcnt vmcnt(0)" ::: "memory");
    __syncthreads();
    if (threadIdx.x == 0) { __builtin_amdgcn_fence(__ATOMIC_ACQUIRE, "agent"); asm volatile("s_waitcnt vmcnt(0)" ::: "memory"); }
    __syncthreads();
}

namespace pg8 {
constexpr int BM = 256, BK = 64, HALF = 128, HTB = HALF * BK * 2, STAGE_BYTES = 8 * HTB, NXCD = 8, WGM = 8;
__host__ __device__ __forceinline__ int lds_byte(int r, int c) { const int st = (r >> 4) * 2 + (c >> 5), rr = r & 15, cc = c & 31, ob = rr * 64 + cc * 2; return st * 1024 + (ob ^ (((ob >> 9) & 1) << 5)); }
__host__ __device__ __forceinline__ void stage_rc(int b, int& R, int& C) { const int st = b / 1024, sb = b % 1024, swz = sb ^ (((sb >> 9) & 1) << 5); R = (st >> 1) * 16 + swz / 64; C = (st & 1) * 32 + (swz % 64) / 2; }
__host__ __device__ __forceinline__ int perm32(int rho) { const int n = rho >> 4, i = rho & 15; return 8 * (i >> 2) + 4 * n + (i & 3); }

struct Unit { int pm, pn, e, nvalid; const char* pa; const char* pb; };

struct StaticOrder {
    int nM, nN, nwg, G, c; const char* A; const char* Bt; size_t atile, btile;
    __device__ void init(const void* A_, const void* Bt_, int M, int N, int lda, int ldb, int G_, int c_) { nM = M / BM; nN = N / BM; nwg = nM * nN; G = G_; c = c_; A = (const char*)A_; Bt = (const char*)Bt_; atile = (size_t)BM * lda * 2; btile = (size_t)BM * ldb * 2; }
    __device__ bool next(int i, Unit& u) const {
        const long L = (long)i * G + c; if (L >= nwg) return false;
        int wgid = (int)L; { const int q = nwg / NXCD, r = nwg % NXCD, xcd = wgid % NXCD, off = wgid / NXCD; wgid = (xcd < r ? xcd * (q + 1) : r * (q + 1) + (xcd - r) * q) + off; }
        const int nig = WGM * nN, gid = wgid / nig, fm = gid * WGM, gsz = (nM - fm) < WGM ? (nM - fm) : WGM;
        u.pm = fm + ((wgid % nig) % gsz); u.pn = (wgid % nig) / gsz; u.e = 0; u.nvalid = 256;
        u.pa = A + (size_t)u.pm * atile; u.pb = Bt + (size_t)u.pn * btile; return true;
    }
    __device__ __forceinline__ unsigned row_off(const Unit&, int) const { return 0u; }
};
struct SingleUnit {
    Unit u;
    __device__ bool next(int i, Unit& o) const { if (i != 0) return false; o = u; return true; }
    __device__ __forceinline__ unsigned row_off(const Unit&, int) const { return 0u; }
};
struct GatherUnit {
    Unit u; const int* toks; unsigned rowbytes;
    __device__ bool next(int i, Unit& o) const { if (i != 0) return false; o = u; return true; }
    __device__ __forceinline__ unsigned row_off(const Unit& uu, int r) const { const int t = (r < uu.nvalid) ? toks[r] : 0; return (unsigned)t * rowbytes; }
};

template <class Epi, class Sched, bool ALIGN_EPI, bool GATHER>
__device__ __forceinline__ void gemm_phase(LAS unsigned char* lds, const int K, const int lda, const int ldb, const Sched& S, const Epi& E) {
    int tid_ = threadIdx.x; asm volatile("" : "+v"(tid_));
    const int tid = tid_, wid = __builtin_amdgcn_readfirstlane(tid >> 6), lane = tid & 63, wr = wid >> 2, wc = wid & 3, fr = lane & 15, fq = lane >> 4;
    const int nt = K / BK;
    Unit cur, nxt; int ui = 0;
    if (!S.next(0, cur)) return;
    unsigned voffA[GATHER ? 2 : 1][2], voffB[2];
#pragma unroll
    for (int i = 0; i < 2; ++i) { int R, C; stage_rc(tid * 16 + i * 8192, R, C); const int Rb = Epi::PERM ? ((R & ~31) + perm32(R & 31)) : R;
        if constexpr (GATHER) { voffA[0][i] = S.row_off(cur, R) + (unsigned)C * 2u; voffA[1][i] = S.row_off(cur, R + HALF) + (unsigned)C * 2u; }
        else { voffA[0][i] = (unsigned)(R * lda + C) * 2u; }
        voffB[i] = (unsigned)(Rb * ldb + C) * 2u; }
    const size_t kstep = (size_t)(BK * 2);
    const size_t hstepA = GATHER ? (size_t)0 : (size_t)HALF * lda * 2, hstepB = (size_t)HALF * ldb * 2;
    const unsigned ldsw = (unsigned)wid * 1024u;
    const int aoff = lds_byte(wr * 64 + fr, fq * 8), boff = lds_byte(wc * 32 + fr, fq * 8);
#define PG8_SA(b, h) (((b) * 2 + (h)) * HTB)
#define PG8_SB(b, h) ((4 + (b) * 2 + (h)) * HTB)
#define PG8_STAGE(bufoff, gbase, voff) do { _Pragma("unroll") for (int _i = 0; _i < 2; ++_i) \
        __builtin_amdgcn_global_load_lds((const unsigned*)((const char*)(gbase) + (voff)[_i]), (LAS unsigned*)(lds + (bufoff) + ldsw + _i * 8192), 16, 0, 0); } while (0)
#define PG8_STAGEA(bufoff, gbase, h) PG8_STAGE(bufoff, (gbase) + (h) * hstepA, voffA[GATHER ? (h) : 0])
#define PG8_STAGEB(bufoff, gbase, h) PG8_STAGE(bufoff, (gbase) + (h) * hstepB, voffB)
#define PG8_LDA(dst, b, h) do { _Pragma("unroll") for (int m = 0; m < 4; ++m) _Pragma("unroll") for (int k = 0; k < 2; ++k) dst[m][k] = *(const LAS bf16x8*)(lds + PG8_SA(b, h) + aoff + m * 2048 + k * 1024); } while (0)
#define PG8_LDB(dst, b, h) do { _Pragma("unroll") for (int n = 0; n < 2; ++n) _Pragma("unroll") for (int k = 0; k < 2; ++k) dst[n][k] = *(const LAS bf16x8*)(lds + PG8_SB(b, h) + boff + n * 2048 + k * 1024); } while (0)
#define PG8_MMA(ai, bj, At, Bt) do { __builtin_amdgcn_s_setprio(1); _Pragma("unroll") for (int m = 0; m < 4; ++m) _Pragma("unroll") for (int n = 0; n < 2; ++n) _Pragma("unroll") for (int k = 0; k < 2; ++k) \
        acc[ai][bj][m][n] = __builtin_amdgcn_mfma_f32_16x16x32_bf16(Bt[n][k], At[m][k], acc[ai][bj][m][n], 0, 0, 0); __builtin_amdgcn_s_setprio(0); } while (0)
#define PG8_WAIT_V(n) asm volatile("s_waitcnt vmcnt(" #n ")" ::: "memory")
#define PG8_WAIT_L(n) asm volatile("s_waitcnt lgkmcnt(" #n ")" ::: "memory")
#define PG8_BAR __builtin_amdgcn_s_barrier()
#define PG8_SCHED __builtin_amdgcn_sched_barrier(0)
    f32x4 acc[2][2][4][2];
#pragma unroll
    for (int a = 0; a < 2; ++a)
#pragma unroll
        for (int b = 0; b < 2; ++b)
#pragma unroll
            for (int m = 0; m < 4; ++m)
#pragma unroll
                for (int n = 0; n < 2; ++n) acc[a][b][m][n] = (f32x4){0.f, 0.f, 0.f, 0.f};
    bf16x8 At[4][2], B0[2][2], B1[2][2];
    const char* cA = cur.pa; const char* cB = cur.pb;
    PG8_STAGEB(PG8_SB(0, 0), cB, 0); PG8_STAGEB(PG8_SB(0, 1), cB, 1); PG8_STAGEA(PG8_SA(0, 0), cA, 0); PG8_STAGEA(PG8_SA(0, 1), cA, 1);
    if (wr == 1) PG8_BAR;
    PG8_WAIT_V(2); PG8_BAR;
    PG8_STAGEB(PG8_SB(1, 0), cB + kstep, 0); PG8_STAGEA(PG8_SA(1, 0), cA + kstep, 0); PG8_STAGEB(PG8_SB(1, 1), cB + kstep, 1);
    PG8_WAIT_V(6); PG8_BAR;
    for (;;) {
        const bool has_next = GATHER ? false : S.next(ui + 1, nxt);
        const char* nA = has_next ? nxt.pa : cA; const char* nB = has_next ? nxt.pb : cB;
        for (int t = 0; t < nt; t += 2) {
            const bool last = (t == nt - 2);
            const char* a1 = cA + (size_t)(t + 1) * kstep;
            const char* a2 = last ? nA : cA + (size_t)(t + 2) * kstep; const char* b2 = last ? nB : cB + (size_t)(t + 2) * kstep;
            const char* a3 = a2 + kstep; const char* b3 = b2 + kstep;
            PG8_LDB(B0, 0, 0); PG8_LDB(B1, 0, 1); PG8_SCHED; PG8_LDA(At, 0, 0); PG8_STAGEA(PG8_SA(1, 1), a1, 1);
            PG8_WAIT_V(8); PG8_WAIT_L(0); PG8_BAR; PG8_MMA(0, 0, At, B0); PG8_MMA(0, 1, At, B1); PG8_BAR; PG8_SCHED;
            PG8_LDA(At, 0, 1); PG8_STAGEB(PG8_SB(0, 0), b2, 0); PG8_STAGEB(PG8_SB(0, 1), b2, 1); PG8_STAGEA(PG8_SA(0, 0), a2, 0);
            PG8_WAIT_V(8); PG8_WAIT_L(0); PG8_BAR; PG8_MMA(1, 0, At, B0); PG8_MMA(1, 1, At, B1); PG8_BAR; PG8_SCHED;
            PG8_LDB(B0, 1, 0); PG8_LDB(B1, 1, 1); PG8_SCHED; PG8_LDA(At, 1, 0); PG8_STAGEA(PG8_SA(0, 1), a2, 1);
            PG8_WAIT_V(8); PG8_WAIT_L(0); PG8_BAR; PG8_MMA(0, 0, At, B0); PG8_MMA(0, 1, At, B1); PG8_BAR; PG8_SCHED;
            PG8_LDA(At, 1, 1); PG8_STAGEB(PG8_SB(1, 0), b3, 0); PG8_STAGEB(PG8_SB(1, 1), b3, 1); PG8_STAGEA(PG8_SA(1, 0), a3, 0);
            PG8_WAIT_V(8); PG8_WAIT_L(0); PG8_BAR; PG8_MMA(1, 0, At, B0); PG8_MMA(1, 1, At, B1); PG8_BAR; PG8_SCHED;
        }
        if constexpr (ALIGN_EPI) { if (wr == 0) PG8_BAR; }
        if constexpr (!Epi::AFTER_DRAIN) { E(acc, cur, wr, wc, fr, fq); }
        if (!has_next) break;
#pragma unroll
        for (int a = 0; a < 2; ++a)
#pragma unroll
            for (int b = 0; b < 2; ++b)
#pragma unroll
                for (int m = 0; m < 4; ++m)
#pragma unroll
                    for (int n = 0; n < 2; ++n) acc[a][b][m][n] = (f32x4){0.f, 0.f, 0.f, 0.f};
        cur = nxt; cA = nA; cB = nB; ++ui;
        if constexpr (ALIGN_EPI) { if (wr == 1) PG8_BAR; }
    }
    PG8_WAIT_V(0);
    if constexpr (!ALIGN_EPI) { if (wr == 0) PG8_BAR; }
    PG8_BAR;
    if constexpr (Epi::AFTER_DRAIN) { E.fused(acc, cur, wr, wc, fr, fq, lds, wid, lane); }
#undef PG8_SA
#undef PG8_SB
#undef PG8_STAGE
#undef PG8_STAGEA
#undef PG8_STAGEB
#undef PG8_LDA
#undef PG8_LDB
#undef PG8_MMA
#undef PG8_WAIT_V
#undef PG8_WAIT_L
#undef PG8_BAR
#undef PG8_SCHED
}

typedef const f32x4 (&AccC)[2][2][4][2];
typedef f32x4 (&AccM)[2][2][4][2];

struct EpiInProj {
    static constexpr bool PERM = true, AFTER_DRAIN = false;
    bf16_t* U; const float* cs;
    __device__ __forceinline__ void operator()(AccC acc, const Unit& u, int wr, int wc, int fr, int fq) const {
        const int row0 = u.pm * BM + wr * 64 + fr, col0 = u.pn * BM + wc * 32 + 8 * fq;
        const bool rot = (u.pn >= 2) && (u.pn < 6) && ((wc & 1) == 0) && (fq < 2);
        const float sc = (u.pn == 2 || u.pn == 3) ? QSCALE_D : 1.f;
#pragma unroll
        for (int ai = 0; ai < 2; ++ai)
#pragma unroll
            for (int m = 0; m < 4; ++m) {
                const int row = row0 + ai * HALF + m * 16;
                f32x4 c0 = (f32x4){1.f, 0.f, 1.f, 0.f}, c1 = (f32x4){1.f, 0.f, 1.f, 0.f};
                if (rot) { const f32x4* cp = (const f32x4*)(cs + (size_t)row * 16 + 8 * fq); c0 = cp[0]; c1 = cp[1]; }
                bf16_t* rowp = U + (size_t)row * INW + col0;
#pragma unroll
                for (int bj = 0; bj < 2; ++bj) {
                    f32x4 v0 = acc[ai][bj][m][0], v1 = acc[ai][bj][m][1];
                    f32x4 w0, w1;
                    w0[0] = v0[0] * c0[0] - v0[1] * c0[1]; w0[1] = v0[1] * c0[0] + v0[0] * c0[1];
                    w0[2] = v0[2] * c0[2] - v0[3] * c0[3]; w0[3] = v0[3] * c0[2] + v0[2] * c0[3];
                    w1[0] = v1[0] * c1[0] - v1[1] * c1[1]; w1[1] = v1[1] * c1[0] + v1[0] * c1[1];
                    w1[2] = v1[2] * c1[2] - v1[3] * c1[3]; w1[3] = v1[3] * c1[2] + v1[2] * c1[3];
                    w0 = w0 * sc; w1 = w1 * sc;
                    u32x4 w; w.x = cvt_pk_bf16(w0[0], w0[1]); w.y = cvt_pk_bf16(w0[2], w0[3]); w.z = cvt_pk_bf16(w1[0], w1[1]); w.w = cvt_pk_bf16(w1[2], w1[3]);
                    *(u32x4*)(rowp + bj * HALF) = w; }
            }
    }
};
struct EpiBf16 {
    static constexpr bool PERM = true, AFTER_DRAIN = false;
    bf16_t* O; int ldc; const LAS float* rs; float mul;
    __device__ __forceinline__ void operator()(AccC acc, const Unit& u, int wr, int wc, int fr, int fq) const {
        const int rt0 = wr * 64 + fr, col0 = u.pn * BM + wc * 32 + 8 * fq;
#pragma unroll
        for (int ai = 0; ai < 2; ++ai)
#pragma unroll
            for (int m = 0; m < 4; ++m) {
                const int rt = rt0 + ai * HALF + m * 16;
                const float s = rs ? rs[rt] * mul : mul;
                bf16_t* rowp = O + (size_t)(u.pm * BM + rt) * ldc + col0;
#pragma unroll
                for (int bj = 0; bj < 2; ++bj) { const f32x4 v0 = acc[ai][bj][m][0] * s, v1 = acc[ai][bj][m][1] * s;
                    u32x4 w; w.x = cvt_pk_bf16(v0[0], v0[1]); w.y = cvt_pk_bf16(v0[2], v0[3]); w.z = cvt_pk_bf16(v1[0], v1[1]); w.w = cvt_pk_bf16(v1[2], v1[3]);
                    *(u32x4*)(rowp + bj * HALF) = w; }
            }
    }
};
struct EpiRes {
    static constexpr bool PERM = false, AFTER_DRAIN = false;
    const float* resid; float* xo; bf16_t* xb; float* ssp;
    __device__ __forceinline__ void operator()(AccC acc, const Unit& u, int wr, int wc, int fr, int fq) const {
        const int row0 = u.pm * BM + wr * 64 + fr, col0 = u.pn * BM + wc * 32 + 4 * fq;
#pragma unroll
        for (int ai = 0; ai < 2; ++ai)
#pragma unroll
            for (int m = 0; m < 4; ++m) {
                const int row = row0 + ai * HALF + m * 16; const size_t off = (size_t)row * D + col0; float ss = 0.f;
#pragma unroll
                for (int bj = 0; bj < 2; ++bj)
#pragma unroll
                    for (int n = 0; n < 2; ++n) { const size_t o2 = off + bj * HALF + n * 16; const f32x4 v = *(const f32x4*)(resid + o2) + acc[ai][bj][m][n];
                        *(f32x4*)(xo + o2) = v; ss += (v[0] * v[0] + v[1] * v[1]) + (v[2] * v[2] + v[3] * v[3]);
                        u32x2 w; w.x = cvt_pk_bf16(v[0], v[1]); w.y = cvt_pk_bf16(v[2], v[3]); *(u32x2*)(xb + o2) = w; }
                if (ssp) { ss += __shfl_xor(ss, 16); ss += __shfl_xor(ss, 32); if (fq == 0) ssp[(size_t)(u.pn * 4 + wc) * T + row] = ss; }
            }
    }
};
struct EpiSoftmax {
    static constexpr bool PERM = true, AFTER_DRAIN = true;
    bf16_t* O; int ldc;
    __device__ __forceinline__ void fused(AccM acc, const Unit& u, int wr, int wc, int fr, int fq, LAS unsigned char* lds, int wid, int lane) const {
        LAS float* PM = (LAS float*)lds; LAS float* PS = (LAS float*)(lds + 4096);
#pragma unroll
        for (int ai = 0; ai < 2; ++ai)
#pragma unroll
            for (int m = 0; m < 4; ++m) { float v = -INFINITY;
#pragma unroll
                for (int bj = 0; bj < 2; ++bj)
#pragma unroll
                    for (int n = 0; n < 2; ++n) { const f32x4 x = acc[ai][bj][m][n]; v = fmaxf(v, fmaxf(fmaxf(x[0], x[1]), fmaxf(x[2], x[3]))); }
                v = fmaxf(v, __shfl_xor(v, 16)); v = fmaxf(v, __shfl_xor(v, 32));
                if (fq == 0) PM[(ai * HALF + wr * 64 + m * 16 + fr) * 4 + wc] = v; }
        LDS_WAIT(); __builtin_amdgcn_s_barrier(); asm volatile("" ::: "memory");
#pragma unroll
        for (int ai = 0; ai < 2; ++ai)
#pragma unroll
            for (int m = 0; m < 4; ++m) { const int rt = ai * HALF + wr * 64 + m * 16 + fr; const f32x4 q = *(const LAS f32x4*)(PM + rt * 4);
                const float mx = fmaxf(fmaxf(q[0], q[1]), fmaxf(q[2], q[3])); float s = 0.f;
#pragma unroll
                for (int bj = 0; bj < 2; ++bj)
#pragma unroll
                    for (int n = 0; n < 2; ++n) { f32x4 x = acc[ai][bj][m][n];
                        x[0] = __builtin_amdgcn_exp2f(x[0] - mx); x[1] = __builtin_amdgcn_exp2f(x[1] - mx); x[2] = __builtin_amdgcn_exp2f(x[2] - mx); x[3] = __builtin_amdgcn_exp2f(x[3] - mx);
                        s += (x[0] + x[1]) + (x[2] + x[3]); acc[ai][bj][m][n] = x; }
                s += __shfl_xor(s, 16); s += __shfl_xor(s, 32);
                if (fq == 0) PS[rt * 4 + wc] = s; }
        LDS_WAIT(); __builtin_amdgcn_s_barrier(); asm volatile("" ::: "memory");
        const int col0 = u.pn * BM + wc * 32 + 8 * fq;
#pragma unroll
        for (int ai = 0; ai < 2; ++ai)
#pragma unroll
            for (int m = 0; m < 4; ++m) { const int rt = ai * HALF + wr * 64 + m * 16 + fr; const f32x4 q = *(const LAS f32x4*)(PS + rt * 4);
                const float inv = 1.0f / ((q[0] + q[1]) + (q[2] + q[3]));
                bf16_t* rowp = O + (size_t)(u.pm * BM + rt) * ldc + col0;
#pragma unroll
                for (int bj = 0; bj < 2; ++bj) { const f32x4 v0 = acc[ai][bj][m][0] * inv, v1 = acc[ai][bj][m][1] * inv;
                    u32x4 w; w.x = cvt_pk_bf16(v0[0], v0[1]); w.y = cvt_pk_bf16(v0[2], v0[3]); w.z = cvt_pk_bf16(v1[0], v1[1]); w.w = cvt_pk_bf16(v1[2], v1[3]);
                    *(u32x4*)(rowp + bj * HALF) = w; }
            }
        LDS_WAIT(); __builtin_amdgcn_s_barrier(); asm volatile("" ::: "memory");
    }
};
struct EpiSwiGLU {
    static constexpr bool PERM = true, AFTER_DRAIN = false;
    bf16_t* H; const float* bgu; const float* rstd; const int* toks; int hrow0;
    __device__ __forceinline__ void operator()(AccC acc, const Unit& u, int wr, int wc, int fr, int fq) const {
        const int rt0 = wr * 64 + fr, c0 = u.pn * HALF + wc * 32 + 8 * fq;
        f32x4 bg[2], bu[2];
#pragma unroll
        for (int n = 0; n < 2; ++n) { bg[n] = *(const f32x4*)(bgu + c0 + 4 * n); bu[n] = *(const f32x4*)(bgu + 1024 + c0 + 4 * n); }
#pragma unroll
        for (int ai = 0; ai < 2; ++ai)
#pragma unroll
            for (int m = 0; m < 4; ++m) {
                const int rt = rt0 + ai * HALF + m * 16;
                const int tok = (rt < u.nvalid) ? toks[rt] : 0; const float rs = rstd[tok];
                unsigned w[4];
#pragma unroll
                for (int n = 0; n < 2; ++n) { const f32x4 g4 = acc[ai][0][m][n] * rs + bg[n], u4 = acc[ai][1][m][n] * rs + bu[n]; float h[4];
#pragma unroll
                    for (int j = 0; j < 4; ++j) { const float g = fminf(g4[j], 7.0f), up = fminf(fmaxf(u4[j], -7.0f), 7.0f);
                        const float sg = __builtin_amdgcn_rcpf(1.0f + __builtin_amdgcn_exp2f(-1.702f * LOG2E * g)); h[j] = (up + 1.0f) * g * sg; }
                    w[2 * n] = cvt_pk_bf16(h[0], h[1]); w[2 * n + 1] = cvt_pk_bf16(h[2], h[3]); }
                *(u32x4*)(H + (size_t)(hrow0 + rt) * 1024 + c0) = (u32x4){w[0], w[1], w[2], w[3]};
            }
    }
};
struct EpiDown {
    static constexpr bool PERM = true, AFTER_DRAIN = false;
    bf16_t* Y; const float* bd; const float* gates; int hrow0;
    __device__ __forceinline__ void operator()(AccC acc, const Unit& u, int wr, int wc, int fr, int fq) const {
        const int rt0 = wr * 64 + fr, col0 = u.pn * BM + wc * 32 + 8 * fq;
        f32x4 bv[2][2];
#pragma unroll
        for (int bj = 0; bj < 2; ++bj)
#pragma unroll
            for (int n = 0; n < 2; ++n) bv[bj][n] = *(const f32x4*)(bd + col0 + bj * HALF + 4 * n);
#pragma unroll
        for (int ai = 0; ai < 2; ++ai)
#pragma unroll
            for (int m = 0; m < 4; ++m) {
                const int rt = rt0 + ai * HALF + m * 16;
                const float g = (rt < u.nvalid) ? gates[rt] : 0.f;
                bf16_t* rowp = Y + (size_t)(hrow0 + rt) * 1024 + col0;
#pragma unroll
                for (int bj = 0; bj < 2; ++bj) { const f32x4 v0 = (acc[ai][bj][m][0] + bv[bj][0]) * g, v1 = (acc[ai][bj][m][1] + bv[bj][1]) * g;
                    u32x4 w; w.x = cvt_pk_bf16(v0[0], v0[1]); w.y = cvt_pk_bf16(v0[2], v0[3]); w.z = cvt_pk_bf16(v1[0], v1[1]); w.w = cvt_pk_bf16(v1[2], v1[3]);
                    *(u32x4*)(rowp + bj * HALF) = w; }
            }
    }
};
}

struct Args {
    const float* x; const int* pos; const float* mem; const float* attn_g; const float* w_in; const float* w_pool; const float* pool_scale;
    const float* lq1; const float* lk1; const float* lq2; const float* lk2; const float* subln_g; const float* w_out; const float* xattn_g; const float* mem_g;
    const float* w_cq; const float* w_ckv; const float* w_co; const float* ffn_g; const float* w_router; const float* b_router; const float* w_gu; const float* b_gu;
    const float* w_down; const float* b_down; const float* final_g;
    float* out; unsigned char* ws; int ph_lo, ph_hi;
};

template <int MAP>
__device__ __forceinline__ int rowmap(int c) {
    if (MAP == 1) { if (c >= 512 && c < 1536) { const int d = c & 63; if (d < 16) return (c & ~63) + ((d < 8) ? 2 * d : 2 * (d - 8) + 1); } return c; }
    if (MAP == 2) { const int j = c & 1023; return ((j >> 7) << 8) + ((c >> 10) << 7) + (j & 127); }
    return c;
}
template <int MAP>
__device__ __forceinline__ void p0_transpose_stream(const float* W, int K, int N, int nmat, bf16_t* WT, int ldt, int kdst0, size_t dst_stride, const float* g, LAS float* scr, int gw, int NGW, int lane) {
    const int nblk = N / 32, ipm = (K / 64) * nblk, nitems = nmat * ipm;
    const int lr = lane >> 3, lc = (lane & 7) * 4;
    f32x4 cur[8], nxt[8];
#define P0_LOAD(dst, it) do { const int e_ = (it) / ipm, r_ = (it) % ipm, kb_ = r_ / nblk, nb_ = r_ % nblk; const float* p_ = W + ((size_t)e_ * K + 64 * kb_ + lr) * N + 32 * nb_ + lc; \
        _Pragma("unroll") for (int i_ = 0; i_ < 8; ++i_) dst[i_] = *(const f32x4*)(p_ + (size_t)(8 * i_) * N); } while (0)
    int it = gw;
    if (it < nitems) P0_LOAD(cur, it);
    while (it < nitems) {
        const int itn = it + NGW;
        if (itn < nitems) P0_LOAD(nxt, itn);
        const int e = it / ipm, r = it % ipm, kb = r / nblk, nb = r % nblk, k0 = 64 * kb, n0 = 32 * nb;
#pragma unroll
        for (int i = 0; i < 8; ++i) { const int kk = 8 * i + lr; f32x4 v = cur[i]; if (g) v = v * g[k0 + kk];
            LAS float* s = scr + kk * 33 + lc; s[0] = v[0]; s[1] = v[1]; s[2] = v[2]; s[3] = v[3]; }
        LDS_WAIT(); asm volatile("" ::: "memory");
        const int c = lane & 7; bf16_t* wt = WT + (size_t)e * dst_stride;
#pragma unroll
        for (int j = 0; j < 4; ++j) { const int n = (lane >> 3) + 8 * j; const LAS float* s = scr + (8 * c) * 33 + n;
            u32x4 o; o.x = pk2(s[0 * 33], s[1 * 33]); o.y = pk2(s[2 * 33], s[3 * 33]); o.z = pk2(s[4 * 33], s[5 * 33]); o.w = pk2(s[6 * 33], s[7 * 33]);
            *(u32x4*)(wt + (size_t)rowmap<MAP>(n0 + n) * ldt + kdst0 + k0 + 8 * c) = o; }
        LDS_WAIT(); asm volatile("" ::: "memory");
#pragma unroll
        for (int i = 0; i < 8; ++i) cur[i] = nxt[i];
        it = itn;
    }
#undef P0_LOAD
}
__device__ __forceinline__ void rms_row_to_bf16(const float* xrow, const float* g, bf16_t* orow, int lane) {
    const f32x4* xr = (const f32x4*)xrow + lane; const f32x4* gr = (const f32x4*)g + lane;
    f32x4 v[4]; float s = 0.f;
#pragma unroll
    for (int j = 0; j < 4; ++j) { v[j] = xr[64 * j]; s += (v[j][0] * v[j][0] + v[j][1] * v[j][1]) + (v[j][2] * v[j][2] + v[j][3] * v[j][3]); }
    const float rstd = 1.0f / sqrtf(wave_sum(s) * (1.0f / D) + EPS);
    u32x2* o8 = (u32x2*)orow + lane;
#pragma unroll
    for (int j = 0; j < 4; ++j) { const f32x4 gg = gr[64 * j]; u32x2 w; w.x = pk2(v[j][0] * rstd * gg[0], v[j][1] * rstd * gg[1]); w.y = pk2(v[j][2] * rstd * gg[2], v[j][3] * rstd * gg[3]); o8[64 * j] = w; }
}

namespace dattn {
constexpr int KP = 144, VP = 320;
constexpr int K_BYTES = 2 * 64 * KP, V_BYTES = 64 * VP, STG = K_BYTES + V_BYTES;
__device__ __forceinline__ s16x4 vtr(const LAS unsigned char* p) { typedef short v4i16_t __attribute__((ext_vector_type(4))); return __builtin_bit_cast(s16x4, __builtin_amdgcn_ds_read_tr16_b64_v4i16((LAS v4i16_t*)p)); }
__device__ __forceinline__ void unit(LAS unsigned char* lds, const bf16_t* U, bf16_t* CAT, const float* subln_g, float lam, int b, int hh, int j) {
    int tid_ = threadIdx.x; asm volatile("" : "+v"(tid_));
    const int tid = tid_, lane = tid & 63, r32 = lane & 31, hi = lane >> 5; const int wid = __builtin_amdgcn_readfirstlane(tid >> 6);
    const int mp = wid & 1, rg = wid >> 1;
    const size_t tok0 = (size_t)b * SEQ;
    const int q0 = j * 128 + rg * 32;
    const int nt_all = 2 * j + 2, nt_mine = (rg < 2) ? nt_all - 1 : nt_all;
    bf16x8 qf[4];
    { const bf16_t* qp = U + (tok0 + q0 + r32) * INW + 512 + hh * 128 + mp * 64 + hi * 8;
#pragma unroll
      for (int ks = 0; ks < 4; ++ks) qf[ks] = *(const bf16x8*)(qp + ks * 16); }
    const int prow = tid >> 3, pc0 = (tid & 7) * 2;
    const bf16_t* kg = U + (tok0 + prow) * INW + 1024 + hh * 128 + pc0 * 8;
    const bf16_t* vg = U + (tok0 + prow) * INW + 1536 + hh * 128 + pc0 * 8;
    unsigned kdst[2], vdst[2];
#pragma unroll
    for (int i = 0; i < 2; ++i) { const int c16 = pc0 + i; kdst[i] = (unsigned)((c16 >> 3) * (64 * KP) + prow * KP + (c16 & 7) * 16); vdst[i] = (unsigned)(K_BYTES + prow * VP + c16 * 16); }
    u32x4 kr[2], vr[2];
#define DA_LOAD(t) do { const size_t go = (size_t)(t) * 64 * INW; kr[0] = *(const u32x4*)(kg + go); kr[1] = *(const u32x4*)(kg + go + 8); vr[0] = *(const u32x4*)(vg + go); vr[1] = *(const u32x4*)(vg + go + 8); } while (0)
#define DA_WRITE(s) do { LAS unsigned char* sb = lds + (s) * STG; *(LAS u32x4*)(sb + kdst[0]) = kr[0]; *(LAS u32x4*)(sb + kdst[1]) = kr[1]; *(LAS u32x4*)(sb + vdst[0]) = vr[0]; *(LAS u32x4*)(sb + vdst[1]) = vr[1]; } while (0)
    f32x16 o[4];
#pragma unroll
    for (int d0 = 0; d0 < 4; ++d0)
#pragma unroll
        for (int r = 0; r < 16; ++r) o[d0][r] = 0.f;
    float mrun = -INFINITY, lrun = 0.f;
    const int i16 = lane & 15, g16 = (lane >> 4) & 1;
    const unsigned kbase = (unsigned)(mp * (64 * KP) + r32 * KP + hi * 16);
    const unsigned vbase = (unsigned)(K_BYTES + (4 * hi + (i16 >> 2)) * VP + (16 * g16 + 4 * (i16 & 3)) * 2);
    DA_LOAD(0); DA_WRITE(0);
    __syncthreads();
    for (int kt = 0; kt < nt_all; ++kt) {
        const bool more = (kt + 1 < nt_all);
        if (more) DA_LOAD(kt + 1);
        if (kt < nt_mine) {
            const LAS unsigned char* sb = lds + (kt & 1) * STG;
            f32x16 p0, p1;
#pragma unroll
            for (int r = 0; r < 16; ++r) { p0[r] = 0.f; p1[r] = 0.f; }
#pragma unroll
            for (int ks = 0; ks < 4; ++ks) {
                const bf16x8 k0 = *(const LAS bf16x8*)(sb + kbase + ks * 32), k1 = *(const LAS bf16x8*)(sb + kbase + 32 * KP + ks * 32);
                p0 = __builtin_amdgcn_mfma_f32_32x32x16_bf16(k0, qf[ks], p0, 0, 0, 0);
                p1 = __builtin_amdgcn_mfma_f32_32x32x16_bf16(k1, qf[ks], p1, 0, 0, 0);
            }
            float mx = fmaxf(p0[0], p1[0]);
#pragma unroll
            for (int r = 1; r < 16; ++r) mx = fmaxf(mx, fmaxf(p0[r], p1[r]));
            mx = fmaxf(mx, __shfl_xor(mx, 32));
            const float mnew = fmaxf(mrun, mx), alpha = __builtin_amdgcn_exp2f(mrun - mnew); mrun = mnew;
            float ls = 0.f;
#pragma unroll
            for (int r = 0; r < 16; ++r) { p0[r] = __builtin_amdgcn_exp2f(p0[r] - mnew); p1[r] = __builtin_amdgcn_exp2f(p1[r] - mnew); ls += p0[r] + p1[r]; }
            lrun = lrun * alpha + ls;
#pragma unroll
            for (int d0 = 0; d0 < 4; ++d0)
#pragma unroll
                for (int r = 0; r < 16; ++r) o[d0][r] *= alpha;
            bf16x8 pf[4];
#pragma unroll
            for (int s = 0; s < 4; ++s) { u32x4 w;
                if (s < 2) { w.x = cvt_pk_bf16(p0[8 * s + 0], p0[8 * s + 1]); w.y = cvt_pk_bf16(p0[8 * s + 2], p0[8 * s + 3]); w.z = cvt_pk_bf16(p0[8 * s + 4], p0[8 * s + 5]); w.w = cvt_pk_bf16(p0[8 * s + 6], p0[8 * s + 7]); }
                else { const int s2 = s - 2; w.x = cvt_pk_bf16(p1[8 * s2 + 0], p1[8 * s2 + 1]); w.y = cvt_pk_bf16(p1[8 * s2 + 2], p1[8 * s2 + 3]); w.z = cvt_pk_bf16(p1[8 * s2 + 4], p1[8 * s2 + 5]); w.w = cvt_pk_bf16(p1[8 * s2 + 6], p1[8 * s2 + 7]); }
                pf[s] = __builtin_bit_cast(bf16x8, w); }
#pragma unroll
            for (int d0 = 0; d0 < 4; ++d0)
#pragma unroll
                for (int s = 0; s < 4; ++s) {
                    const s16x4 lo = vtr(sb + vbase + s * 16 * VP + d0 * 64), hv = vtr(sb + vbase + s * 16 * VP + 8 * VP + d0 * 64);
                    const bf16x8 vf = (bf16x8){lo[0], lo[1], lo[2], lo[3], hv[0], hv[1], hv[2], hv[3]};
                    o[d0] = __builtin_amdgcn_mfma_f32_32x32x16_bf16(vf, pf[s], o[d0], 0, 0, 0);
                }
        }
        if (more) DA_WRITE((kt + 1) & 1);
        __syncthreads();
    }
#undef DA_LOAD
#undef DA_WRITE
    const float ltot = lrun + __shfl_xor(lrun, 32), inv = 1.0f / ltot;
    LAS float* X = (LAS float*)lds + rg * 4096;
    if (mp == 1) {
#pragma unroll
        for (int d0 = 0; d0 < 4; ++d0)
#pragma unroll
            for (int r = 0; r < 16; ++r) { const int dv = 32 * d0 + (r & 3) + 8 * (r >> 2) + 4 * hi; X[dv * 32 + r32] = o[d0][r] * inv; }
    }
    __syncthreads();
    if (mp == 0) {
        float ss = 0.f;
#pragma unroll
        for (int d0 = 0; d0 < 4; ++d0)
#pragma unroll
            for (int r = 0; r < 16; ++r) { const int dv = 32 * d0 + (r & 3) + 8 * (r >> 2) + 4 * hi; const float v = o[d0][r] * inv - lam * X[dv * 32 + r32]; o[d0][r] = v; ss += v * v; }
        ss += __shfl_xor(ss, 32);
        const float rstd = 0.8f / sqrtf(ss * (1.0f / 128.0f) + EPS);
        bf16_t* op = CAT + (tok0 + q0 + r32) * D + 512 + hh * 128;
#pragma unroll
        for (int d0 = 0; d0 < 4; ++d0)
#pragma unroll
            for (int r4 = 0; r4 < 4; ++r4) { const int dv = 32 * d0 + 8 * r4 + 4 * hi; const f32x4 gg = *(const f32x4*)(subln_g + dv);
                u32x2 w; w.x = cvt_pk_bf16(o[d0][4 * r4 + 0] * rstd * gg[0], o[d0][4 * r4 + 1] * rstd * gg[1]); w.y = cvt_pk_bf16(o[d0][4 * r4 + 2] * rstd * gg[2], o[d0][4 * r4 + 3] * rstd * gg[3]);
                *(u32x2*)(op + dv) = w; }
    }
    __syncthreads();
}
}

typedef const __attribute__((address_space(4))) Args* KArgsP;
__device__ __forceinline__ KArgsP kargs() { KArgsP p = (KArgsP)__builtin_amdgcn_kernarg_segment_ptr(); asm volatile("" : "+s"(p)); return p; }
#define PH_PTRS() KArgsP ap = kargs(); unsigned char* ws = ap->ws; (void)ws; int tid = threadIdx.x; asm volatile("" : "+v"(tid)); const int lane = tid & 63; (void)lane; \
    float* cs = (float*)(ws + WS_CS); float* ssp = (float*)(ws + WS_SSP); float* rstd2 = (float*)(ws + WS_RSTD2); \
    int* tokslot = (int*)(ws + WS_TOKSLOT); int* ltok = (int*)(ws + WS_LTOK); float* lgate = (float*)(ws + WS_LGATE); \
    bf16_t* Win_t = (bf16_t*)(ws + WS_WIN); bf16_t* Wout_t = (bf16_t*)(ws + WS_WOUT); bf16_t* Wcq_t = (bf16_t*)(ws + WS_WCQ); bf16_t* Wckv_t = (bf16_t*)(ws + WS_WCKV); \
    bf16_t* Wco_t = (bf16_t*)(ws + WS_WCO); bf16_t* Wgu_t = (bf16_t*)(ws + WS_WGU); bf16_t* Wdn_t = (bf16_t*)(ws + WS_WDN); \
    bf16_t* H0 = (bf16_t*)(ws + WS_H0); bf16_t* MEMN = (bf16_t*)(ws + WS_MEMN); bf16_t* KC = (bf16_t*)(ws + WS_KC); bf16_t* VT = (bf16_t*)(ws + WS_VT); \
    bf16_t* U = (bf16_t*)(ws + WS_U); bf16_t* CAT = (bf16_t*)(ws + WS_CAT); float* X1 = (float*)(ws + WS_X1); bf16_t* X1B = (bf16_t*)(ws + WS_X1B); \
    bf16_t* QC = (bf16_t*)(ws + WS_QC); bf16_t* PC = (bf16_t*)(ws + WS_PC); bf16_t* OC = (bf16_t*)(ws + WS_OC); float* X2 = (float*)(ws + WS_X2); bf16_t* X2B = (bf16_t*)(ws + WS_X2B); \
    bf16_t* HID = (bf16_t*)(ws + WS_HID); bf16_t* YR = (bf16_t*)(ws + WS_Y); \
    (void)cs; (void)ssp; (void)rstd2; (void)tokslot; (void)ltok; (void)lgate; (void)Win_t; (void)Wout_t; (void)Wcq_t; (void)Wckv_t; (void)Wco_t; (void)Wgu_t; (void)Wdn_t; (void)H0; (void)MEMN; (void)KC; (void)VT; \
    (void)U; (void)CAT; (void)X1; (void)X1B; (void)QC; (void)PC; (void)OC; (void)X2; (void)X2B; (void)HID; (void)YR

constexpr int NWAVES = 8;
constexpr int N_PHASES = 10;

__global__ void __launch_bounds__(NWAVES * 64, 2) fwd_kernel(Args a) {
    extern __shared__ __attribute__((aligned(16))) unsigned char lds_raw[];
    LAS unsigned char* lds = (LAS unsigned char*)lds_raw;
    const int tid = threadIdx.x, lane = tid & 63, wave = __builtin_amdgcn_readfirstlane(tid >> 6);
    const int G = gridDim.x, bx = blockIdx.x;
    const int gw = bx * NWAVES + wave, NGW = G * NWAVES;
    unsigned* ctl; { unsigned char* ws0 = a.ws; ctl = (unsigned*)(ws0 + WS_CTL); }
    volatile LAS unsigned* MISC = (volatile LAS unsigned*)(lds + MISC_OFF);
    for (int u = tid; u < (LDS_BYTES - MISC_OFF) / 4; u += NWAVES * 64) ((LAS unsigned*)(lds + MISC_OFF))[u] = 0u;
    __syncthreads();
    XcdBarrier bar; bar.bar = ctl + CW_BAR; bar.x = 0; bar.st = nullptr;
    if (MK_N_LAUNCHES == 1) bar = xcd_barrier_post(ctl + CW_BAR, MISC + 8);
    const int lo = a.ph_lo, hi = a.ph_hi;
#define IN(k) (((PMASK >> (k)) & 1) && lo <= (k) && (k) < hi)
#define SEAM(k) do { if (IN(k) && IN((k) + 1)) xcd_barrier(bar); } while (0)

    if (IN(0)) for (int rep_ = 0; rep_ < REPS(0); ++rep_) { PH_PTRS();
        LAS float* scr = (LAS float*)(lds + wave * 16384);
        p0_transpose_stream<2>(ap->w_gu, 1024, 2048, NE, Wgu_t, 1024, 0, (size_t)2048 * 1024, ap->ffn_g, scr, gw, NGW, lane);
        p0_transpose_stream<0>(ap->w_down, 1024, 1024, NE, Wdn_t, 1024, 0, (size_t)1024 * 1024, nullptr, scr, gw, NGW, lane);
        p0_transpose_stream<1>(ap->w_in, 1024, 2048, 1, Win_t, 1024, 0, 0, nullptr, scr, gw, NGW, lane);
        p0_transpose_stream<0>(ap->w_out + (size_t)512 * 1024, 512, 1024, 1, Wout_t, 1024, 512, 0, nullptr, scr, gw, NGW, lane);
        p0_transpose_stream<0>(ap->w_cq, 1024, 1024, 1, Wcq_t, 1024, 0, 0, ap->xattn_g, scr, gw, NGW, lane);
        p0_transpose_stream<0>(ap->w_ckv, 1024, 2048, 1, Wckv_t, 1024, 0, 0, nullptr, scr, gw, NGW, lane);
        p0_transpose_stream<0>(ap->w_co, 1024, 1024, 1, Wco_t, 1024, 0, 0, nullptr, scr, gw, NGW, lane);
        constexpr int I_WEFF = 1024, I_XR = T, I_MR = NMEM, I_ROPE = T * 8 / 64;
        constexpr int NITEMS = I_WEFF + I_XR + I_MR + I_ROPE;
        for (int it = gw; it < NITEMS; it += NGW) {
            int r = it;
            if (r < I_WEFF) {
                const int nb = r & 15, cb = r >> 4, n = nb * 64 + lane, kk0 = cb * 8, g = kk0 >> 7;
                float accv[8];
#pragma unroll
                for (int q = 0; q < 8; ++q) accv[q] = 0.f;
#pragma unroll 8
                for (int d = 0; d < 128; ++d) { const float wo = ap->w_out[(size_t)(g * 128 + d) * 1024 + n] * ap->pool_scale[g * 128 + d];
#pragma unroll
                    for (int q = 0; q < 8; ++q) accv[q] += ap->w_pool[(size_t)(kk0 + q) * 128 + d] * wo; }
                u32x4 o4; o4.x = pk2(accv[0], accv[1]); o4.y = pk2(accv[2], accv[3]); o4.z = pk2(accv[4], accv[5]); o4.w = pk2(accv[6], accv[7]);
                *(u32x4*)(Wout_t + (size_t)n * 1024 + kk0) = o4; continue; } r -= I_WEFF;
            if (r < I_XR) { rms_row_to_bf16(ap->x + (size_t)r * D, ap->attn_g, H0 + (size_t)r * D, lane); continue; } r -= I_XR;
            if (r < I_MR) { rms_row_to_bf16(ap->mem + (size_t)r * D, ap->mem_g, MEMN + (size_t)r * D, lane); continue; } r -= I_MR;
            {
                const int idx = r * 64 + lane, t = idx >> 3, i = idx & 7;
                const double inv_freq = exp2(-(double)i * (18.931568569324174 / 8.0));
                const double rev = (double)ap->pos[t] * inv_freq * 0.15915494309189535;
                const float fr = (float)(rev - floor(rev));
                cs[(size_t)idx * 2] = __builtin_amdgcn_cosf(fr); cs[(size_t)idx * 2 + 1] = __builtin_amdgcn_sinf(fr);
            }
        }
    }
    SEAM(0);

    if (IN(1)) for (int rep_ = 0; rep_ < REPS(1); ++rep_) { PH_PTRS();
        { pg8::StaticOrder S; S.init(H0, Win_t, T, INW, D, D, G, bx); pg8::EpiInProj E{U, cs};
          pg8::gemm_phase<pg8::EpiInProj, pg8::StaticOrder, true, false>(lds, D, D, D, S, E); }
        { pg8::StaticOrder S; S.init(MEMN, Wckv_t, NMEM, 1024, D, D, G, bx); pg8::EpiBf16 E{KC, 1024, nullptr, 1.0f};
          pg8::gemm_phase<pg8::EpiBf16, pg8::StaticOrder, true, false>(lds, D, D, D, S, E); }
        { pg8::StaticOrder S; S.init(Wckv_t + (size_t)1024 * 1024, MEMN, 1024, NMEM, D, D, G, (bx + 32) % G); pg8::EpiBf16 E{VT, NMEM, nullptr, 1.0f};
          pg8::gemm_phase<pg8::EpiBf16, pg8::StaticOrder, true, false>(lds, D, D, D, S, E); }
    }
    SEAM(1);

    if (IN(2)) for (int rep_ = 0; rep_ < REPS(2); ++rep_) { PH_PTRS();
        float d1 = (lane < 64) ? ap->lq1[lane] * ap->lk1[lane] : 0.f, d2 = ap->lq2[lane] * ap->lk2[lane];
        d1 = wave_sum(d1); d2 = wave_sum(d2);
        const float lam = expf(d1) - expf(d2) + 0.2f;
        for (int un = bx; un < 256; un += G) {
            const int bh = un >> 3, jp = un & 7;
            dattn::unit(lds, U, CAT, ap->subln_g, lam, bh >> 2, bh & 3, jp);
            dattn::unit(lds, U, CAT, ap->subln_g, lam, bh >> 2, bh & 3, 15 - jp);
        }
        for (int it = gw; it < T / 8; it += NGW) {
            const int b = it >> 8, t0 = (it & 255) * 8, wnd = 2 << (lane >> 4);
            const bf16_t* up = U + (size_t)b * SEQ * INW + lane * 8;
#pragma unroll 1
            for (int tt = 0; tt < 8; ++tt) { const int t = t0 + tt; float s[8], c[8];
#pragma unroll
                for (int q = 0; q < 8; ++q) s[q] = 0.f;
                for (int jj = 0; jj < 16; ++jj) { if (jj < wnd && jj <= t) { const bf16x8 v = *(const bf16x8*)(up + (size_t)(t - jj) * INW);
#pragma unroll
                        for (int q = 0; q < 8; ++q) { const float f = bf2f((unsigned short)v[q]); s[q] += f; if (jj == 0) c[q] = f; } } }
                const float ic = 1.0f / (float)((t + 1 < wnd) ? t + 1 : wnd);
                u32x4 o4; o4.x = pk2(s[0] * ic - c[0], s[1] * ic - c[1]); o4.y = pk2(s[2] * ic - c[2], s[3] * ic - c[3]); o4.z = pk2(s[4] * ic - c[4], s[5] * ic - c[5]); o4.w = pk2(s[6] * ic - c[6], s[7] * ic - c[7]);
                *(u32x4*)(CAT + ((size_t)b * SEQ + t) * D + lane * 8) = o4; }
        }
    }
    SEAM(2);

    if (IN(3)) for (int rep_ = 0; rep_ < REPS(3); ++rep_) { PH_PTRS();
        pg8::StaticOrder S; S.init(CAT, Wout_t, T, D, D, D, G, bx); pg8::EpiRes E{ap->x, X1, X1B, ssp};
        pg8::gemm_phase<pg8::EpiRes, pg8::StaticOrder, true, false>(lds, D, D, D, S, E);
    }
    SEAM(3);

    if (IN(4)) for (int rep_ = 0; rep_ < REPS(4); ++rep_) { PH_PTRS();
        LAS float* rs = (LAS float*)(lds + XTAB_OFF);
        for (int un = bx; un < 256; un += G) {
            const int pm = un >> 2, h = un & 3, b = pm >> 3;
            if (tid < 256) { const int row = pm * 256 + tid; float s = 0.f;
#pragma unroll
                for (int p = 0; p < 16; ++p) s += ssp[(size_t)p * T + row];
                rs[tid] = 1.0f / sqrtf(s * (1.0f / D) + EPS); }
            __syncthreads();
            { pg8::SingleUnit S; S.u = pg8::Unit{pm, h, 0, 256, (const char*)(X1B + (size_t)pm * 256 * D), (const char*)(Wcq_t + (size_t)h * 256 * D)};
              pg8::EpiBf16 E{QC, D, rs, QSCALE_X};
              pg8::gemm_phase<pg8::EpiBf16, pg8::SingleUnit, false, false>(lds, D, D, D, S, E); }
            wg_global_sync();
            { pg8::SingleUnit S; S.u = pg8::Unit{pm, h, 0, 256, (const char*)(QC + (size_t)pm * 256 * D + h * 256), (const char*)(KC + (size_t)b * 256 * D + h * 256)};
              pg8::EpiSoftmax E{PC, D};
              pg8::gemm_phase<pg8::EpiSoftmax, pg8::SingleUnit, false, false>(lds, 256, D, D, S, E); }
            wg_global_sync();
            { pg8::SingleUnit S; S.u = pg8::Unit{pm, h, 0, 256, (const char*)(PC + (size_t)pm * 256 * D + h * 256), (const char*)(VT + (size_t)h * 256 * NMEM + b * 256)};
              pg8::EpiBf16 E{OC, D, nullptr, 1.0f};
              pg8::gemm_phase<pg8::EpiBf16, pg8::SingleUnit, false, false>(lds, 256, D, NMEM, S, E); }
            __syncthreads();
        }
    }
    SEAM(4);

    if (IN(5)) for (int rep_ = 0; rep_ < REPS(5); ++rep_) { PH_PTRS();
        pg8::StaticOrder S; S.init(OC, Wco_t, T, D, D, D, G, bx); pg8::EpiRes E{X1, X2, X2B, nullptr};
        pg8::gemm_phase<pg8::EpiRes, pg8::StaticOrder, true, false>(lds, D, D, D, S, E);
    }
    SEAM(5);

    if (IN(6)) for (int rep_ = 0; rep_ < REPS(6); ++rep_) { PH_PTRS();
        LAS float* WR = (LAS float*)lds;
        LAS int* lcnt = (LAS int*)(lds + RT_OFF);
        LAS int* sel = (LAS int*)(lds + RT_OFF + 512);
        LAS float* selg = (LAS float*)(lds + RT_OFF + 512 + 1024);
        const int wave_ = __builtin_amdgcn_readfirstlane(tid >> 6);
        for (int tb = bx; tb < T / 64; tb += G) {
            for (int i = tid; i < 8192; i += NWAVES * 64) { const f32x4 w = ((const f32x4*)ap->w_router)[i]; *(LAS f32x4*)(WR + 4 * i) = w * ap->ffn_g[i >> 3]; }
            if (tid < 32) lcnt[tid] = 0;
            __syncthreads();
            const int tile = wave_ >> 2, kq = wave_ & 3, r32 = lane & 31, h = lane >> 5;
            const float* xp = X2 + (size_t)(tb * 64 + tile * 32 + r32) * D + kq * 256 + 32 * h;
            f32x16 accr;
#pragma unroll
            for (int r = 0; r < 16; ++r) accr[r] = 0.f;
            float ss = 0.f;
#pragma unroll 1
            for (int S = 0; S < 4; ++S) {
                f32x4 xv[8];
#pragma unroll
                for (int q = 0; q < 8; ++q) xv[q] = *(const f32x4*)(xp + 64 * S + 4 * q);
                const LAS float* wp = WR + (kq * 256 + 64 * S + 32 * h) * 32 + r32;
#pragma unroll
                for (int s = 0; s < 32; ++s) { const float av = xv[s >> 2][s & 3]; accr = __builtin_amdgcn_mfma_f32_32x32x2f32(av, wp[s * 32], accr, 0, 0, 0); ss += av * av; }
            }
            ss += __shfl_xor(ss, 32);
            __syncthreads();
            LAS float* PT = (LAS float*)lds + wave_ * (32 * 33);
            LAS float* PSS = (LAS float*)lds + 8 * 32 * 33;
#pragma unroll
            for (int r = 0; r < 16; ++r) PT[((r & 3) + 8 * (r >> 2) + 4 * h) * 33 + r32] = accr[r];
            if (h == 0) PSS[wave_ * 32 + r32] = ss;
            __syncthreads();
            if (tid < 64) {
                const int tl = tid & 31, tok = tb * 64 + tid; const LAS float* p0 = (LAS float*)lds + ((tid >> 5) * 4) * (32 * 33) + tl * 33; const LAS float* q0 = PSS + (tid >> 5) * 128 + tl;
                const float sq = (q0[0] + q0[32]) + (q0[64] + q0[96]);
                const float rstd = 1.0f / sqrtf(sq * (1.0f / D) + EPS);
                rstd2[tok] = rstd;
                float b0 = -INFINITY, b1 = -INFINITY, b2 = -INFINITY, b3 = -INFINITY; int i0 = 0, i1 = 0, i2 = 0, i3 = 0;
                for (int e = 0; e < 32; ++e) {
                    const float lg = ((p0[e] + p0[32 * 33 + e]) + (p0[2 * 32 * 33 + e] + p0[3 * 32 * 33 + e])) * rstd + ap->b_router[e];
                    if (lg > b3) { b3 = lg; i3 = e;
                        if (b3 > b2) { const float tf = b2; b2 = b3; b3 = tf; const int ti = i2; i2 = i3; i3 = ti; }
                        if (b2 > b1) { const float tf = b1; b1 = b2; b2 = tf; const int ti = i1; i1 = i2; i2 = ti; }
                        if (b1 > b0) { const float tf = b0; b0 = b1; b1 = tf; const int ti = i0; i0 = i1; i1 = ti; } }
                }
                const float e1 = expf(b1 - b0), e2 = expf(b2 - b0), e3 = expf(b3 - b0), isum = 1.0f / (1.0f + e1 + e2 + e3);
                int lr;
                lr = atomicAdd((int*)&lcnt[i0], 1); sel[tid * 4 + 0] = (i0 << 16) | lr; selg[tid * 4 + 0] = isum;
                lr = atomicAdd((int*)&lcnt[i1], 1); sel[tid * 4 + 1] = (i1 << 16) | lr; selg[tid * 4 + 1] = e1 * isum;
                lr = atomicAdd((int*)&lcnt[i2], 1); sel[tid * 4 + 2] = (i2 << 16) | lr; selg[tid * 4 + 2] = e2 * isum;
                lr = atomicAdd((int*)&lcnt[i3], 1); sel[tid * 4 + 3] = (i3 << 16) | lr; selg[tid * 4 + 3] = e3 * isum;
            }
            __syncthreads();
            if (tid < 32) { const int c = lcnt[tid]; lcnt[32 + tid] = (c > 0) ? (int)atomicAdd(ctl + CW_CNT + tid, (unsigned)c) : 0; }
            __syncthreads();
            if (tid < 256) { const int tl = tid >> 2, tok = tb * 64 + tl, sv = sel[tid], ee = sv >> 16, pos = lcnt[32 + ee] + (sv & 0xffff);
                ltok[ee * CAP + pos] = tok; lgate[ee * CAP + pos] = selg[tid]; tokslot[tok * 4 + (tid & 3)] = (ee << 16) | pos; }
            __syncthreads();
        }
    }
    SEAM(6);

    LAS int* ecnt = (LAS int*)(lds + ECNT_OFF);
    LAS int* etp = (LAS int*)(lds + ECNT_OFF + 128);
    if (IN(7) || IN(8) || IN(9)) {
        __syncthreads();
        if (tid == 0) { int acc = 0; for (int e = 0; e < NE; ++e) { const int c = (int)__hip_atomic_load(ctl + CW_CNT + e, __ATOMIC_RELAXED, __HIP_MEMORY_SCOPE_AGENT); ecnt[e] = c; etp[e] = acc; acc += (c + 255) >> 8; } etp[NE] = acc; }
        __syncthreads();
    }

    if (IN(7)) for (int rep_ = 0; rep_ < REPS(7); ++rep_) { PH_PTRS();
        const int ntile = etp[NE], nunits = ntile * 8;
        for (int L = bx; L < nunits; L += G) {
            int e = 0; while (e < NE - 1 && L >= etp[e + 1] * 8) ++e;
            const int rem = L - etp[e] * 8, nrt = etp[e + 1] - etp[e], pn = rem / nrt, r = rem % nrt;
            const int nvalid = min(256, ecnt[e] - r * 256), hrow0 = (etp[e] + r) * 256;
            pg8::GatherUnit S; S.u = pg8::Unit{0, pn, e, nvalid, (const char*)X2B, (const char*)(Wgu_t + ((size_t)e * 2048 + (size_t)pn * 256) * 1024)};
            S.toks = ltok + e * CAP + r * 256; S.rowbytes = D * 2;
            pg8::EpiSwiGLU E{HID, ap->b_gu + (size_t)e * 2048, rstd2, ltok + e * CAP + r * 256, hrow0};
            pg8::gemm_phase<pg8::EpiSwiGLU, pg8::GatherUnit, false, true>(lds, D, D, D, S, E);
            __syncthreads();
        }
    }
    SEAM(7);

    if (IN(8)) for (int rep_ = 0; rep_ < REPS(8); ++rep_) { PH_PTRS();
        const int ntile = etp[NE], nunits = ntile * 4;
        for (int L = bx; L < nunits; L += G) {
            int e = 0; while (e < NE - 1 && L >= etp[e + 1] * 4) ++e;
            const int rem = L - etp[e] * 4, nrt = etp[e + 1] - etp[e], pn = rem / nrt, r = rem % nrt;
            const int nvalid = min(256, ecnt[e] - r * 256), hrow0 = (etp[e] + r) * 256;
            pg8::SingleUnit S; S.u = pg8::Unit{0, pn, e, nvalid, (const char*)(HID + (size_t)hrow0 * 1024), (const char*)(Wdn_t + ((size_t)e * 1024 + (size_t)pn * 256) * 1024)};
            pg8::EpiDown E{YR, ap->b_down + (size_t)e * 1024, lgate + e * CAP + r * 256, hrow0};
            pg8::gemm_phase<pg8::EpiDown, pg8::SingleUnit, false, false>(lds, D, D, D, S, E);
            __syncthreads();
        }
    }
    SEAM(8);

    if (IN(9)) for (int rep_ = 0; rep_ < REPS(9); ++rep_) { PH_PTRS();
        for (int tok = gw; tok < T; tok += NGW) {
            int rowk[4];
#pragma unroll
            for (int k = 0; k < 4; ++k) { const int sv = tokslot[tok * 4 + k], ee = sv >> 16; rowk[k] = etp[ee] * 256 + (sv & 0xffff); }
            const f32x4* xr = (const f32x4*)(X2 + (size_t)tok * D) + lane;
            f32x4 v[4]; float s = 0.f;
#pragma unroll
            for (int j = 0; j < 4; ++j) { v[j] = xr[64 * j];
#pragma unroll
                for (int k = 0; k < 4; ++k) { const u32x2 y = *((const u32x2*)(YR + (size_t)rowk[k] * 1024) + lane + 64 * j);
                    v[j][0] += __builtin_bit_cast(float, y.x << 16); v[j][1] += __builtin_bit_cast(float, y.x & 0xffff0000u);
                    v[j][2] += __builtin_bit_cast(float, y.y << 16); v[j][3] += __builtin_bit_cast(float, y.y & 0xffff0000u); }
                s += (v[j][0] * v[j][0] + v[j][1] * v[j][1]) + (v[j][2] * v[j][2] + v[j][3] * v[j][3]); }
            const float rstd = 1.0f / sqrtf(wave_sum(s) * (1.0f / D) + EPS);
            f32x4* op = (f32x4*)(ap->out + (size_t)tok * D) + lane; const f32x4* gr = (const f32x4*)ap->final_g + lane;
#pragma unroll
            for (int j = 0; j < 4; ++j) op[64 * j] = v[j] * rstd * gr[64 * j];
        }
    }
#undef IN
#undef SEAM
}

extern "C" void kernel_launch(void* const* d_in, const int* in_sizes, int n_in, void* d_out, int out_size, void* d_ws, size_t ws_size, hipStream_t stream) {
    static int grid = 0;
    if (grid == 0) {
        if (n_in != 26 || in_sizes[0] != T * D || out_size != T * D || ws_size < WS_END) { fprintf(stderr, "kernel_launch: unexpected shapes (n_in %d, in0 %d, out %d, ws %zu); nothing launched\n", n_in, n_in > 0 ? in_sizes[0] : -1, out_size, ws_size); grid = -1; return; }
        int dev = 0, cus = 0, per_cu = 0;
        if (hipGetDevice(&dev) != hipSuccess || hipDeviceGetAttribute(&cus, hipDeviceAttributeMultiprocessorCount, dev) != hipSuccess) { grid = -1; return; }
        if (hipFuncSetAttribute((const void*)fwd_kernel, hipFuncAttributeMaxDynamicSharedMemorySize, LDS_BYTES) != hipSuccess) { fprintf(stderr, "kernel_launch: hipFuncSetAttribute failed\n"); grid = -1; return; }
        if (hipOccupancyMaxActiveBlocksPerMultiprocessor(&per_cu, (const void*)fwd_kernel, NWAVES * 64, LDS_BYTES) != hipSuccess || per_cu < 1) { fprintf(stderr, "kernel_launch: occupancy query says %d\n", per_cu); per_cu = 1; }
        (void)hipGetLastError();
        grid = cus;
    }
    if (grid < 0) return;
    (void)hipMemsetAsync((char*)d_ws + WS_CTL, 0, CTL_BYTES, stream);
    Args a{};
    a.x = (const float*)d_in[0]; a.pos = (const int*)d_in[1]; a.mem = (const float*)d_in[2]; a.attn_g = (const float*)d_in[3]; a.w_in = (const float*)d_in[4];
    a.w_pool = (const float*)d_in[5]; a.pool_scale = (const float*)d_in[6]; a.lq1 = (const float*)d_in[7]; a.lk1 = (const float*)d_in[8]; a.lq2 = (const float*)d_in[9];
    a.lk2 = (const float*)d_in[10]; a.subln_g = (const float*)d_in[11]; a.w_out = (const float*)d_in[12]; a.xattn_g = (const float*)d_in[13]; a.mem_g = (const float*)d_in[14];
    a.w_cq = (const float*)d_in[15]; a.w_ckv = (const float*)d_in[16]; a.w_co = (const float*)d_in[17]; a.ffn_g = (const float*)d_in[18]; a.w_router = (const float*)d_in[19];
    a.b_router = (const float*)d_in[20]; a.w_gu = (const float*)d_in[21]; a.b_gu = (const float*)d_in[22]; a.w_down = (const float*)d_in[23]; a.b_down = (const float*)d_in[24];
    a.final_g = (const float*)d_in[25]; a.out = (float*)d_out; a.ws = (unsigned char*)d_ws;
    if (MK_N_LAUNCHES == 1) {
        a.ph_lo = 0; a.ph_hi = N_PHASES;
        void* args[] = {&a};
        hipError_t e = hipLaunchCooperativeKernel((const void*)fwd_kernel, dim3(grid), dim3(NWAVES * 64), args, LDS_BYTES, stream);
        if (e != hipSuccess) fprintf(stderr, "kernel_launch: cooperative launch failed: %s (grid %d)\n", hipGetErrorString(e), grid);
    } else {
        for (int p = 0; p < N_PHASES; ++p) { a.ph_lo = p; a.ph_hi = p + 1; hipLaunchKernelGGL(fwd_kernel, dim3(grid), dim3(NWAVES * 64), LDS_BYTES, stream, a); }
    }
}
```

```cpp
#include <hip/hip_runtime.h>
#include <cstdio>
#include <cstdint>

#ifndef MK_N_LAUNCHES
#define MK_N_LAUNCHES 1
#endif

#ifndef REPMASK
#define REPMASK 0
#endif
#define REPS(k) (((REPMASK >> (k)) & 1) ? 2 : 1)
#ifndef PMASK
#define PMASK 0x3ff
#endif
#define LAS __attribute__((address_space(3)))
#define GAS __attribute__((address_space(1)))

typedef unsigned short bf16_t;
typedef short bf16x8 __attribute__((ext_vector_type(8)));
typedef short s16x4 __attribute__((ext_vector_type(4)));
typedef float f32x4 __attribute__((ext_vector_type(4)));
typedef float f32x2 __attribute__((ext_vector_type(2)));
typedef float f32x16 __attribute__((ext_vector_type(16)));
typedef unsigned u32x4 __attribute__((ext_vector_type(4)));
typedef unsigned u32x2 __attribute__((ext_vector_type(2)));

constexpr int NB = 8, SEQ = 2048, T = NB * SEQ, D = 1024, INW = 2048, MEM = 256, NMEM = NB * MEM;
constexpr int NE = 32, TOPK = 4, CAP = 16384, MAXRT = 288;
constexpr float EPS = 1e-5f;
constexpr float LOG2E = 1.4426950408889634f;
constexpr float QSCALE_D = 0.125f * LOG2E;
constexpr float QSCALE_X = 0.0625f * LOG2E;

constexpr size_t MiB = 1u << 20;
constexpr size_t WS_CTL = 0, CTL_BYTES = 1 * MiB;
constexpr size_t WS_CS = 1 * MiB;
constexpr size_t WS_SSP = 2 * MiB;
constexpr size_t WS_RSTD2 = 3 * MiB;
constexpr size_t WS_TOKSLOT = 3 * MiB + 256 * 1024;
constexpr size_t WS_LTOK = 4 * MiB;
constexpr size_t WS_LGATE = 6 * MiB;
constexpr size_t WS_WIN = 8 * MiB;
constexpr size_t WS_WOUT = 12 * MiB;
constexpr size_t WS_WCQ = 14 * MiB;
constexpr size_t WS_WCKV = 16 * MiB;
constexpr size_t WS_WCO = 20 * MiB;
constexpr size_t WS_WGU = 24 * MiB;
constexpr size_t WS_WDN = 152 * MiB;
constexpr size_t WS_H0 = 216 * MiB;
constexpr size_t WS_MEMN = 248 * MiB;
constexpr size_t WS_KC = 252 * MiB;
constexpr size_t WS_VT = 256 * MiB;
constexpr size_t WS_U = 260 * MiB;
constexpr size_t WS_CAT = 324 * MiB;
constexpr size_t WS_X1 = 356 * MiB;
constexpr size_t WS_X1B = 420 * MiB;
constexpr size_t WS_QC = 452 * MiB;
constexpr size_t WS_PC = 484 * MiB;
constexpr size_t WS_OC = 516 * MiB;
constexpr size_t WS_X2 = 548 * MiB;
constexpr size_t WS_X2B = 612 * MiB;
constexpr size_t WS_HID = 644 * MiB;
constexpr size_t WS_Y = 788 * MiB;
constexpr size_t WS_END = 932 * MiB;
constexpr int CW_CNT = 64;
constexpr int CW_BAR = 4096;

constexpr int RING_BYTES = 131072;
constexpr int XTAB_OFF = RING_BYTES;
constexpr int ECNT_OFF = RING_BYTES + 1024;
constexpr int RT_OFF = RING_BYTES + 1536;
constexpr int MISC_OFF = RING_BYTES + 4096;
static_assert(RT_OFF + 2560 <= MISC_OFF, "LDS map");
constexpr int XE_OFF = MISC_OFF + 128;
constexpr int TOKT_OFF = MISC_OFF + 512;
constexpr int MAXU = 24;
constexpr int LDS_BYTES = 163840;
static_assert(TOKT_OFF + MAXU * 1024 <= LDS_BYTES, "LDS map");

#define LDS_WAIT() asm volatile("s_waitcnt lgkmcnt(0)" ::: "memory")
#define VM_WAIT() asm volatile("s_waitcnt vmcnt(0)" ::: "memory")
__device__ __forceinline__ unsigned f2bf(float f) { unsigned u = __builtin_bit_cast(unsigned, f); return (u + 0x7fffu + ((u >> 16) & 1u)) >> 16; }
__device__ __forceinline__ unsigned pk2(float lo, float hi) { return f2bf(lo) | (f2bf(hi) << 16); }
__device__ __forceinline__ float bf2f(unsigned short v) { return __builtin_bit_cast(float, (unsigned)v << 16); }
__device__ __forceinline__ unsigned cvt_pk_bf16(float lo, float hi) { unsigned r; asm volatile("v_cvt_pk_bf16_f32 %0, %1, %2" : "=v"(r) : "v"(lo), "v"(hi)); return r; }
__device__ __forceinline__ int lane_id() { int l; asm volatile("v_mbcnt_lo_u32_b32 %0, -1, 0\n\tv_mbcnt_hi_u32_b32 %0, -1, %0" : "=v"(l)); return l; }
__device__ __forceinline__ float wave_sum(float v) {
#pragma unroll
    for (int o = 1; o < 64; o <<= 1) v += __shfl_xor(v, o);
    return v;
}

#define XB_TMO      128
#define XB_XCNT(j)  (256  + 64 * (j))
#define XB_XSUB(j)  (1280 + 64 * (j))
#define XB_XGEN(j)  (2304 + 64 * (j))
#define XB_TOP      3328
#define XB_TOPGEN   3392
#define XCD_BAR_WORDS 3456
#define XB_SPIN_CAP (1u << 18)
__device__ __forceinline__ unsigned xb_ld(unsigned* p)              { return __hip_atomic_load(p, __ATOMIC_RELAXED, __HIP_MEMORY_SCOPE_AGENT); }
__device__ __forceinline__ unsigned xb_add(unsigned* p, unsigned v) { return __hip_atomic_fetch_add(p, v, __ATOMIC_RELAXED, __HIP_MEMORY_SCOPE_AGENT); }
__device__ __forceinline__ unsigned xb_xcc_id() { return (unsigned)__builtin_amdgcn_s_getreg((3 << 11) | 20) & 0xFu; }
#define XB_SPIN(cond, bar) do { unsigned _sp = 0; while (cond) { __builtin_amdgcn_s_sleep(1); \
    if ((++_sp & 255u) == 0u) { if (xb_ld(&(bar)[XB_TMO])) break; if (_sp > XB_SPIN_CAP) { atomicAdd(&(bar)[XB_TMO], 1u); break; } } } } while (0)
struct XcdBarrier { unsigned* bar; unsigned x; volatile LAS unsigned* st; };
__device__ __forceinline__ XcdBarrier xcd_barrier_post(unsigned* bar, volatile LAS unsigned* st, int tid) {
    XcdBarrier b; b.bar = bar; b.x = xb_xcc_id(); b.st = st;
    if (tid == 0) (void)xb_add(&bar[XB_XCNT(b.x)], 1u);
    return b;
}
__device__ __forceinline__ void xcd_barrier_complete(unsigned* bar, unsigned x, unsigned& nloc, unsigned& nx) {
    const unsigned G = gridDim.x * gridDim.y * gridDim.z;
    unsigned sum, cnt, mine, sp = 0u;
    for (;;) {
        sum = 0u; cnt = 0u; mine = 0u;
#pragma unroll
        for (unsigned j = 0; j < 16; ++j) { const unsigned c = xb_ld(&bar[XB_XCNT(j)]); sum += c; cnt += (c > 0u) ? 1u : 0u; mine = (j == x) ? c : mine; }
        if (sum == G) break;
        __builtin_amdgcn_s_sleep(1);
        if ((++sp & 255u) == 0u) { if (xb_ld(&bar[XB_TMO])) break; if (sp > XB_SPIN_CAP) { atomicAdd(&bar[XB_TMO], 1u); break; } }
    }
    nloc = mine > 0u ? mine : 1u; nx = cnt > 0u ? cnt : 1u;
}
__device__ __forceinline__ void xcd_barrier(const XcdBarrier& b, int tid) {
    asm volatile("s_waitcnt vmcnt(0)" ::: "memory");
    __syncthreads();
    if (tid == 0) {
        unsigned* bar = b.bar;
        __builtin_amdgcn_s_waitcnt(0);
        unsigned nloc = b.st[0], nx = b.st[1];
        if (nloc == 0u) { xcd_barrier_complete(bar, b.x, nloc, nx); b.st[0] = nloc; b.st[1] = nx; }
        const unsigned old = xb_add(&bar[XB_XSUB(b.x)], 1u);
        const unsigned gen = old / nloc;
        if (old + 1u == (gen + 1u) * nloc) {
            __builtin_amdgcn_fence(__ATOMIC_RELEASE, "agent");
            asm volatile("s_waitcnt vmcnt(0)" ::: "memory");
            const unsigned og = xb_add(&bar[XB_TOP], 1u);
            const unsigned tg = og / nx;
            if (og + 1u == (tg + 1u) * nx) xb_add(&bar[XB_TOPGEN], 1u);
            else XB_SPIN(xb_ld(&bar[XB_TOPGEN]) == tg, bar);
            __builtin_amdgcn_fence(__ATOMIC_ACQUIRE, "agent");
            xb_add(&bar[XB_XGEN(b.x)], 1u);
            asm volatile("s_waitcnt vmcnt(0)" ::: "memory");
        } else {
            XB_SPIN(xb_ld(&bar[XB_XGEN(b.x)]) == gen, bar);
            __builtin_amdgcn_fence(__ATOMIC_ACQUIRE, "agent");
            asm volatile("s_waitcnt vmcnt(0)" ::: "memory");
        }
    }
    __syncthreads();
}
__device__ __forceinline__ void wg_global_sync(int tid) {
    asm volatile("s_waitcnt vmcnt(0)" ::: "memory");
    __syncthreads();
    if (tid == 0) { __builtin_amdgcn_fence(__ATOMIC_ACQUIRE, "agent"); asm volatile("s_waitcnt vmcnt(0)" ::: "memory"); }
    __syncthreads();
}

namespace pg8 {
constexpr int BM = 256, BK = 64, HALF = 128, HTB = HALF * BK * 2, STAGE_BYTES = 8 * HTB, NXCD = 8, WGM = 8;
__host__ __device__ __forceinline__ int lds_byte(int r, int c) { const int st = (r >> 4) * 2 + (c >> 5), rr = r & 15, cc = c & 31, ob = rr * 64 + cc * 2; return st * 1024 + (ob ^ (((ob >> 9) & 1) << 5)); }
__host__ __device__ __forceinline__ void stage_rc(int b, int& R, int& C) { const int st = b / 1024, sb = b % 1024, swz = sb ^ (((sb >> 9) & 1) << 5); R = (st >> 1) * 16 + swz / 64; C = (st & 1) * 32 + (swz % 64) / 2; }
__host__ __device__ __forceinline__ int perm32(int rho) { const int n = rho >> 4, i = rho & 15; return 8 * (i >> 2) + 4 * n + (i & 3); }

struct Unit { int pm, pn, e, r, nvalid, ui; const char* pa; const char* pb; };

struct StaticOrder {
    int nM, nN, nwg, G, c; const char* A; const char* Bt; size_t atile, btile;
    __device__ void init(const void* A_, const void* Bt_, int M, int N, int lda, int ldb, int G_, int c_) { nM = M / BM; nN = N / BM; nwg = nM * nN; G = G_; c = c_; A = (const char*)A_; Bt = (const char*)Bt_; atile = (size_t)BM * lda * 2; btile = (size_t)BM * ldb * 2; }
    __device__ bool next(int i, Unit& u) const {
        const long L = (long)i * G + c; if (L >= nwg) return false;
        int wgid = (int)L; { const int q = nwg / NXCD, r = nwg % NXCD, xcd = wgid % NXCD, off = wgid / NXCD; wgid = (xcd < r ? xcd * (q + 1) : r * (q + 1) + (xcd - r) * q) + off; }
        const int nig = WGM * nN, gid = wgid / nig, fm = gid * WGM, gsz = (nM - fm) < WGM ? (nM - fm) : WGM;
        u.pm = fm + ((wgid % nig) % gsz); u.pn = (wgid % nig) / gsz; u.e = 0; u.r = 0; u.nvalid = 256; u.ui = i;
        u.pa = A + (size_t)u.pm * atile; u.pb = Bt + (size_t)u.pn * btile; return true;
    }
    __device__ __forceinline__ unsigned row_off(const Unit&, int) const { return 0u; }
};
struct SingleUnit {
    Unit u;
    __device__ bool next(int i, Unit& o) const { if (i != 0) return false; o = u; return true; }
    __device__ __forceinline__ unsigned row_off(const Unit&, int) const { return 0u; }
};
struct MoeOrder {
    const LAS int* ecnt; const LAS int* etp; const LAS int* xe; const LAS int* tokt;
    int x, cl, nloc, npn; const char* Abase; const char* Bbase; size_t b_expert; unsigned rowbytes; bool gather;
    __device__ bool next(int i, Unit& u) const {
        int j = i * nloc + cl;
        for (int k = 0; k < 4; ++k) { const int e = __builtin_amdgcn_readfirstlane(xe[x * 4 + k]), tp0 = __builtin_amdgcn_readfirstlane(etp[e]), nrt = __builtin_amdgcn_readfirstlane(etp[e + 1]) - tp0, n = nrt * npn;
            if (j < n) { const int pn = j / nrt, r = j - pn * nrt; u.pm = tp0 + r; u.pn = pn; u.e = e; u.r = r; u.nvalid = min(256, __builtin_amdgcn_readfirstlane(ecnt[e]) - r * 256); u.ui = i;
                u.pa = gather ? Abase : Abase + (size_t)u.pm * 256 * rowbytes; u.pb = Bbase + (size_t)e * b_expert + (size_t)pn * 256 * 2048; return true; }
            j -= n; }
        return false;
    }
    __device__ __forceinline__ unsigned row_off(const Unit& uu, int r) const { return (unsigned)tokt[uu.ui * 256 + r] * rowbytes; }
};

template <class Epi, class Sched, bool ALIGN_EPI, bool GATHER>
__device__ __forceinline__ void gemm_phase(LAS unsigned char* lds, const int wv, const int K, const int lda, const int ldb, const Sched& S, const Epi& E) {
    int tid_ = wv * 64 + lane_id(); asm volatile("" : "+v"(tid_));
    const int tid = tid_, wid = __builtin_amdgcn_readfirstlane(tid >> 6), lane = tid & 63, wr = wid >> 2, wc = wid & 3, fr = lane & 15, fq = lane >> 4;
    const int nt = K / BK;
    Unit cur, nxt; int ui = 0;
    if (!S.next(0, cur)) return;
    unsigned voffA[GATHER ? 2 : 1][2], voffB[2];
#pragma unroll
    for (int i = 0; i < 2; ++i) { int R, C; stage_rc(tid * 16 + i * 8192, R, C); const int Rb = Epi::PERM ? ((R & ~31) + perm32(R & 31)) : R;
        if constexpr (GATHER) { voffA[0][i] = S.row_off(cur, R) + (unsigned)C * 2u; voffA[1][i] = S.row_off(cur, R + HALF) + (unsigned)C * 2u; }
        else { voffA[0][i] = (unsigned)(R * lda + C) * 2u; }
        voffB[i] = (unsigned)(Rb * ldb + C) * 2u; }
    const size_t kstep = (size_t)(BK * 2);
    const size_t hstepA = GATHER ? (size_t)0 : (size_t)HALF * lda * 2, hstepB = (size_t)HALF * ldb * 2;
    const unsigned ldsw = (unsigned)wid * 1024u;
    const int aoff = lds_byte(wr * 64 + fr, fq * 8), boff = lds_byte(wc * 32 + fr, fq * 8);
#define PG8_SA(b, h) (((b) * 2 + (h)) * HTB)
#define PG8_SB(b, h) ((4 + (b) * 2 + (h)) * HTB)
#define PG8_STAGE(bufoff, gbase, voff) do { _Pragma("unroll") for (int _i = 0; _i < 2; ++_i) \
        __builtin_amdgcn_global_load_lds((const unsigned*)((const char*)(gbase) + (voff)[_i]), (LAS unsigned*)(lds + (bufoff) + ldsw + _i * 8192), 16, 0, 0); } while (0)
#define PG8_STAGEA(bufoff, gbase, h) PG8_STAGE(bufoff, (gbase) + (h) * hstepA, voffA[GATHER ? (h) : 0])
#define PG8_STAGEB(bufoff, gbase, h) PG8_STAGE(bufoff, (gbase) + (h) * hstepB, voffB)
#define PG8_LDA(dst, b, h) do { _Pragma("unroll") for (int m = 0; m < 4; ++m) _Pragma("unroll") for (int k = 0; k < 2; ++k) dst[m][k] = *(const LAS bf16x8*)(lds + PG8_SA(b, h) + aoff + m * 2048 + k * 1024); } while (0)
#define PG8_LDB(dst, b, h) do { _Pragma("unroll") for (int n = 0; n < 2; ++n) _Pragma("unroll") for (int k = 0; k < 2; ++k) dst[n][k] = *(const LAS bf16x8*)(lds + PG8_SB(b, h) + boff + n * 2048 + k * 1024); } while (0)
#define PG8_MMA(ai, bj, At, Bt) do { __builtin_amdgcn_s_setprio(1); _Pragma("unroll") for (int m = 0; m < 4; ++m) _Pragma("unroll") for (int n = 0; n < 2; ++n) _Pragma("unroll") for (int k = 0; k < 2; ++k) \
        acc[ai][bj][m][n] = __builtin_amdgcn_mfma_f32_16x16x32_bf16(Bt[n][k], At[m][k], acc[ai][bj][m][n], 0, 0, 0); __builtin_amdgcn_s_setprio(0); } while (0)
#define PG8_WAIT_V(n) asm volatile("s_waitcnt vmcnt(" #n ")" ::: "memory")
#define PG8_WAIT_L(n) asm volatile("s_waitcnt lgkmcnt(" #n ")" ::: "memory")
#define PG8_BAR __builtin_amdgcn_s_barrier()
#define PG8_SCHED __builtin_amdgcn_sched_barrier(0)
    f32x4 acc[2][2][4][2];
#pragma unroll
    for (int a = 0; a < 2; ++a)
#pragma unroll
        for (int b = 0; b < 2; ++b)
#pragma unroll
            for (int m = 0; m < 4; ++m)
#pragma unroll
                for (int n = 0; n < 2; ++n) acc[a][b][m][n] = (f32x4){0.f, 0.f, 0.f, 0.f};
    bf16x8 At[4][2], B0[2][2], B1[2][2];
    const char* cA = cur.pa; const char* cB = cur.pb;
    PG8_STAGEB(PG8_SB(0, 0), cB, 0); PG8_STAGEB(PG8_SB(0, 1), cB, 1); PG8_STAGEA(PG8_SA(0, 0), cA, 0); PG8_STAGEA(PG8_SA(0, 1), cA, 1);
    if (wr == 1) PG8_BAR;
    PG8_WAIT_V(2); PG8_BAR;
    PG8_STAGEB(PG8_SB(1, 0), cB + kstep, 0); PG8_STAGEA(PG8_SA(1, 0), cA + kstep, 0); PG8_STAGEB(PG8_SB(1, 1), cB + kstep, 1);
    PG8_WAIT_V(6); PG8_BAR;
    for (;;) {
        const bool has_next = S.next(ui + 1, nxt);
        const char* nA = has_next ? nxt.pa : cA; const char* nB = has_next ? nxt.pb : cB;
        for (int t = 0; t < nt; t += 2) {
            const bool last = (t == nt - 2);
            const char* a1 = cA + (size_t)(t + 1) * kstep;
            const char* a2 = last ? nA : cA + (size_t)(t + 2) * kstep; const char* b2 = last ? nB : cB + (size_t)(t + 2) * kstep;
            const char* a3 = a2 + kstep; const char* b3 = b2 + kstep;
            PG8_LDB(B0, 0, 0); PG8_LDB(B1, 0, 1); PG8_SCHED; PG8_LDA(At, 0, 0); PG8_STAGEA(PG8_SA(1, 1), a1, 1);
            if constexpr (GATHER) { if (last && has_next) {
#pragma unroll
                for (int i = 0; i < 2; ++i) { int R, C; stage_rc(tid * 16 + i * 8192, R, C); voffA[0][i] = S.row_off(nxt, R) + (unsigned)C * 2u; voffA[1][i] = S.row_off(nxt, R + HALF) + (unsigned)C * 2u; } } }
            PG8_WAIT_V(8); PG8_WAIT_L(0); PG8_BAR; PG8_MMA(0, 0, At, B0); PG8_MMA(0, 1, At, B1); PG8_BAR; PG8_SCHED;
            PG8_LDA(At, 0, 1); PG8_STAGEB(PG8_SB(0, 0), b2, 0); PG8_STAGEB(PG8_SB(0, 1), b2, 1); PG8_STAGEA(PG8_SA(0, 0), a2, 0);
            PG8_WAIT_V(8); PG8_WAIT_L(0); PG8_BAR; PG8_MMA(1, 0, At, B0); PG8_MMA(1, 1, At, B1); PG8_BAR; PG8_SCHED;
            PG8_LDB(B0, 1, 0); PG8_LDB(B1, 1, 1); PG8_SCHED; PG8_LDA(At, 1, 0); PG8_STAGEA(PG8_SA(0, 1), a2, 1);
            PG8_WAIT_V(8); PG8_WAIT_L(0); PG8_BAR; PG8_MMA(0, 0, At, B0); PG8_MMA(0, 1, At, B1); PG8_BAR; PG8_SCHED;
            PG8_LDA(At, 1, 1); PG8_STAGEB(PG8_SB(1, 0), b3, 0); PG8_STAGEB(PG8_SB(1, 1), b3, 1); PG8_STAGEA(PG8_SA(1, 0), a3, 0);
            PG8_WAIT_V(8); PG8_WAIT_L(0); PG8_BAR; PG8_MMA(1, 0, At, B0); PG8_MMA(1, 1, At, B1); PG8_BAR; PG8_SCHED;
        }
        if constexpr (ALIGN_EPI) { if (wr == 0) PG8_BAR; }
        if constexpr (!Epi::AFTER_DRAIN) { E(acc, cur, wr, wc, fr, fq); }
        if (!has_next) break;
#pragma unroll
        for (int a = 0; a < 2; ++a)
#pragma unroll
            for (int b = 0; b < 2; ++b)
#pragma unroll
                for (int m = 0; m < 4; ++m)
#pragma unroll
                    for (int n = 0; n < 2; ++n) acc[a][b][m][n] = (f32x4){0.f, 0.f, 0.f, 0.f};
        cur = nxt; cA = nA; cB = nB; ++ui;
        if constexpr (ALIGN_EPI) { if (wr == 1) PG8_BAR; }
    }
    PG8_WAIT_V(0);
    if constexpr (!ALIGN_EPI) { if (wr == 0) PG8_BAR; }
    PG8_BAR;
    if constexpr (Epi::AFTER_DRAIN) { E.fused(acc, cur, wr, wc, fr, fq, lds, wid, lane); }
#undef PG8_SA
#undef PG8_SB
#undef PG8_STAGE
#undef PG8_STAGEA
#undef PG8_STAGEB
#undef PG8_LDA
#undef PG8_LDB
#undef PG8_MMA
#undef PG8_WAIT_V
#undef PG8_WAIT_L
#undef PG8_BAR
#undef PG8_SCHED
}

typedef const f32x4 (&AccC)[2][2][4][2];
typedef f32x4 (&AccM)[2][2][4][2];

struct EpiInProj {
    static constexpr bool PERM = true, AFTER_DRAIN = false;
    bf16_t* U; const float* cs;
    __device__ __forceinline__ void operator()(AccC acc, const Unit& u, int wr, int wc, int fr, int fq) const {
        const int row0 = u.pm * BM + wr * 64 + fr, col0 = u.pn * BM + wc * 32 + 8 * fq;
        const bool rot = (u.pn >= 2) && (u.pn < 6) && ((wc & 1) == 0) && (fq < 2);
        const float sc = (u.pn == 2 || u.pn == 3) ? QSCALE_D : 1.f;
#pragma unroll
        for (int ai = 0; ai < 2; ++ai)
#pragma unroll
            for (int m = 0; m < 4; ++m) {
                const int row = row0 + ai * HALF + m * 16;
                f32x4 c0 = (f32x4){1.f, 0.f, 1.f, 0.f}, c1 = (f32x4){1.f, 0.f, 1.f, 0.f};
                if (rot) { const f32x4* cp = (const f32x4*)(cs + (size_t)row * 16 + 8 * fq); c0 = cp[0]; c1 = cp[1]; }
                bf16_t* rowp = U + (size_t)row * INW + col0;
#pragma unroll
                for (int bj = 0; bj < 2; ++bj) {
                    f32x4 v0 = acc[ai][bj][m][0], v1 = acc[ai][bj][m][1];
                    f32x4 w0, w1;
                    w0[0] = v0[0] * c0[0] - v0[1] * c0[1]; w0[1] = v0[1] * c0[0] + v0[0] * c0[1];
                    w0[2] = v0[2] * c0[2] - v0[3] * c0[3]; w0[3] = v0[3] * c0[2] + v0[2] * c0[3];
                    w1[0] = v1[0] * c1[0] - v1[1] * c1[1]; w1[1] = v1[1] * c1[0] + v1[0] * c1[1];
                    w1[2] = v1[2] * c1[2] - v1[3] * c1[3]; w1[3] = v1[3] * c1[2] + v1[2] * c1[3];
                    w0 = w0 * sc; w1 = w1 * sc;
                    u32x4 w; w.x = cvt_pk_bf16(w0[0], w0[1]); w.y = cvt_pk_bf16(w0[2], w0[3]); w.z = cvt_pk_bf16(w1[0], w1[1]); w.w = cvt_pk_bf16(w1[2], w1[3]);
                    *(u32x4*)(rowp + bj * HALF) = w; }
            }
    }
};
struct EpiBf16 {
    static constexpr bool PERM = true, AFTER_DRAIN = false;
    bf16_t* O; int ldc; const LAS float* rs; float mul;
    __device__ __forceinline__ void operator()(AccC acc, const Unit& u, int wr, int wc, int fr, int fq) const {
        const int rt0 = wr * 64 + fr, col0 = u.pn * BM + wc * 32 + 8 * fq;
#pragma unroll
        for (int ai = 0; ai < 2; ++ai)
#pragma unroll
            for (int m = 0; m < 4; ++m) {
                const int rt = rt0 + ai * HALF + m * 16;
                const float s = rs ? rs[rt] * mul : mul;
                bf16_t* rowp = O + (size_t)(u.pm * BM + rt) * ldc + col0;
#pragma unroll
                for (int bj = 0; bj < 2; ++bj) { const f32x4 v0 = acc[ai][bj][m][0] * s, v1 = acc[ai][bj][m][1] * s;
                    u32x4 w; w.x = cvt_pk_bf16(v0[0], v0[1]); w.y = cvt_pk_bf16(v0[2], v0[3]); w.z = cvt_pk_bf16(v1[0], v1[1]); w.w = cvt_pk_bf16(v1[2], v1[3]);
                    *(u32x4*)(rowp + bj * HALF) = w; }
            }
    }
};
struct EpiRes {
    static constexpr bool PERM = false, AFTER_DRAIN = false;
    const float* resid; float* xo; bf16_t* xb; float* ssp;
    __device__ __forceinline__ void operator()(AccC acc, const Unit& u, int wr, int wc, int fr, int fq) const {
        const int row0 = u.pm * BM + wr * 64 + fr, col0 = u.pn * BM + wc * 32 + 4 * fq;
#pragma unroll
        for (int ai = 0; ai < 2; ++ai)
#pragma unroll
            for (int m = 0; m < 4; ++m) {
                const int row = row0 + ai * HALF + m * 16; const size_t off = (size_t)row * D + col0; float ss = 0.f;
#pragma unroll
                for (int bj = 0; bj < 2; ++bj)
#pragma unroll
                    for (int n = 0; n < 2; ++n) { const size_t o2 = off + bj * HALF + n * 16; const f32x4 v = *(const f32x4*)(resid + o2) + acc[ai][bj][m][n];
                        *(f32x4*)(xo + o2) = v; ss += (v[0] * v[0] + v[1] * v[1]) + (v[2] * v[2] + v[3] * v[3]);
                        u32x2 w; w.x = cvt_pk_bf16(v[0], v[1]); w.y = cvt_pk_bf16(v[2], v[3]); *(u32x2*)(xb + o2) = w; }
                if (ssp) { ss += __shfl_xor(ss, 16); ss += __shfl_xor(ss, 32); if (fq == 0) ssp[(size_t)(u.pn * 4 + wc) * T + row] = ss; }
            }
    }
};
struct EpiSoftmax {
    static constexpr bool PERM = true, AFTER_DRAIN = true;
    bf16_t* O; int ldc;
    __device__ __forceinline__ void fused(AccM acc, const Unit& u, int wr, int wc, int fr, int fq, LAS unsigned char* lds, int wid, int lane) const {
        LAS float* PM = (LAS float*)lds; LAS float* PS = (LAS float*)(lds + 4096);
#pragma unroll
        for (int ai = 0; ai < 2; ++ai)
#pragma unroll
            for (int m = 0; m < 4; ++m) { float v = -INFINITY;
#pragma unroll
                for (int bj = 0; bj < 2; ++bj)
#pragma unroll
                    for (int n = 0; n < 2; ++n) { const f32x4 x = acc[ai][bj][m][n]; v = fmaxf(v, fmaxf(fmaxf(x[0], x[1]), fmaxf(x[2], x[3]))); }
                v = fmaxf(v, __shfl_xor(v, 16)); v = fmaxf(v, __shfl_xor(v, 32));
                if (fq == 0) PM[(ai * HALF + wr * 64 + m * 16 + fr) * 4 + wc] = v; }
        LDS_WAIT(); __builtin_amdgcn_s_barrier(); asm volatile("" ::: "memory");
#pragma unroll
        for (int ai = 0; ai < 2; ++ai)
#pragma unroll
            for (int m = 0; m < 4; ++m) { const int rt = ai * HALF + wr * 64 + m * 16 + fr; const f32x4 q = *(const LAS f32x4*)(PM + rt * 4);
                const float mx = fmaxf(fmaxf(q[0], q[1]), fmaxf(q[2], q[3])); float s = 0.f;
#pragma unroll
                for (int bj = 0; bj < 2; ++bj)
#pragma unroll
                    for (int n = 0; n < 2; ++n) { f32x4 x = acc[ai][bj][m][n];
                        x[0] = __builtin_amdgcn_exp2f(x[0] - mx); x[1] = __builtin_amdgcn_exp2f(x[1] - mx); x[2] = __builtin_amdgcn_exp2f(x[2] - mx); x[3] = __builtin_amdgcn_exp2f(x[3] - mx);
                        s += (x[0] + x[1]) + (x[2] + x[3]); acc[ai][bj][m][n] = x; }
                s += __shfl_xor(s, 16); s += __shfl_xor(s, 32);
                if (fq == 0) PS[rt * 4 + wc] = s; }
        LDS_WAIT(); __builtin_amdgcn_s_barrier(); asm volatile("" ::: "memory");
        const int col0 = u.pn * BM + wc * 32 + 8 * fq;
#pragma unroll
        for (int ai = 0; ai < 2; ++ai)
#pragma unroll
            for (int m = 0; m < 4; ++m) { const int rt = ai * HALF + wr * 64 + m * 16 + fr; const f32x4 q = *(const LAS f32x4*)(PS + rt * 4);
                const float inv = 1.0f / ((q[0] + q[1]) + (q[2] + q[3]));
                bf16_t* rowp = O + (size_t)(u.pm * BM + rt) * ldc + col0;
#pragma unroll
                for (int bj = 0; bj < 2; ++bj) { const f32x4 v0 = acc[ai][bj][m][0] * inv, v1 = acc[ai][bj][m][1] * inv;
                    u32x4 w; w.x = cvt_pk_bf16(v0[0], v0[1]); w.y = cvt_pk_bf16(v0[2], v0[3]); w.z = cvt_pk_bf16(v1[0], v1[1]); w.w = cvt_pk_bf16(v1[2], v1[3]);
                    *(u32x4*)(rowp + bj * HALF) = w; }
            }
        LDS_WAIT(); __builtin_amdgcn_s_barrier(); asm volatile("" ::: "memory");
    }
};
struct EpiSwiGLU {
    static constexpr bool PERM = true, AFTER_DRAIN = false;
    bf16_t* H; const float* bgu; const float* rstd; const LAS int* tokt;
    __device__ __forceinline__ void operator()(AccC acc, const Unit& u, int wr, int wc, int fr, int fq) const {
        const int rt0 = wr * 64 + fr, c0 = u.pn * HALF + wc * 32 + 8 * fq; const float* bg_ = bgu + (size_t)u.e * 2048;
        f32x4 bg[2], bu[2];
#pragma unroll
        for (int n = 0; n < 2; ++n) { bg[n] = *(const f32x4*)(bg_ + c0 + 4 * n); bu[n] = *(const f32x4*)(bg_ + 1024 + c0 + 4 * n); }
#pragma unroll
        for (int ai = 0; ai < 2; ++ai)
#pragma unroll
            for (int m = 0; m < 4; ++m) {
                const int rt = rt0 + ai * HALF + m * 16;
                const float rs = rstd[tokt[u.ui * 256 + rt]];
                unsigned w[4];
#pragma unroll
                for (int n = 0; n < 2; ++n) { const f32x4 g4 = acc[ai][0][m][n] * rs + bg[n], u4 = acc[ai][1][m][n] * rs + bu[n]; float h[4];
#pragma unroll
                    for (int j = 0; j < 4; ++j) { const float g = fminf(g4[j], 7.0f), up = fminf(fmaxf(u4[j], -7.0f), 7.0f);
                        const float sg = __builtin_amdgcn_rcpf(1.0f + __builtin_amdgcn_exp2f(-1.702f * LOG2E * g)); h[j] = (up + 1.0f) * g * sg; }
                    w[2 * n] = cvt_pk_bf16(h[0], h[1]); w[2 * n + 1] = cvt_pk_bf16(h[2], h[3]); }
                *(u32x4*)(H + (size_t)(u.pm * BM + rt) * 1024 + c0) = (u32x4){w[0], w[1], w[2], w[3]};
            }
    }
};
struct EpiDown {
    static constexpr bool PERM = true, AFTER_DRAIN = false;
    bf16_t* Y; const float* bd; const float* gates;
    __device__ __forceinline__ void operator()(AccC acc, const Unit& u, int wr, int wc, int fr, int fq) const {
        const int rt0 = wr * 64 + fr, col0 = u.pn * BM + wc * 32 + 8 * fq; const float* bd_ = bd + (size_t)u.e * 1024; const float* gt_ = gates + (size_t)u.e * CAP + u.r * 256;
        f32x4 bv[2][2];
#pragma unroll
        for (int bj = 0; bj < 2; ++bj)
#pragma unroll
            for (int n = 0; n < 2; ++n) bv[bj][n] = *(const f32x4*)(bd_ + col0 + bj * HALF + 4 * n);
#pragma unroll
        for (int ai = 0; ai < 2; ++ai)
#pragma unroll
            for (int m = 0; m < 4; ++m) {
                const int rt = rt0 + ai * HALF + m * 16;
                const float g = (rt < u.nvalid) ? gt_[rt] : 0.f;
                bf16_t* rowp = Y + (size_t)(u.pm * BM + rt) * 1024 + col0;
#pragma unroll
                for (int bj = 0; bj < 2; ++bj) { const f32x4 v0 = (acc[ai][bj][m][0] + bv[bj][0]) * g, v1 = (acc[ai][bj][m][1] + bv[bj][1]) * g;
                    u32x4 w; w.x = cvt_pk_bf16(v0[0], v0[1]); w.y = cvt_pk_bf16(v0[2], v0[3]); w.z = cvt_pk_bf16(v1[0], v1[1]); w.w = cvt_pk_bf16(v1[2], v1[3]);
                    *(u32x4*)(rowp + bj * HALF) = w; }
            }
    }
};
}

struct Args {
    const float* x; const int* pos; const float* mem; const float* attn_g; const float* w_in; const float* w_pool; const float* pool_scale;
    const float* lq1; const float* lk1; const float* lq2; const float* lk2; const float* subln_g; const float* w_out; const float* xattn_g; const float* mem_g;
    const float* w_cq; const float* w_ckv; const float* w_co; const float* ffn_g; const float* w_router; const float* b_router; const float* w_gu; const float* b_gu;
    const float* w_down; const float* b_down; const float* final_g;
    float* out; unsigned char* ws; int ph_lo, ph_hi;
};

template <int MAP>
__device__ __forceinline__ int rowmap(int c) {
    if (MAP == 1) { if (c >= 512 && c < 1536) { const int d = c & 63; if (d < 16) return (c & ~63) + ((d < 8) ? 2 * d : 2 * (d - 8) + 1); } return c; }
    if (MAP == 2) { const int j = c & 1023; return ((j >> 7) << 8) + ((c >> 10) << 7) + (j & 127); }
    return c;
}
template <int MAP>
__device__ __forceinline__ void p0_transpose_stream(const float* W, int K, int N, int nmat, bf16_t* WT, int ldt, int kdst0, size_t dst_stride, const float* g, LAS float* scr, int gw, int NGW, int lane) {
    const int nblk = N / 32, ipm = (K / 64) * nblk, nitems = nmat * ipm;
    const int lr = lane >> 3, lc = (lane & 7) * 4;
    f32x4 cur[8], nxt[8];
#define P0_LOAD(dst, it) do { const int e_ = (it) / ipm, r_ = (it) % ipm, kb_ = r_ / nblk, nb_ = r_ % nblk; const float* p_ = W + ((size_t)e_ * K + 64 * kb_ + lr) * N + 32 * nb_ + lc; \
        _Pragma("unroll") for (int i_ = 0; i_ < 8; ++i_) dst[i_] = *(const f32x4*)(p_ + (size_t)(8 * i_) * N); } while (0)
    int it = gw;
    if (it < nitems) P0_LOAD(cur, it);
    while (it < nitems) {
        const int itn = it + NGW;
        if (itn < nitems) P0_LOAD(nxt, itn);
        const int e = it / ipm, r = it % ipm, kb = r / nblk, nb = r % nblk, k0 = 64 * kb, n0 = 32 * nb;
#pragma unroll
        for (int i = 0; i < 8; ++i) { const int kk = 8 * i + lr; f32x4 v = cur[i]; if (g) v = v * g[k0 + kk];
            LAS float* s = scr + kk * 33 + lc; s[0] = v[0]; s[1] = v[1]; s[2] = v[2]; s[3] = v[3]; }
        LDS_WAIT(); asm volatile("" ::: "memory");
        const int c = lane & 7; bf16_t* wt = WT + (size_t)e * dst_stride;
#pragma unroll
        for (int j = 0; j < 4; ++j) { const int n = (lane >> 3) + 8 * j; const LAS float* s = scr + (8 * c) * 33 + n;
            u32x4 o; o.x = pk2(s[0 * 33], s[1 * 33]); o.y = pk2(s[2 * 33], s[3 * 33]); o.z = pk2(s[4 * 33], s[5 * 33]); o.w = pk2(s[6 * 33], s[7 * 33]);
            *(u32x4*)(wt + (size_t)rowmap<MAP>(n0 + n) * ldt + kdst0 + k0 + 8 * c) = o; }
        LDS_WAIT(); asm volatile("" ::: "memory");
#pragma unroll
        for (int i = 0; i < 8; ++i) cur[i] = nxt[i];
        it = itn;
    }
#undef P0_LOAD
}
__device__ __forceinline__ void rms_row_to_bf16(const float* xrow, const float* g, bf16_t* orow, int lane) {
    const f32x4* xr = (const f32x4*)xrow + lane; const f32x4* gr = (const f32x4*)g + lane;
    f32x4 v[4]; float s = 0.f;
#pragma unroll
    for (int j = 0; j < 4; ++j) { v[j] = xr[64 * j]; s += (v[j][0] * v[j][0] + v[j][1] * v[j][1]) + (v[j][2] * v[j][2] + v[j][3] * v[j][3]); }
    const float rstd = 1.0f / sqrtf(wave_sum(s) * (1.0f / D) + EPS);
    u32x2* o8 = (u32x2*)orow + lane;
#pragma unroll
    for (int j = 0; j < 4; ++j) { const f32x4 gg = gr[64 * j]; u32x2 w; w.x = pk2(v[j][0] * rstd * gg[0], v[j][1] * rstd * gg[1]); w.y = pk2(v[j][2] * rstd * gg[2], v[j][3] * rstd * gg[3]); o8[64 * j] = w; }
}

namespace dattn {
constexpr int KP = 144, VP = 320;
constexpr int K_BYTES = 2 * 64 * KP, V_BYTES = 64 * VP, STG = K_BYTES + V_BYTES;
__device__ __forceinline__ s16x4 vtr(const LAS unsigned char* p) { typedef short v4i16_t __attribute__((ext_vector_type(4))); return __builtin_bit_cast(s16x4, __builtin_amdgcn_ds_read_tr16_b64_v4i16((LAS v4i16_t*)p)); }
__device__ __forceinline__ void unit(LAS unsigned char* lds, const int wv, const bf16_t* U, bf16_t* CAT, const float* subln_g, float lam, int b, int hh, int j) {
    int tid_ = wv * 64 + lane_id(); asm volatile("" : "+v"(tid_));
    const int tid = tid_, lane = tid & 63, r32 = lane & 31, hi = lane >> 5; const int wid = __builtin_amdgcn_readfirstlane(tid >> 6);
    const int mp = wid & 1, rg = wid >> 1;
    const size_t tok0 = (size_t)b * SEQ;
    const int q0 = j * 128 + rg * 32;
    const int nt_all = 2 * j + 2, nt_mine = (rg < 2) ? nt_all - 1 : nt_all;
    bf16x8 qf[4];
    { const bf16_t* qp = U + (tok0 + q0 + r32) * INW + 512 + hh * 128 + mp * 64 + hi * 8;
#pragma unroll
      for (int ks = 0; ks < 4; ++ks) qf[ks] = *(const bf16x8*)(qp + ks * 16); }
    const int prow = tid >> 3, pc0 = (tid & 7) * 2;
    const bf16_t* kg = U + (tok0 + prow) * INW + 1024 + hh * 128 + pc0 * 8;
    const bf16_t* vg = U + (tok0 + prow) * INW + 1536 + hh * 128 + pc0 * 8;
    unsigned kdst[2], vdst[2];
#pragma unroll
    for (int i = 0; i < 2; ++i) { const int c16 = pc0 + i; kdst[i] = (unsigned)((c16 >> 3) * (64 * KP) + prow * KP + (c16 & 7) * 16); vdst[i] = (unsigned)(K_BYTES + prow * VP + c16 * 16); }
    u32x4 kr[2], vr[2];
#define DA_LOAD(t) do { const size_t go = (size_t)(t) * 64 * INW; kr[0] = *(const u32x4*)(kg + go); kr[1] = *(const u32x4*)(kg + go + 8); vr[0] = *(const u32x4*)(vg + go); vr[1] = *(const u32x4*)(vg + go + 8); } while (0)
#define DA_WRITE(s) do { LAS unsigned char* sb = lds + (s) * STG; *(LAS u32x4*)(sb + kdst[0]) = kr[0]; *(LAS u32x4*)(sb + kdst[1]) = kr[1]; *(LAS u32x4*)(sb + vdst[0]) = vr[0]; *(LAS u32x4*)(sb + vdst[1]) = vr[1]; } while (0)
    f32x16 o[4];
#pragma unroll
    for (int d0 = 0; d0 < 4; ++d0)
#pragma unroll
        for (int r = 0; r < 16; ++r) o[d0][r] = 0.f;
    float mrun = -INFINITY, lrun = 0.f;
    const int i16 = lane & 15, g16 = (lane >> 4) & 1;
    const unsigned kbase = (unsigned)(mp * (64 * KP) + r32 * KP + hi * 16);
    const unsigned vbase = (unsigned)(K_BYTES + (4 * hi + (i16 >> 2)) * VP + (16 * g16 + 4 * (i16 & 3)) * 2);
    DA_LOAD(0); DA_WRITE(0);
    __syncthreads();
    for (int kt = 0; kt < nt_all; ++kt) {
        const bool more = (kt + 1 < nt_all);
        if (more) DA_LOAD(kt + 1);
        if (kt < nt_mine) {
            const LAS unsigned char* sb = lds + (kt & 1) * STG;
            f32x16 p0, p1;
#pragma unroll
            for (int r = 0; r < 16; ++r) { p0[r] = 0.f; p1[r] = 0.f; }
#pragma unroll
            for (int ks = 0; ks < 4; ++ks) {
                const bf16x8 k0 = *(const LAS bf16x8*)(sb + kbase + ks * 32), k1 = *(const LAS bf16x8*)(sb + kbase + 32 * KP + ks * 32);
                p0 = __builtin_amdgcn_mfma_f32_32x32x16_bf16(k0, qf[ks], p0, 0, 0, 0);
                p1 = __builtin_amdgcn_mfma_f32_32x32x16_bf16(k1, qf[ks], p1, 0, 0, 0);
            }
            float mx = fmaxf(p0[0], p1[0]);
#pragma unroll
            for (int r = 1; r < 16; ++r) mx = fmaxf(mx, fmaxf(p0[r], p1[r]));
            mx = fmaxf(mx, __shfl_xor(mx, 32));
            const float mnew = fmaxf(mrun, mx), alpha = __builtin_amdgcn_exp2f(mrun - mnew); mrun = mnew;
            float ls = 0.f;
#pragma unroll
            for (int r = 0; r < 16; ++r) { p0[r] = __builtin_amdgcn_exp2f(p0[r] - mnew); p1[r] = __builtin_amdgcn_exp2f(p1[r] - mnew); ls += p0[r] + p1[r]; }
            lrun = lrun * alpha + ls;
#pragma unroll
            for (int d0 = 0; d0 < 4; ++d0)
#pragma unroll
                for (int r = 0; r < 16; ++r) o[d0][r] *= alpha;
            bf16x8 pf[4];
#pragma unroll
            for (int s = 0; s < 4; ++s) { u32x4 w;
                if (s < 2) { w.x = cvt_pk_bf16(p0[8 * s + 0], p0[8 * s + 1]); w.y = cvt_pk_bf16(p0[8 * s + 2], p0[8 * s + 3]); w.z = cvt_pk_bf16(p0[8 * s + 4], p0[8 * s + 5]); w.w = cvt_pk_bf16(p0[8 * s + 6], p0[8 * s + 7]); }
                else { const int s2 = s - 2; w.x = cvt_pk_bf16(p1[8 * s2 + 0], p1[8 * s2 + 1]); w.y = cvt_pk_bf16(p1[8 * s2 + 2], p1[8 * s2 + 3]); w.z = cvt_pk_bf16(p1[8 * s2 + 4], p1[8 * s2 + 5]); w.w = cvt_pk_bf16(p1[8 * s2 + 6], p1[8 * s2 + 7]); }
                pf[s] = __builtin_bit_cast(bf16x8, w); }
#pragma unroll
            for (int d0 = 0; d0 < 4; ++d0)
#pragma unroll
                for (int s = 0; s < 4; ++s) {
                    const s16x4 lo = vtr(sb + vbase + s * 16 * VP + d0 * 64), hv = vtr(sb + vbase + s * 16 * VP + 8 * VP + d0 * 64);
                    const bf16x8 vf = (bf16x8){lo[0], lo[1], lo[2], lo[3], hv[0], hv[1], hv[2], hv[3]};
                    o[d0] = __builtin_amdgcn_mfma_f32_32x32x16_bf16(vf, pf[s], o[d0], 0, 0, 0);
                }
        }
        if (more) DA_WRITE((kt + 1) & 1);
        __syncthreads();
    }
#undef DA_LOAD
#undef DA_WRITE
    const float ltot = lrun + __shfl_xor(lrun, 32), inv = 1.0f / ltot;
    LAS float* X = (LAS float*)lds + rg * 4096;
    if (mp == 1) {
#pragma unroll
        for (int d0 = 0; d0 < 4; ++d0)
#pragma unroll
            for (int r = 0; r < 16; ++r) { const int dv = 32 * d0 + (r & 3) + 8 * (r >> 2) + 4 * hi; X[dv * 32 + r32] = o[d0][r] * inv; }
    }
    __syncthreads();
    if (mp == 0) {
        float ss = 0.f;
#pragma unroll
        for (int d0 = 0; d0 < 4; ++d0)
#pragma unroll
            for (int r = 0; r < 16; ++r) { const int dv = 32 * d0 + (r & 3) + 8 * (r >> 2) + 4 * hi; const float v = o[d0][r] * inv - lam * X[dv * 32 + r32]; o[d0][r] = v; ss += v * v; }
        ss += __shfl_xor(ss, 32);
        const float rstd = 0.8f / sqrtf(ss * (1.0f / 128.0f) + EPS);
        bf16_t* op = CAT + (tok0 + q0 + r32) * D + 512 + hh * 128;
#pragma unroll
        for (int d0 = 0; d0 < 4; ++d0)
#pragma unroll
            for (int r4 = 0; r4 < 4; ++r4) { const int dv = 32 * d0 + 8 * r4 + 4 * hi; const f32x4 gg = *(const f32x4*)(subln_g + dv);
                u32x2 w; w.x = cvt_pk_bf16(o[d0][4 * r4 + 0] * rstd * gg[0], o[d0][4 * r4 + 1] * rstd * gg[1]); w.y = cvt_pk_bf16(o[d0][4 * r4 + 2] * rstd * gg[2], o[d0][4 * r4 + 3] * rstd * gg[3]);
                *(u32x2*)(op + dv) = w; }
    }
    __syncthreads();
}
}

typedef const __attribute__((address_space(4))) Args* KArgsP;
__device__ __forceinline__ KArgsP kargs() { KArgsP p = (KArgsP)__builtin_amdgcn_kernarg_segment_ptr(); asm volatile("" : "+s"(p)); return p; }
#define PH_PTRS() KArgsP ap = kargs(); unsigned char* ws = ap->ws; (void)ws; int tid = wave * 64 + lane_id(); asm volatile("" : "+v"(tid)); const int lane = tid & 63; (void)lane; \
    float* cs = (float*)(ws + WS_CS); float* ssp = (float*)(ws + WS_SSP); float* rstd2 = (float*)(ws + WS_RSTD2); \
    int* tokslot = (int*)(ws + WS_TOKSLOT); int* ltok = (int*)(ws + WS_LTOK); float* lgate = (float*)(ws + WS_LGATE); \
    bf16_t* Win_t = (bf16_t*)(ws + WS_WIN); bf16_t* Wout_t = (bf16_t*)(ws + WS_WOUT); bf16_t* Wcq_t = (bf16_t*)(ws + WS_WCQ); bf16_t* Wckv_t = (bf16_t*)(ws + WS_WCKV); \
    bf16_t* Wco_t = (bf16_t*)(ws + WS_WCO); bf16_t* Wgu_t = (bf16_t*)(ws + WS_WGU); bf16_t* Wdn_t = (bf16_t*)(ws + WS_WDN); \
    bf16_t* H0 = (bf16_t*)(ws + WS_H0); bf16_t* MEMN = (bf16_t*)(ws + WS_MEMN); bf16_t* KC = (bf16_t*)(ws + WS_KC); bf16_t* VT = (bf16_t*)(ws + WS_VT); \
    bf16_t* U = (bf16_t*)(ws + WS_U); bf16_t* CAT = (bf16_t*)(ws + WS_CAT); float* X1 = (float*)(ws + WS_X1); bf16_t* X1B = (bf16_t*)(ws + WS_X1B); \
    bf16_t* QC = (bf16_t*)(ws + WS_QC); bf16_t* PC = (bf16_t*)(ws + WS_PC); bf16_t* OC = (bf16_t*)(ws + WS_OC); float* X2 = (float*)(ws + WS_X2); bf16_t* X2B = (bf16_t*)(ws + WS_X2B); \
    bf16_t* HID = (bf16_t*)(ws + WS_HID); bf16_t* YR = (bf16_t*)(ws + WS_Y); \
    (void)cs; (void)ssp; (void)rstd2; (void)tokslot; (void)ltok; (void)lgate; (void)Win_t; (void)Wout_t; (void)Wcq_t; (void)Wckv_t; (void)Wco_t; (void)Wgu_t; (void)Wdn_t; (void)H0; (void)MEMN; (void)KC; (void)VT; \
    (void)U; (void)CAT; (void)X1; (void)X1B; (void)QC; (void)PC; (void)OC; (void)X2; (void)X2B; (void)HID; (void)YR

constexpr int NWAVES = 8;
constexpr int N_PHASES = 10;

__global__ void __launch_bounds__(NWAVES * 64, 2) fwd_kernel(Args a) {
    extern __shared__ __attribute__((aligned(16))) unsigned char lds_raw[];
    LAS unsigned char* lds = (LAS unsigned char*)lds_raw;
    const int wave = __builtin_amdgcn_readfirstlane((int)threadIdx.x >> 6);
    const int tid = wave * 64 + lane_id(), lane = tid & 63; (void)lane;
    const int G = gridDim.x, bx = blockIdx.x;
    const int gw = bx * NWAVES + wave, NGW = G * NWAVES;
    unsigned* ctl; { unsigned char* ws0 = a.ws; ctl = (unsigned*)(ws0 + WS_CTL); }
    volatile LAS unsigned* MISC = (volatile LAS unsigned*)(lds + MISC_OFF);
    if (tid < 32) ((LAS unsigned*)(lds + MISC_OFF))[tid] = 0u;
    __syncthreads();
    XcdBarrier bar; bar.bar = ctl + CW_BAR; bar.x = 0; bar.st = nullptr;
    if (MK_N_LAUNCHES == 1) bar = xcd_barrier_post(ctl + CW_BAR, MISC + 8, tid);
    const int lo = a.ph_lo, hi = a.ph_hi;
#define IN(k) (((PMASK >> (k)) & 1) && lo <= (k) && (k) < hi)
#define SEAM(k) do { if (IN(k) && IN((k) + 1)) xcd_barrier(bar, wave * 64 + lane_id()); } while (0)

    if (IN(0)) for (int rep_ = 0; rep_ < REPS(0); ++rep_) { PH_PTRS();
        LAS float* scr = (LAS float*)(lds + wave * 16384);
        p0_transpose_stream<2>(ap->w_gu, 1024, 2048, NE, Wgu_t, 1024, 0, (size_t)2048 * 1024, ap->ffn_g, scr, gw, NGW, lane);
        p0_transpose_stream<0>(ap->w_down, 1024, 1024, NE, Wdn_t, 1024, 0, (size_t)1024 * 1024, nullptr, scr, gw, NGW, lane);
        p0_transpose_stream<1>(ap->w_in, 1024, 2048, 1, Win_t, 1024, 0, 0, nullptr, scr, gw, NGW, lane);
        p0_transpose_stream<0>(ap->w_out + (size_t)512 * 1024, 512, 1024, 1, Wout_t, 1024, 512, 0, nullptr, scr, gw, NGW, lane);
        p0_transpose_stream<0>(ap->w_cq, 1024, 1024, 1, Wcq_t, 1024, 0, 0, ap->xattn_g, scr, gw, NGW, lane);
        p0_transpose_stream<0>(ap->w_ckv, 1024, 2048, 1, Wckv_t, 1024, 0, 0, nullptr, scr, gw, NGW, lane);
        p0_transpose_stream<0>(ap->w_co, 1024, 1024, 1, Wco_t, 1024, 0, 0, nullptr, scr, gw, NGW, lane);
        constexpr int I_WEFF = 1024, I_XR = T, I_MR = NMEM, I_ROPE = T * 8 / 64;
        constexpr int NITEMS = I_WEFF + I_XR + I_MR + I_ROPE;
        for (int it = gw; it < NITEMS; it += NGW) {
            int r = it;
            if (r < I_WEFF) {
                const int nb = r & 15, cb = r >> 4, n = nb * 64 + lane, kk0 = cb * 8, g = kk0 >> 7;
                float accv[8];
#pragma unroll
                for (int q = 0; q < 8; ++q) accv[q] = 0.f;
#pragma unroll 8
                for (int d = 0; d < 128; ++d) { const float wo = ap->w_out[(size_t)(g * 128 + d) * 1024 + n] * ap->pool_scale[g * 128 + d];
#pragma unroll
                    for (int q = 0; q < 8; ++q) accv[q] += ap->w_pool[(size_t)(kk0 + q) * 128 + d] * wo; }
                u32x4 o4; o4.x = pk2(accv[0], accv[1]); o4.y = pk2(accv[2], accv[3]); o4.z = pk2(accv[4], accv[5]); o4.w = pk2(accv[6], accv[7]);
                *(u32x4*)(Wout_t + (size_t)n * 1024 + kk0) = o4; continue; } r -= I_WEFF;
            if (r < I_XR) { rms_row_to_bf16(ap->x + (size_t)r * D, ap->attn_g, H0 + (size_t)r * D, lane); continue; } r -= I_XR;
            if (r < I_MR) { rms_row_to_bf16(ap->mem + (size_t)r * D, ap->mem_g, MEMN + (size_t)r * D, lane); continue; } r -= I_MR;
            {
                const int idx = r * 64 + lane, t = idx >> 3, i = idx & 7;
                const double inv_freq = exp2(-(double)i * (18.931568569324174 / 8.0));
                const double rev = (double)ap->pos[t] * inv_freq * 0.15915494309189535;
                const float fr = (float)(rev - floor(rev));
                cs[(size_t)idx * 2] = __builtin_amdgcn_cosf(fr); cs[(size_t)idx * 2 + 1] = __builtin_amdgcn_sinf(fr);
            }
        }
    }
    SEAM(0);

    if (IN(1)) for (int rep_ = 0; rep_ < REPS(1); ++rep_) { PH_PTRS();
        { pg8::StaticOrder S; S.init(H0, Win_t, T, INW, D, D, G, bx); pg8::EpiInProj E{U, cs};
          pg8::gemm_phase<pg8::EpiInProj, pg8::StaticOrder, true, false>(lds, wave, D, D, D, S, E); }
        { pg8::StaticOrder S; S.init(MEMN, Wckv_t, NMEM, 1024, D, D, G, bx); pg8::EpiBf16 E{KC, 1024, nullptr, 1.0f};
          pg8::gemm_phase<pg8::EpiBf16, pg8::StaticOrder, true, false>(lds, wave, D, D, D, S, E); }
        { pg8::StaticOrder S; S.init(Wckv_t + (size_t)1024 * 1024, MEMN, 1024, NMEM, D, D, G, (bx + 32) % G); pg8::EpiBf16 E{VT, NMEM, nullptr, 1.0f};
          pg8::gemm_phase<pg8::EpiBf16, pg8::StaticOrder, true, false>(lds, wave, D, D, D, S, E); }
    }
    SEAM(1);

    if (IN(2)) for (int rep_ = 0; rep_ < REPS(2); ++rep_) { PH_PTRS();
        float d1 = (lane < 64) ? ap->lq1[lane] * ap->lk1[lane] : 0.f, d2 = ap->lq2[lane] * ap->lk2[lane];
        d1 = wave_sum(d1); d2 = wave_sum(d2);
        const float lam = expf(d1) - expf(d2) + 0.2f;
        for (int un = bx; un < 256; un += G) {
            const int bh = un >> 3, jp = un & 7;
            dattn::unit(lds, wave, U, CAT, ap->subln_g, lam, bh >> 2, bh & 3, jp);
            dattn::unit(lds, wave, U, CAT, ap->subln_g, lam, bh >> 2, bh & 3, 15 - jp);
        }
        for (int it = gw; it < T / 8; it += NGW) {
            const int b = it >> 8, t0 = (it & 255) * 8, wnd = 2 << (lane >> 4);
            const bf16_t* up = U + (size_t)b * SEQ * INW + lane * 8;
#pragma unroll 1
            for (int tt = 0; tt < 8; ++tt) { const int t = t0 + tt; float s[8], c[8];
#pragma unroll
                for (int q = 0; q < 8; ++q) s[q] = 0.f;
                for (int jj = 0; jj < 16; ++jj) { if (jj < wnd && jj <= t) { const bf16x8 v = *(const bf16x8*)(up + (size_t)(t - jj) * INW);
#pragma unroll
                        for (int q = 0; q < 8; ++q) { const float f = bf2f((unsigned short)v[q]); s[q] += f; if (jj == 0) c[q] = f; } } }
                const float ic = 1.0f / (float)((t + 1 < wnd) ? t + 1 : wnd);
                u32x4 o4; o4.x = pk2(s[0] * ic - c[0], s[1] * ic - c[1]); o4.y = pk2(s[2] * ic - c[2], s[3] * ic - c[3]); o4.z = pk2(s[4] * ic - c[4], s[5] * ic - c[5]); o4.w = pk2(s[6] * ic - c[6], s[7] * ic - c[7]);
                *(u32x4*)(CAT + ((size_t)b * SEQ + t) * D + lane * 8) = o4; }
        }
    }
    SEAM(2);

    if (IN(3)) for (int rep_ = 0; rep_ < REPS(3); ++rep_) { PH_PTRS();
        pg8::StaticOrder S; S.init(CAT, Wout_t, T, D, D, D, G, bx); pg8::EpiRes E{ap->x, X1, X1B, ssp};
        pg8::gemm_phase<pg8::EpiRes, pg8::StaticOrder, true, false>(lds, wave, D, D, D, S, E);
    }
    SEAM(3);

    if (IN(4)) for (int rep_ = 0; rep_ < REPS(4); ++rep_) { PH_PTRS();
        LAS float* rs = (LAS float*)(lds + XTAB_OFF);
        for (int un = bx; un < 256; un += G) {
            const int pm = un >> 2, h = un & 3, b = pm >> 3;
            if (tid < 256) { const int row = pm * 256 + tid; float s = 0.f;
#pragma unroll
                for (int p = 0; p < 16; ++p) s += ssp[(size_t)p * T + row];
                rs[tid] = 1.0f / sqrtf(s * (1.0f / D) + EPS); }
            __syncthreads();
            { pg8::SingleUnit S; S.u = pg8::Unit{pm, h, 0, 0, 256, 0, (const char*)(X1B + (size_t)pm * 256 * D), (const char*)(Wcq_t + (size_t)h * 256 * D)};
              pg8::EpiBf16 E{QC, D, rs, QSCALE_X};
              pg8::gemm_phase<pg8::EpiBf16, pg8::SingleUnit, false, false>(lds, wave, D, D, D, S, E); }
            wg_global_sync(tid);
            { pg8::SingleUnit S; S.u = pg8::Unit{pm, h, 0, 0, 256, 0, (const char*)(QC + (size_t)pm * 256 * D + h * 256), (const char*)(KC + (size_t)b * 256 * D + h * 256)};
              pg8::EpiSoftmax E{PC, D};
              pg8::gemm_phase<pg8::EpiSoftmax, pg8::SingleUnit, false, false>(lds, wave, 256, D, D, S, E); }
            wg_global_sync(tid);
            { pg8::SingleUnit S; S.u = pg8::Unit{pm, h, 0, 0, 256, 0, (const char*)(PC + (size_t)pm * 256 * D + h * 256), (const char*)(VT + (size_t)h * 256 * NMEM + b * 256)};
              pg8::EpiBf16 E{OC, D, nullptr, 1.0f};
              pg8::gemm_phase<pg8::EpiBf16, pg8::SingleUnit, false, false>(lds, wave, 256, D, NMEM, S, E); }
            __syncthreads();
        }
    }
    SEAM(4);

    if (IN(5)) for (int rep_ = 0; rep_ < REPS(5); ++rep_) { PH_PTRS();
        pg8::StaticOrder S; S.init(OC, Wco_t, T, D, D, D, G, bx); pg8::EpiRes E{X1, X2, X2B, nullptr};
        pg8::gemm_phase<pg8::EpiRes, pg8::StaticOrder, true, false>(lds, wave, D, D, D, S, E);
    }
    SEAM(5);

    if (IN(6)) for (int rep_ = 0; rep_ < REPS(6); ++rep_) { PH_PTRS();
        LAS float* WR = (LAS float*)lds;
        LAS int* lcnt = (LAS int*)(lds + RT_OFF);
        LAS int* sel = (LAS int*)(lds + RT_OFF + 512);
        LAS float* selg = (LAS float*)(lds + RT_OFF + 512 + 1024);
        const int wave_ = __builtin_amdgcn_readfirstlane(tid >> 6);
        for (int tb = bx; tb < T / 64; tb += G) {
            for (int i = tid; i < 8192; i += NWAVES * 64) { const f32x4 w = ((const f32x4*)ap->w_router)[i]; *(LAS f32x4*)(WR + 4 * i) = w * ap->ffn_g[i >> 3]; }
            if (tid < 32) lcnt[tid] = 0;
            __syncthreads();
            const int tile = wave_ >> 2, kq = wave_ & 3, r32 = lane & 31, h = lane >> 5;
            const float* xp = X2 + (size_t)(tb * 64 + tile * 32 + r32) * D + kq * 256 + 32 * h;
            f32x16 accr;
#pragma unroll
            for (int r = 0; r < 16; ++r) accr[r] = 0.f;
            float ss = 0.f;
#pragma unroll 1
            for (int S = 0; S < 4; ++S) {
                f32x4 xv[8];
#pragma unroll
                for (int q = 0; q < 8; ++q) xv[q] = *(const f32x4*)(xp + 64 * S + 4 * q);
                const LAS float* wp = WR + (kq * 256 + 64 * S + 32 * h) * 32 + r32;
#pragma unroll
                for (int s = 0; s < 32; ++s) { const float av = xv[s >> 2][s & 3]; accr = __builtin_amdgcn_mfma_f32_32x32x2f32(av, wp[s * 32], accr, 0, 0, 0); ss += av * av; }
            }
            ss += __shfl_xor(ss, 32);
            __syncthreads();
            LAS float* PT = (LAS float*)lds + wave_ * (32 * 33);
            LAS float* PSS = (LAS float*)lds + 8 * 32 * 33;
#pragma unroll
            for (int r = 0; r < 16; ++r) PT[((r & 3) + 8 * (r >> 2) + 4 * h) * 33 + r32] = accr[r];
            if (h == 0) PSS[wave_ * 32 + r32] = ss;
            __syncthreads();
            if (tid < 64) {
                const int tl = tid & 31, tok = tb * 64 + tid; const LAS float* p0 = (LAS float*)lds + ((tid >> 5) * 4) * (32 * 33) + tl * 33; const LAS float* q0 = PSS + (tid >> 5) * 128 + tl;
                const float sq = (q0[0] + q0[32]) + (q0[64] + q0[96]);
                const float rstd = 1.0f / sqrtf(sq * (1.0f / D) + EPS);
                rstd2[tok] = rstd;
                float b0 = -INFINITY, b1 = -INFINITY, b2 = -INFINITY, b3 = -INFINITY; int i0 = 0, i1 = 0, i2 = 0, i3 = 0;
                for (int e = 0; e < 32; ++e) {
                    const float lg = ((p0[e] + p0[32 * 33 + e]) + (p0[2 * 32 * 33 + e] + p0[3 * 32 * 33 + e])) * rstd + ap->b_router[e];
                    if (lg > b3) { b3 = lg; i3 = e;
                        if (b3 > b2) { const float tf = b2; b2 = b3; b3 = tf; const int ti = i2; i2 = i3; i3 = ti; }
                        if (b2 > b1) { const float tf = b1; b1 = b2; b2 = tf; const int ti = i1; i1 = i2; i2 = ti; }
                        if (b1 > b0) { const float tf = b0; b0 = b1; b1 = tf; const int ti = i0; i0 = i1; i1 = ti; } }
                }
                const float e1 = expf(b1 - b0), e2 = expf(b2 - b0), e3 = expf(b3 - b0), isum = 1.0f / (1.0f + e1 + e2 + e3);
                int lr;
                lr = atomicAdd((int*)&lcnt[i0], 1); sel[tid * 4 + 0] = (i0 << 16) | lr; selg[tid * 4 + 0] = isum;
                lr = atomicAdd((int*)&lcnt[i1], 1); sel[tid * 4 + 1] = (i1 << 16) | lr; selg[tid * 4 + 1] = e1 * isum;
                lr = atomicAdd((int*)&lcnt[i2], 1); sel[tid * 4 + 2] = (i2 << 16) | lr; selg[tid * 4 + 2] = e2 * isum;
                lr = atomicAdd((int*)&lcnt[i3], 1); sel[tid * 4 + 3] = (i3 << 16) | lr; selg[tid * 4 + 3] = e3 * isum;
            }
            __syncthreads();
            if (tid < 32) { const int c = lcnt[tid]; lcnt[32 + tid] = (c > 0) ? (int)atomicAdd(ctl + CW_CNT + tid, (unsigned)c) : 0; }
            __syncthreads();
            if (tid < 256) { const int tl = tid >> 2, tok = tb * 64 + tl, sv = sel[tid], ee = sv >> 16, pos = lcnt[32 + ee] + (sv & 0xffff);
                ltok[ee * CAP + pos] = tok; lgate[ee * CAP + pos] = selg[tid]; tokslot[tok * 4 + (tid & 3)] = (ee << 16) | pos; }
            __syncthreads();
        }
    }
    SEAM(6);

    LAS int* ecnt = (LAS int*)(lds + ECNT_OFF);
    LAS int* etp = (LAS int*)(lds + ECNT_OFF + 128);
    LAS int* xe = (LAS int*)(lds + XE_OFF);
    LAS int* tokt = (LAS int*)(lds + TOKT_OFF);
    if (IN(7) || IN(8) || IN(9)) {
        __syncthreads();
        const int t_ = wave * 64 + lane_id();
        if (t_ == 0) { int acc = 0; for (int e = 0; e < NE; ++e) { const int c = (int)__hip_atomic_load(ctl + CW_CNT + e, __ATOMIC_RELAXED, __HIP_MEMORY_SCOPE_AGENT); ecnt[e] = c; etp[e] = acc; acc += (c + 255) >> 8; } etp[NE] = acc; }
        __syncthreads();
        if (t_ < NE) { const int e = t_, n = etp[e + 1] - etp[e]; int rank = 0;
            for (int o = 0; o < NE; ++o) { const int no = etp[o + 1] - etp[o]; rank += (no > n || (no == n && o < e)) ? 1 : 0; }
            const int rnd = rank >> 3, p = rank & 7, x = (rnd & 1) ? 7 - p : p; xe[x * 4 + rnd] = e; }
        __syncthreads();
    }

    if (IN(7)) for (int rep_ = 0; rep_ < REPS(7); ++rep_) { PH_PTRS();
        pg8::MoeOrder S; S.ecnt = ecnt; S.etp = etp; S.xe = xe; S.tokt = tokt; S.x = bx & 7; S.cl = bx >> 3; S.nloc = G >> 3; S.npn = 8;
        S.Abase = (const char*)X2B; S.Bbase = (const char*)Wgu_t; S.b_expert = (size_t)2048 * 1024 * 2; S.rowbytes = D * 2; S.gather = true;
        { pg8::Unit u;
          for (int i = 0; i < MAXU && S.next(i, u); ++i) if (tid < 256) tokt[i * 256 + tid] = (tid < u.nvalid) ? ltok[u.e * CAP + u.r * 256 + tid] : 0; }
        __syncthreads();
        pg8::EpiSwiGLU E{HID, ap->b_gu, rstd2, tokt};
        pg8::gemm_phase<pg8::EpiSwiGLU, pg8::MoeOrder, true, true>(lds, wave, D, D, D, S, E);
    }
    SEAM(7);

    if (IN(8)) for (int rep_ = 0; rep_ < REPS(8); ++rep_) { PH_PTRS();
        pg8::MoeOrder S; S.ecnt = ecnt; S.etp = etp; S.xe = xe; S.tokt = tokt; S.x = bx & 7; S.cl = bx >> 3; S.nloc = G >> 3; S.npn = 4;
        S.Abase = (const char*)HID; S.Bbase = (const char*)Wdn_t; S.b_expert = (size_t)1024 * 1024 * 2; S.rowbytes = D * 2; S.gather = false;
        pg8::EpiDown E{YR, ap->b_down, lgate};
        pg8::gemm_phase<pg8::EpiDown, pg8::MoeOrder, true, false>(lds, wave, D, D, D, S, E);
    }
    SEAM(8);

    if (IN(9)) for (int rep_ = 0; rep_ < REPS(9); ++rep_) { PH_PTRS();
        for (int tok = gw; tok < T; tok += NGW) {
            int rowk[4];
#pragma unroll
            for (int k = 0; k < 4; ++k) { const int sv = tokslot[tok * 4 + k], ee = sv >> 16; rowk[k] = etp[ee] * 256 + (sv & 0xffff); }
            const f32x4* xr = (const f32x4*)(X2 + (size_t)tok * D) + lane;
            f32x4 v[4]; float s = 0.f;
#pragma unroll
            for (int j = 0; j < 4; ++j) { v[j] = xr[64 * j];
#pragma unroll
                for (int k = 0; k < 4; ++k) { const u32x2 y = *((const u32x2*)(YR + (size_t)rowk[k] * 1024) + lane + 64 * j);
                    v[j][0] += __builtin_bit_cast(float, y.x << 16); v[j][1] += __builtin_bit_cast(float, y.x & 0xffff0000u);
                    v[j][2] += __builtin_bit_cast(float, y.y << 16); v[j][3] += __builtin_bit_cast(float, y.y & 0xffff0000u); }
                s += (v[j][0] * v[j][0] + v[j][1] * v[j][1]) + (v[j][2] * v[j][2] + v[j][3] * v[j][3]); }
            const float rstd = 1.0f / sqrtf(wave_sum(s) * (1.0f / D) + EPS);
            f32x4* op = (f32x4*)(ap->out + (size_t)tok * D) + lane; const f32x4* gr = (const f32x4*)ap->final_g + lane;
#pragma unroll
            for (int j = 0; j < 4; ++j) op[64 * j] = v[j] * rstd * gr[64 * j];
        }
    }
#undef IN
#undef SEAM
}

extern "C" void kernel_launch(void* const* d_in, const int* in_sizes, int n_in, void* d_out, int out_size, void* d_ws, size_t ws_size, hipStream_t stream) {
    static int grid = 0;
    if (grid == 0) {
        if (n_in != 26 || in_sizes[0] != T * D || out_size != T * D || ws_size < WS_END) { fprintf(stderr, "kernel_launch: unexpected shapes (n_in %d, in0 %d, out %d, ws %zu); nothing launched\n", n_in, n_in > 0 ? in_sizes[0] : -1, out_size, ws_size); grid = -1; return; }
        int dev = 0, cus = 0, per_cu = 0;
        if (hipGetDevice(&dev) != hipSuccess || hipDeviceGetAttribute(&cus, hipDeviceAttributeMultiprocessorCount, dev) != hipSuccess) { grid = -1; return; }
        if (hipFuncSetAttribute((const void*)fwd_kernel, hipFuncAttributeMaxDynamicSharedMemorySize, LDS_BYTES) != hipSuccess) { fprintf(stderr, "kernel_launch: hipFuncSetAttribute failed\n"); grid = -1; return; }
        if (hipOccupancyMaxActiveBlocksPerMultiprocessor(&per_cu, (const void*)fwd_kernel, NWAVES * 64, LDS_BYTES) != hipSuccess || per_cu < 1) { fprintf(stderr, "kernel_launch: occupancy query says %d\n", per_cu); per_cu = 1; }
        (void)hipGetLastError();
        grid = cus;
    }
    if (grid < 0) return;
    (void)hipMemsetAsync((char*)d_ws + WS_CTL, 0, CTL_BYTES, stream);
    Args a{};
    a.x = (const float*)d_in[0]; a.pos = (const int*)d_in[1]; a.mem = (const float*)d_in[2]; a.attn_g = (const float*)d_in[3]; a.w_in = (const float*)d_in[4];
    a.w_pool = (const float*)d_in[5]; a.pool_scale = (const float*)d_in[6]; a.lq1 = (const float*)d_in[7]; a.lk1 = (const float*)d_in[8]; a.lq2 = (const float*)d_in[9];
    a.lk2 = (const float*)d_in[10]; a.subln_g = (const float*)d_in[11]; a.w_out = (const float*)d_in[12]; a.xattn_g = (const float*)d_in[13]; a.mem_g = (const float*)d_in[14];
    a.w_cq = (const float*)d_in[15]; a.w_ckv = (const float*)d_in[16]; a.w_co = (const float*)d_in[17]; a.ffn_g = (const float*)d_in[18]; a.w_router = (const float*)d_in[19];
    a.b_router = (const float*)d_in[20]; a.w_gu = (const float*)d_in[21]; a.b_gu = (const float*)d_in[22]; a.w_down = (const float*)d_in[23]; a.b_down = (const float*)d_in[24];
    a.final_g = (const float*)d_in[25]; a.out = (float*)d_out; a.ws = (unsigned char*)d_ws;
    if (MK_N_LAUNCHES == 1) {
        a.ph_lo = 0; a.ph_hi = N_PHASES;
        void* args[] = {&a};
        hipError_t e = hipLaunchCooperativeKernel((const void*)fwd_kernel, dim3(grid), dim3(NWAVES * 64), args, LDS_BYTES, stream);
        if (e != hipSuccess) fprintf(stderr, "kernel_launch: cooperative launch failed: %s (grid %d)\n", hipGetErrorString(e), grid);
    } else {
        for (int p = 0; p < N_PHASES; ++p) { a.ph_lo = p; a.ph_hi = p + 1; hipLaunchKernelGGL(fwd_kernel, dim3(grid), dim3(NWAVES * 64), LDS_BYTES, stream, a); }
    }
}
```

```cpp
#include <hip/hip_runtime.h>
#include <cstdio>
#include <cstdint>

#ifndef MK_N_LAUNCHES
#define MK_N_LAUNCHES 1
#endif

#ifndef REPMASK
#define REPMASK 0
#endif
#define REPS(k) (((REPMASK >> (k)) & 1) ? 2 : 1)
#ifndef PMASK
#define PMASK 0x3ff
#endif
#define LAS __attribute__((address_space(3)))
#define GAS __attribute__((address_space(1)))

typedef unsigned short bf16_t;
typedef short bf16x8 __attribute__((ext_vector_type(8)));
typedef short s16x4 __attribute__((ext_vector_type(4)));
typedef float f32x4 __attribute__((ext_vector_type(4)));
typedef float f32x2 __attribute__((ext_vector_type(2)));
typedef float f32x16 __attribute__((ext_vector_type(16)));
typedef unsigned u32x4 __attribute__((ext_vector_type(4)));
typedef unsigned u32x2 __attribute__((ext_vector_type(2)));
typedef int i32x4 __attribute__((ext_vector_type(4)));
typedef int i32x8 __attribute__((ext_vector_type(8)));

constexpr int NB = 8, SEQ = 2048, T = NB * SEQ, D = 1024, INW = 2048, MEM = 256, NMEM = NB * MEM;
constexpr int NE = 32, TOPK = 4, CAP = 16384, MAXRT = 288;
constexpr float EPS = 1e-5f;
constexpr float LOG2E = 1.4426950408889634f;
constexpr float QSCALE_D = 0.125f * LOG2E;
constexpr float QSCALE_X = 0.0625f * LOG2E;

constexpr size_t MiB = 1u << 20;
constexpr size_t WS_CTL = 0, CTL_BYTES = 1 * MiB;
constexpr size_t WS_CS = 1 * MiB;
constexpr size_t WS_SSP = 2 * MiB;
constexpr size_t WS_RSTD2 = 3 * MiB;
constexpr size_t WS_TOKSLOT = 3 * MiB + 256 * 1024;
constexpr size_t WS_LTOK = 4 * MiB;
constexpr size_t WS_LGATE = 6 * MiB;
constexpr size_t WS_WIN = 8 * MiB;
constexpr size_t WS_WOUT = 12 * MiB;
constexpr size_t WS_WCQ = 14 * MiB;
constexpr size_t WS_WCKV = 16 * MiB;
constexpr size_t WS_WCO = 20 * MiB;
constexpr size_t WS_WGU = 24 * MiB;
constexpr size_t WS_WDN = 152 * MiB;
constexpr size_t WS_H0 = 216 * MiB;
constexpr size_t WS_MEMN = 248 * MiB;
constexpr size_t WS_KC = 252 * MiB;
constexpr size_t WS_VT = 256 * MiB;
constexpr size_t WS_U = 260 * MiB;
constexpr size_t WS_CAT = 324 * MiB;
constexpr size_t WS_X1 = 356 * MiB;
constexpr size_t WS_X1B = 420 * MiB;
constexpr size_t WS_QC = 452 * MiB;
constexpr size_t WS_PC = 484 * MiB;
constexpr size_t WS_OC = 516 * MiB;
constexpr size_t WS_X2 = 548 * MiB;
constexpr size_t WS_X2B = 612 * MiB;
constexpr size_t WS_HID = 644 * MiB;
constexpr size_t WS_Y = 788 * MiB;
constexpr size_t WS_END = 932 * MiB;
constexpr int CW_CNT = 64;
constexpr int CW_BAR = 4096;

constexpr int RING_BYTES = 131072;
constexpr int XTAB_OFF = RING_BYTES;
constexpr int ECNT_OFF = RING_BYTES + 1024;
constexpr int RT_OFF = RING_BYTES + 1536;
constexpr int MISC_OFF = RING_BYTES + 4096;
static_assert(RT_OFF + 2560 <= MISC_OFF, "LDS map");
constexpr int XE_OFF = MISC_OFF + 128;
constexpr int TOKT_OFF = MISC_OFF + 512;
constexpr int MAXU = 24;
constexpr int LDS_BYTES = 163840;
static_assert(TOKT_OFF + MAXU * 1024 <= LDS_BYTES, "LDS map");

#define LDS_WAIT() asm volatile("s_waitcnt lgkmcnt(0)" ::: "memory")
#define VM_WAIT() asm volatile("s_waitcnt vmcnt(0)" ::: "memory")
__device__ __forceinline__ unsigned f2bf(float f) { unsigned u = __builtin_bit_cast(unsigned, f); return (u + 0x7fffu + ((u >> 16) & 1u)) >> 16; }
__device__ __forceinline__ unsigned pk2(float lo, float hi) { return f2bf(lo) | (f2bf(hi) << 16); }
__device__ __forceinline__ float bf2f(unsigned short v) { return __builtin_bit_cast(float, (unsigned)v << 16); }
__device__ __forceinline__ unsigned cvt_pk_bf16(float lo, float hi) { unsigned r; asm volatile("v_cvt_pk_bf16_f32 %0, %1, %2" : "=v"(r) : "v"(lo), "v"(hi)); return r; }
__device__ __forceinline__ unsigned pk4_fp8(float a, float b, float c, float d) { int w = 0; w = __builtin_amdgcn_cvt_pk_fp8_f32(a, b, w, false); w = __builtin_amdgcn_cvt_pk_fp8_f32(c, d, w, true); return (unsigned)w; }
__device__ __forceinline__ int lane_id() { int l; asm volatile("v_mbcnt_lo_u32_b32 %0, -1, 0\n\tv_mbcnt_hi_u32_b32 %0, -1, %0" : "=v"(l)); return l; }
__device__ __forceinline__ float wave_sum(float v) {
#pragma unroll
    for (int o = 1; o < 64; o <<= 1) v += __shfl_xor(v, o);
    return v;
}

#define XB_TMO      128
#define XB_XCNT(j)  (256  + 64 * (j))
#define XB_XSUB(j)  (1280 + 64 * (j))
#define XB_XGEN(j)  (2304 + 64 * (j))
#define XB_TOP      3328
#define XB_TOPGEN   3392
#define XCD_BAR_WORDS 3456
#define XB_SPIN_CAP (1u << 18)
__device__ __forceinline__ unsigned xb_ld(unsigned* p)              { return __hip_atomic_load(p, __ATOMIC_RELAXED, __HIP_MEMORY_SCOPE_AGENT); }
__device__ __forceinline__ unsigned xb_add(unsigned* p, unsigned v) { return __hip_atomic_fetch_add(p, v, __ATOMIC_RELAXED, __HIP_MEMORY_SCOPE_AGENT); }
__device__ __forceinline__ unsigned xb_xcc_id() { return (unsigned)__builtin_amdgcn_s_getreg((3 << 11) | 20) & 0xFu; }
#define XB_SPIN(cond, bar) do { unsigned _sp = 0; while (cond) { __builtin_amdgcn_s_sleep(1); \
    if ((++_sp & 255u) == 0u) { if (xb_ld(&(bar)[XB_TMO])) break; if (_sp > XB_SPIN_CAP) { atomicAdd(&(bar)[XB_TMO], 1u); break; } } } } while (0)
struct XcdBarrier { unsigned* bar; unsigned x; volatile LAS unsigned* st; };
__device__ __forceinline__ XcdBarrier xcd_barrier_post(unsigned* bar, volatile LAS unsigned* st, int tid) {
    XcdBarrier b; b.bar = bar; b.x = xb_xcc_id(); b.st = st;
    if (tid == 0) (void)xb_add(&bar[XB_XCNT(b.x)], 1u);
    return b;
}
__device__ __forceinline__ void xcd_barrier_complete(unsigned* bar, unsigned x, unsigned& nloc, unsigned& nx) {
    const unsigned G = gridDim.x * gridDim.y * gridDim.z;
    unsigned sum, cnt, mine, sp = 0u;
    for (;;) {
        sum = 0u; cnt = 0u; mine = 0u;
#pragma unroll
        for (unsigned j = 0; j < 16; ++j) { const unsigned c = xb_ld(&bar[XB_XCNT(j)]); sum += c; cnt += (c > 0u) ? 1u : 0u; mine = (j == x) ? c : mine; }
        if (sum == G) break;
        __builtin_amdgcn_s_sleep(1);
        if ((++sp & 255u) == 0u) { if (xb_ld(&bar[XB_TMO])) break; if (sp > XB_SPIN_CAP) { atomicAdd(&bar[XB_TMO], 1u); break; } }
    }
    nloc = mine > 0u ? mine : 1u; nx = cnt > 0u ? cnt : 1u;
}
__device__ __forceinline__ void xcd_barrier(const XcdBarrier& b, int tid) {
    asm volatile("s_waitcnt vmcnt(0)" ::: "memory");
    __syncthreads();
    if (tid == 0) {
        unsigned* bar = b.bar;
        __builtin_amdgcn_s_waitcnt(0);
        unsigned nloc = b.st[0], nx = b.st[1];
        if (nloc == 0u) { xcd_barrier_complete(bar, b.x, nloc, nx); b.st[0] = nloc; b.st[1] = nx; }
        const unsigned old = xb_add(&bar[XB_XSUB(b.x)], 1u);
        const unsigned gen = old / nloc;
        if (old + 1u == (gen + 1u) * nloc) {
            __builtin_amdgcn_fence(__ATOMIC_RELEASE, "agent");
            asm volatile("s_waitcnt vmcnt(0)" ::: "memory");
            const unsigned og = xb_add(&bar[XB_TOP], 1u);
            const unsigned tg = og / nx;
            if (og + 1u == (tg + 1u) * nx) xb_add(&bar[XB_TOPGEN], 1u);
            else XB_SPIN(xb_ld(&bar[XB_TOPGEN]) == tg, bar);
            __builtin_amdgcn_fence(__ATOMIC_ACQUIRE, "agent");
            xb_add(&bar[XB_XGEN(b.x)], 1u);
            asm volatile("s_waitcnt vmcnt(0)" ::: "memory");
        } else {
            XB_SPIN(xb_ld(&bar[XB_XGEN(b.x)]) == gen, bar);
            __builtin_amdgcn_fence(__ATOMIC_ACQUIRE, "agent");
            asm volatile("s_waitcnt vmcnt(0)" ::: "memory");
        }
    }
    __syncthreads();
}
__device__ __forceinline__ void wg_global_sync(int tid) {
    asm volatile("s_waitcnt vmcnt(0)" ::: "memory");
    __syncthreads();
    if (tid == 0) { __builtin_amdgcn_fence(__ATOMIC_ACQUIRE, "agent"); asm volatile("s_waitcnt vmcnt(0)" ::: "memory"); }
    __syncthreads();
}

namespace pg8 {
constexpr int BM = 256, BK = 64, HALF = 128, HTB = HALF * BK * 2, STAGE_BYTES = 8 * HTB, NXCD = 8, WGM = 8;
__host__ __device__ __forceinline__ int lds_byte(int r, int c) { const int st = (r >> 4) * 2 + (c >> 5), rr = r & 15, cc = c & 31, ob = rr * 64 + cc * 2; return st * 1024 + (ob ^ (((ob >> 9) & 1) << 5)); }
__host__ __device__ __forceinline__ void stage_rc(int b, int& R, int& C) { const int st = b / 1024, sb = b % 1024, swz = sb ^ (((sb >> 9) & 1) << 5); R = (st >> 1) * 16 + swz / 64; C = (st & 1) * 32 + (swz % 64) / 2; }
__host__ __device__ __forceinline__ int perm32(int rho) { const int n = rho >> 4, i = rho & 15; return 8 * (i >> 2) + 4 * n + (i & 3); }

struct Unit { int pm, pn, e, r, nvalid, ui; const char* pa; const char* pb; };

struct StaticOrder {
    int nM, nN, nwg, G, c; const char* A; const char* Bt; size_t atile, btile;
    __device__ void init(const void* A_, const void* Bt_, int M, int N, int lda, int ldb, int G_, int c_) { nM = M / BM; nN = N / BM; nwg = nM * nN; G = G_; c = c_; A = (const char*)A_; Bt = (const char*)Bt_; atile = (size_t)BM * lda * 2; btile = (size_t)BM * ldb * 2; }
    __device__ bool next(int i, Unit& u) const {
        const long L = (long)i * G + c; if (L >= nwg) return false;
        int wgid = (int)L; { const int q = nwg / NXCD, r = nwg % NXCD, xcd = wgid % NXCD, off = wgid / NXCD; wgid = (xcd < r ? xcd * (q + 1) : r * (q + 1) + (xcd - r) * q) + off; }
        const int nig = WGM * nN, gid = wgid / nig, fm = gid * WGM, gsz = (nM - fm) < WGM ? (nM - fm) : WGM;
        u.pm = fm + ((wgid % nig) % gsz); u.pn = (wgid % nig) / gsz; u.e = 0; u.r = 0; u.nvalid = 256; u.ui = i;
        u.pa = A + (size_t)u.pm * atile; u.pb = Bt + (size_t)u.pn * btile; return true;
    }
    __device__ __forceinline__ unsigned row_off(const Unit&, int) const { return 0u; }
};
struct SingleUnit {
    Unit u;
    __device__ bool next(int i, Unit& o) const { if (i != 0) return false; o = u; return true; }
    __device__ __forceinline__ unsigned row_off(const Unit&, int) const { return 0u; }
};
struct MoeOrder {
    const LAS int* ecnt; const LAS int* etp; const LAS int* xe; const LAS int* tokt;
    int x, cl, nloc, npn; const char* Abase; const char* Bbase; size_t b_expert; unsigned rowbytes, b_rowbytes; bool gather;
    __device__ bool next(int i, Unit& u) const {
        int j = i * nloc + cl;
        for (int k = 0; k < 4; ++k) { const int e = __builtin_amdgcn_readfirstlane(xe[x * 4 + k]), tp0 = __builtin_amdgcn_readfirstlane(etp[e]), nrt = __builtin_amdgcn_readfirstlane(etp[e + 1]) - tp0, n = nrt * npn;
            if (j < n) { const int pn = __builtin_amdgcn_readfirstlane(j / nrt), r = j - pn * nrt; u.pm = tp0 + r; u.pn = pn; u.e = e; u.r = r; u.nvalid = min(256, __builtin_amdgcn_readfirstlane(ecnt[e]) - r * 256); u.ui = i;
                u.pa = gather ? Abase : Abase + (size_t)u.pm * 256 * rowbytes; u.pb = Bbase + (size_t)e * b_expert + (size_t)pn * 256 * b_rowbytes; return true; }
            j -= n; }
        return false;
    }
    __device__ __forceinline__ unsigned row_off(const Unit& uu, int r) const { return (unsigned)tokt[uu.ui * 256 + r] * rowbytes; }
};

template <class Epi, class Sched, bool ALIGN_EPI, bool GATHER, bool F8>
__device__ __forceinline__ void gemm_phase(LAS unsigned char* lds, const int wv, const int KB, const int ldaB, const int ldbB, const Sched& S, const Epi& E) {
    int tid_ = wv * 64 + lane_id(); asm volatile("" : "+v"(tid_));
    const int tid = tid_, wid = __builtin_amdgcn_readfirstlane(tid >> 6), lane = tid & 63, wr = wid >> 2, wc = wid & 3, fr = lane & 15, fq = lane >> 4;
    const int nt = KB / 128;
    Unit cur, nxt; int ui = 0;
    if (!S.next(0, cur)) return;
    unsigned voffA[GATHER ? 2 : 1][2], voffB[2];
#pragma unroll
    for (int i = 0; i < 2; ++i) { int R, C; stage_rc(tid * 16 + i * 8192, R, C); const int Rb = Epi::PERM ? ((R & ~31) + perm32(R & 31)) : R;
        if constexpr (GATHER) { voffA[0][i] = S.row_off(cur, R) + (unsigned)C * 2u; voffA[1][i] = S.row_off(cur, R + HALF) + (unsigned)C * 2u; }
        else { voffA[0][i] = (unsigned)(R * ldaB + C * 2); }
        voffB[i] = (unsigned)(Rb * ldbB + C * 2); }
    const size_t kstep = (size_t)(BK * 2);
    const size_t hstepA = GATHER ? (size_t)0 : (size_t)HALF * ldaB, hstepB = (size_t)HALF * ldbB;
    const unsigned ldsw = (unsigned)wid * 1024u;
    const int aoff = lds_byte(wr * 64 + fr, fq * 8), boff = lds_byte(wc * 32 + fr, fq * 8);
#define PG8_SA(b, h) (((b) * 2 + (h)) * HTB)
#define PG8_SB(b, h) ((4 + (b) * 2 + (h)) * HTB)
#define PG8_STAGE(bufoff, gbase, voff) do { _Pragma("unroll") for (int _i = 0; _i < 2; ++_i) \
        __builtin_amdgcn_global_load_lds((const unsigned*)((const char*)(gbase) + (voff)[_i]), (LAS unsigned*)(lds + (bufoff) + ldsw + _i * 8192), 16, 0, 0); } while (0)
#define PG8_STAGEA(bufoff, gbase, h) PG8_STAGE(bufoff, (gbase) + (h) * hstepA, voffA[GATHER ? (h) : 0])
#define PG8_STAGEB(bufoff, gbase, h) PG8_STAGE(bufoff, (gbase) + (h) * hstepB, voffB)
#define PG8_RD(off) (*(const LAS i32x4*)(lds + (off)))
#define PG8_CAT8(x0, x1) __builtin_shufflevector(x0, x1, 0, 1, 2, 3, 4, 5, 6, 7)
#define PG8_LDA(dst, b, h) do { if constexpr (F8) { _Pragma("unroll") for (int m = 0; m < 4; ++m) { const i32x4 l_ = PG8_RD(PG8_SA(b, h) + aoff + m * 2048), h_ = PG8_RD(PG8_SA(b, h) + aoff + m * 2048 + 1024); dst##8[m] = PG8_CAT8(l_, h_); } } \
        else { _Pragma("unroll") for (int m = 0; m < 4; ++m) _Pragma("unroll") for (int k = 0; k < 2; ++k) dst[m][k] = *(const LAS bf16x8*)(lds + PG8_SA(b, h) + aoff + m * 2048 + k * 1024); } } while (0)
#define PG8_LDB(dst, b, h) do { if constexpr (F8) { _Pragma("unroll") for (int n = 0; n < 2; ++n) { const i32x4 l_ = PG8_RD(PG8_SB(b, h) + boff + n * 2048), h_ = PG8_RD(PG8_SB(b, h) + boff + n * 2048 + 1024); dst##8[n] = PG8_CAT8(l_, h_); } } \
        else { _Pragma("unroll") for (int n = 0; n < 2; ++n) _Pragma("unroll") for (int k = 0; k < 2; ++k) dst[n][k] = *(const LAS bf16x8*)(lds + PG8_SB(b, h) + boff + n * 2048 + k * 1024); } } while (0)
#define PG8_MMA(ai, bj, At, Bt) do { __builtin_amdgcn_s_setprio(1); \
        if constexpr (F8) { _Pragma("unroll") for (int m = 0; m < 4; ++m) _Pragma("unroll") for (int n = 0; n < 2; ++n) \
            acc[ai][bj][m][n] = __builtin_amdgcn_mfma_scale_f32_16x16x128_f8f6f4(Bt##8[n], At##8[m], acc[ai][bj][m][n], 0, 0, 0, 0x7f7f7f7f, 0, 0x7f7f7f7f); } \
        else { _Pragma("unroll") for (int m = 0; m < 4; ++m) _Pragma("unroll") for (int n = 0; n < 2; ++n) _Pragma("unroll") for (int k = 0; k < 2; ++k) \
            acc[ai][bj][m][n] = __builtin_amdgcn_mfma_f32_16x16x32_bf16(Bt[n][k], At[m][k], acc[ai][bj][m][n], 0, 0, 0); } \
        __builtin_amdgcn_s_setprio(0); } while (0)
#define PG8_WAIT_V(n) asm volatile("s_waitcnt vmcnt(" #n ")" ::: "memory")
#define PG8_WAIT_L(n) asm volatile("s_waitcnt lgkmcnt(" #n ")" ::: "memory")
#define PG8_BAR __builtin_amdgcn_s_barrier()
#define PG8_SCHED __builtin_amdgcn_sched_barrier(0)
    f32x4 acc[2][2][4][2];
#pragma unroll
    for (int a = 0; a < 2; ++a)
#pragma unroll
        for (int b = 0; b < 2; ++b)
#pragma unroll
            for (int m = 0; m < 4; ++m)
#pragma unroll
                for (int n = 0; n < 2; ++n) acc[a][b][m][n] = (f32x4){0.f, 0.f, 0.f, 0.f};
    bf16x8 At[4][2], B0[2][2], B1[2][2]; i32x8 At8[4], B08[2], B18[2]; (void)At; (void)B0; (void)B1; (void)At8; (void)B08; (void)B18;
    const char* cA = cur.pa; const char* cB = cur.pb;
    PG8_STAGEB(PG8_SB(0, 0), cB, 0); PG8_STAGEB(PG8_SB(0, 1), cB, 1); PG8_STAGEA(PG8_SA(0, 0), cA, 0); PG8_STAGEA(PG8_SA(0, 1), cA, 1);
    if (wr == 1) PG8_BAR;
    PG8_WAIT_V(2); PG8_BAR;
    PG8_STAGEB(PG8_SB(1, 0), cB + kstep, 0); PG8_STAGEA(PG8_SA(1, 0), cA + kstep, 0); PG8_STAGEB(PG8_SB(1, 1), cB + kstep, 1);
    PG8_WAIT_V(6); PG8_BAR;
    for (;;) {
        const bool has_next = S.next(ui + 1, nxt);
        const char* nA = has_next ? nxt.pa : cA; const char* nB = has_next ? nxt.pb : cB;
#pragma unroll 1
        for (int t = 0; t < nt; t += 2) {
            const bool last = (t == nt - 2);
            const char* a1 = cA + (size_t)(t + 1) * kstep;
            const char* a2 = last ? nA : cA + (size_t)(t + 2) * kstep; const char* b2 = last ? nB : cB + (size_t)(t + 2) * kstep;
            const char* a3 = a2 + kstep; const char* b3 = b2 + kstep;
            PG8_LDB(B0, 0, 0); PG8_LDB(B1, 0, 1); PG8_SCHED; PG8_LDA(At, 0, 0); PG8_STAGEA(PG8_SA(1, 1), a1, 1);
            if constexpr (GATHER) { if (last && has_next) {
#pragma unroll
                for (int i = 0; i < 2; ++i) { int R, C; stage_rc(tid * 16 + i * 8192, R, C); voffA[0][i] = S.row_off(nxt, R) + (unsigned)C * 2u; voffA[1][i] = S.row_off(nxt, R + HALF) + (unsigned)C * 2u; } } }
            PG8_WAIT_V(8); PG8_WAIT_L(0); PG8_BAR; PG8_MMA(0, 0, At, B0); PG8_MMA(0, 1, At, B1); PG8_BAR; PG8_SCHED;
            PG8_LDA(At, 0, 1); PG8_STAGEB(PG8_SB(0, 0), b2, 0); PG8_STAGEB(PG8_SB(0, 1), b2, 1); PG8_STAGEA(PG8_SA(0, 0), a2, 0);
            PG8_WAIT_V(8); PG8_WAIT_L(0); PG8_BAR; PG8_MMA(1, 0, At, B0); PG8_MMA(1, 1, At, B1); PG8_BAR; PG8_SCHED;
            PG8_LDB(B0, 1, 0); PG8_LDB(B1, 1, 1); PG8_SCHED; PG8_LDA(At, 1, 0); PG8_STAGEA(PG8_SA(0, 1), a2, 1);
            PG8_WAIT_V(8); PG8_WAIT_L(0); PG8_BAR; PG8_MMA(0, 0, At, B0); PG8_MMA(0, 1, At, B1); PG8_BAR; PG8_SCHED;
            PG8_LDA(At, 1, 1); PG8_STAGEB(PG8_SB(1, 0), b3, 0); PG8_STAGEB(PG8_SB(1, 1), b3, 1); PG8_STAGEA(PG8_SA(1, 0), a3, 0);
            PG8_WAIT_V(8); PG8_WAIT_L(0); PG8_BAR; PG8_MMA(1, 0, At, B0); PG8_MMA(1, 1, At, B1); PG8_BAR; PG8_SCHED;
        }
        if constexpr (ALIGN_EPI) { if (wr == 0) PG8_BAR; }
        if constexpr (!Epi::AFTER_DRAIN) { int fr_ = fr, fq_ = fq; asm volatile("" : "+v"(fr_), "+v"(fq_));
            E(acc, cur, wr, wc, fr_, fq_); }
        if (!has_next) break;
#pragma unroll
        for (int a = 0; a < 2; ++a)
#pragma unroll
            for (int b = 0; b < 2; ++b)
#pragma unroll
                for (int m = 0; m < 4; ++m)
#pragma unroll
                    for (int n = 0; n < 2; ++n) acc[a][b][m][n] = (f32x4){0.f, 0.f, 0.f, 0.f};
        cur = nxt; cA = nA; cB = nB; ++ui;
        if constexpr (ALIGN_EPI) { if (wr == 1) PG8_BAR; }
    }
    PG8_WAIT_V(0);
    if constexpr (!ALIGN_EPI) { if (wr == 0) PG8_BAR; }
    PG8_BAR;
    if constexpr (Epi::AFTER_DRAIN) { int fr_ = fr, fq_ = fq; asm volatile("" : "+v"(fr_), "+v"(fq_)); E.fused(acc, cur, wr, wc, fr_, fq_, lds, wid, lane); }
#undef PG8_SA
#undef PG8_SB
#undef PG8_STAGE
#undef PG8_STAGEA
#undef PG8_STAGEB
#undef PG8_LDA
#undef PG8_LDB
#undef PG8_MMA
#undef PG8_CAT8
#undef PG8_RD
#undef PG8_WAIT_V
#undef PG8_WAIT_L
#undef PG8_BAR
#undef PG8_SCHED
}

typedef const f32x4 (&AccC)[2][2][4][2];
typedef f32x4 (&AccM)[2][2][4][2];

struct EpiInProj {
    static constexpr bool PERM = true, AFTER_DRAIN = false;
    bf16_t* U; const float* cs;
    __device__ __forceinline__ void operator()(AccC acc, const Unit& u, int wr, int wc, int fr, int fq) const {
        const int row0 = u.pm * BM + wr * 64 + fr, col0 = u.pn * BM + wc * 32 + 8 * fq;
        const bool rot = (u.pn >= 2) && (u.pn < 6) && ((wc & 1) == 0) && (fq < 2);
        const float sc = (u.pn == 2 || u.pn == 3) ? QSCALE_D : 1.f;
#pragma unroll
        for (int ai = 0; ai < 2; ++ai)
#pragma unroll
            for (int m = 0; m < 4; ++m) {
                const int row = row0 + ai * HALF + m * 16;
                f32x4 c0 = (f32x4){1.f, 0.f, 1.f, 0.f}, c1 = (f32x4){1.f, 0.f, 1.f, 0.f};
                if (rot) { const f32x4* cp = (const f32x4*)(cs + (size_t)row * 16 + 8 * fq); c0 = cp[0]; c1 = cp[1]; }
                bf16_t* rowp = U + (size_t)row * INW + col0;
#pragma unroll
                for (int bj = 0; bj < 2; ++bj) {
                    f32x4 v0 = acc[ai][bj][m][0], v1 = acc[ai][bj][m][1];
                    f32x4 w0, w1;
                    w0[0] = v0[0] * c0[0] - v0[1] * c0[1]; w0[1] = v0[1] * c0[0] + v0[0] * c0[1];
                    w0[2] = v0[2] * c0[2] - v0[3] * c0[3]; w0[3] = v0[3] * c0[2] + v0[2] * c0[3];
                    w1[0] = v1[0] * c1[0] - v1[1] * c1[1]; w1[1] = v1[1] * c1[0] + v1[0] * c1[1];
                    w1[2] = v1[2] * c1[2] - v1[3] * c1[3]; w1[3] = v1[3] * c1[2] + v1[2] * c1[3];
                    w0 = w0 * sc; w1 = w1 * sc;
                    u32x4 w; w.x = cvt_pk_bf16(w0[0], w0[1]); w.y = cvt_pk_bf16(w0[2], w0[3]); w.z = cvt_pk_bf16(w1[0], w1[1]); w.w = cvt_pk_bf16(w1[2], w1[3]);
                    *(u32x4*)(rowp + bj * HALF) = w; }
            }
    }
};
struct EpiBf16 {
    static constexpr bool PERM = true, AFTER_DRAIN = false;
    bf16_t* O; int ldc; const LAS float* rs; float mul;
    __device__ __forceinline__ void operator()(AccC acc, const Unit& u, int wr, int wc, int fr, int fq) const {
        const int rt0 = wr * 64 + fr, col0 = u.pn * BM + wc * 32 + 8 * fq;
#pragma unroll
        for (int ai = 0; ai < 2; ++ai)
#pragma unroll
            for (int m = 0; m < 4; ++m) {
                const int rt = rt0 + ai * HALF + m * 16;
                const float s = rs ? rs[rt] * mul : mul;
                bf16_t* rowp = O + (size_t)(u.pm * BM + rt) * ldc + col0;
#pragma unroll
                for (int bj = 0; bj < 2; ++bj) { const f32x4 v0 = acc[ai][bj][m][0] * s, v1 = acc[ai][bj][m][1] * s;
                    u32x4 w; w.x = cvt_pk_bf16(v0[0], v0[1]); w.y = cvt_pk_bf16(v0[2], v0[3]); w.z = cvt_pk_bf16(v1[0], v1[1]); w.w = cvt_pk_bf16(v1[2], v1[3]);
                    *(u32x4*)(rowp + bj * HALF) = w; }
            }
    }
};
template <bool F8OUT> struct EpiRes {
    static constexpr bool PERM = false, AFTER_DRAIN = false;
    const float* resid; float* xo; void* xb; float* ssp;
    __device__ __forceinline__ void operator()(AccC acc, const Unit& u, int wr, int wc, int fr, int fq) const {
        const int row0 = u.pm * BM + wr * 64 + fr, col0 = u.pn * BM + wc * 32 + 4 * fq;
#pragma unroll
        for (int ai = 0; ai < 2; ++ai)
#pragma unroll
            for (int m = 0; m < 4; ++m) {
                const int row = row0 + ai * HALF + m * 16; const size_t off = (size_t)row * D + col0; float ss = 0.f;
#pragma unroll
                for (int bj = 0; bj < 2; ++bj)
#pragma unroll
                    for (int n = 0; n < 2; ++n) { const size_t o2 = off + bj * HALF + n * 16; const f32x4 v = *(const f32x4*)(resid + o2) + acc[ai][bj][m][n];
                        *(f32x4*)(xo + o2) = v; ss += (v[0] * v[0] + v[1] * v[1]) + (v[2] * v[2] + v[3] * v[3]);
                        if constexpr (F8OUT) { *(unsigned*)((unsigned char*)xb + o2) = pk4_fp8(v[0], v[1], v[2], v[3]); }
                        else { u32x2 w; w.x = cvt_pk_bf16(v[0], v[1]); w.y = cvt_pk_bf16(v[2], v[3]); *(u32x2*)((bf16_t*)xb + o2) = w; } }
                if (ssp) { ss += __shfl_xor(ss, 16); ss += __shfl_xor(ss, 32); if (fq == 0) ssp[(size_t)(u.pn * 4 + wc) * T + row] = ss; }
            }
    }
};
struct EpiSoftmax {
    static constexpr bool PERM = true, AFTER_DRAIN = true;
    bf16_t* O; int ldc;
    __device__ __forceinline__ void fused(AccM acc, const Unit& u, int wr, int wc, int fr, int fq, LAS unsigned char* lds, int wid, int lane) const {
        LAS float* PM = (LAS float*)lds; LAS float* PS = (LAS float*)(lds + 4096);
#pragma unroll
        for (int ai = 0; ai < 2; ++ai)
#pragma unroll
            for (int m = 0; m < 4; ++m) { float v = -INFINITY;
#pragma unroll
                for (int bj = 0; bj < 2; ++bj)
#pragma unroll
                    for (int n = 0; n < 2; ++n) { const f32x4 x = acc[ai][bj][m][n]; v = fmaxf(v, fmaxf(fmaxf(x[0], x[1]), fmaxf(x[2], x[3]))); }
                v = fmaxf(v, __shfl_xor(v, 16)); v = fmaxf(v, __shfl_xor(v, 32));
                if (fq == 0) PM[(ai * HALF + wr * 64 + m * 16 + fr) * 4 + wc] = v; }
        LDS_WAIT(); __builtin_amdgcn_s_barrier(); asm volatile("" ::: "memory");
#pragma unroll
        for (int ai = 0; ai < 2; ++ai)
#pragma unroll
            for (int m = 0; m < 4; ++m) { const int rt = ai * HALF + wr * 64 + m * 16 + fr; const f32x4 q = *(const LAS f32x4*)(PM + rt * 4);
                const float mx = fmaxf(fmaxf(q[0], q[1]), fmaxf(q[2], q[3])); float s = 0.f;
#pragma unroll
                for (int bj = 0; bj < 2; ++bj)
#pragma unroll
                    for (int n = 0; n < 2; ++n) { f32x4 x = acc[ai][bj][m][n];
                        x[0] = __builtin_amdgcn_exp2f(x[0] - mx); x[1] = __builtin_amdgcn_exp2f(x[1] - mx); x[2] = __builtin_amdgcn_exp2f(x[2] - mx); x[3] = __builtin_amdgcn_exp2f(x[3] - mx);
                        s += (x[0] + x[1]) + (x[2] + x[3]); acc[ai][bj][m][n] = x; }
                s += __shfl_xor(s, 16); s += __shfl_xor(s, 32);
                if (fq == 0) PS[rt * 4 + wc] = s; }
        LDS_WAIT(); __builtin_amdgcn_s_barrier(); asm volatile("" ::: "memory");
        const int col0 = u.pn * BM + wc * 32 + 8 * fq;
#pragma unroll
        for (int ai = 0; ai < 2; ++ai)
#pragma unroll
            for (int m = 0; m < 4; ++m) { const int rt = ai * HALF + wr * 64 + m * 16 + fr; const f32x4 q = *(const LAS f32x4*)(PS + rt * 4);
                const float inv = 1.0f / ((q[0] + q[1]) + (q[2] + q[3]));
                bf16_t* rowp = O + (size_t)(u.pm * BM + rt) * ldc + col0;
#pragma unroll
                for (int bj = 0; bj < 2; ++bj) { const f32x4 v0 = acc[ai][bj][m][0] * inv, v1 = acc[ai][bj][m][1] * inv;
                    u32x4 w; w.x = cvt_pk_bf16(v0[0], v0[1]); w.y = cvt_pk_bf16(v0[2], v0[3]); w.z = cvt_pk_bf16(v1[0], v1[1]); w.w = cvt_pk_bf16(v1[2], v1[3]);
                    *(u32x4*)(rowp + bj * HALF) = w; }
            }
        LDS_WAIT(); __builtin_amdgcn_s_barrier(); asm volatile("" ::: "memory");
    }
};
struct EpiSwiGLU {
    static constexpr bool PERM = true, AFTER_DRAIN = false;
    unsigned char* H; const float* bgu; const float* rstd; const LAS int* tokt;
    __device__ __forceinline__ void operator()(AccC acc, const Unit& u, int wr, int wc, int fr, int fq) const {
        const int rt0 = wr * 64 + fr, c0 = u.pn * HALF + wc * 32 + 8 * fq; const float* bg_ = bgu + (size_t)u.e * 2048;
        f32x4 bg[2], bu[2];
#pragma unroll
        for (int n = 0; n < 2; ++n) { bg[n] = *(const f32x4*)(bg_ + c0 + 4 * n); bu[n] = *(const f32x4*)(bg_ + 1024 + c0 + 4 * n); }
#pragma unroll
        for (int ai = 0; ai < 2; ++ai)
#pragma unroll
            for (int m = 0; m < 4; ++m) {
                const int rt = rt0 + ai * HALF + m * 16;
                const float rs = rstd[tokt[u.ui * 256 + rt]] * 0.03125f;
                unsigned w[2];
#pragma unroll
                for (int n = 0; n < 2; ++n) { const f32x4 g4 = acc[ai][0][m][n] * rs + bg[n], u4 = acc[ai][1][m][n] * rs + bu[n]; float h[4];
#pragma unroll
                    for (int j = 0; j < 4; ++j) { const float g = fminf(g4[j], 7.0f), up = fminf(fmaxf(u4[j], -7.0f), 7.0f);
                        const float sg = __builtin_amdgcn_rcpf(1.0f + __builtin_amdgcn_exp2f(-1.702f * LOG2E * g)); h[j] = (up + 1.0f) * g * sg; }
                    w[n] = pk4_fp8(h[0] * 4.0f, h[1] * 4.0f, h[2] * 4.0f, h[3] * 4.0f); }
                *(u32x2*)(H + (size_t)(u.pm * BM + rt) * 1024 + c0) = (u32x2){w[0], w[1]};
            }
    }
};
struct EpiDown {
    static constexpr bool PERM = true, AFTER_DRAIN = false;
    bf16_t* Y; const float* bd; const float* gates;
    __device__ __forceinline__ void operator()(AccC acc, const Unit& u, int wr, int wc, int fr, int fq) const {
        const int rt0 = wr * 64 + fr, col0 = u.pn * BM + wc * 32 + 8 * fq; const float* bd_ = bd + (size_t)u.e * 1024; const float* gt_ = gates + (size_t)u.e * CAP + u.r * 256;
        f32x4 bv[2][2];
#pragma unroll
        for (int bj = 0; bj < 2; ++bj)
#pragma unroll
            for (int n = 0; n < 2; ++n) bv[bj][n] = *(const f32x4*)(bd_ + col0 + bj * HALF + 4 * n);
#pragma unroll
        for (int ai = 0; ai < 2; ++ai)
#pragma unroll
            for (int m = 0; m < 4; ++m) {
                const int rt = rt0 + ai * HALF + m * 16;
                const float g = (rt < u.nvalid) ? gt_[rt] : 0.f;
                bf16_t* rowp = Y + (size_t)(u.pm * BM + rt) * 1024 + col0;
#pragma unroll
                for (int bj = 0; bj < 2; ++bj) { const f32x4 v0 = (acc[ai][bj][m][0] * 0.0078125f + bv[bj][0]) * g, v1 = (acc[ai][bj][m][1] * 0.0078125f + bv[bj][1]) * g;
                    u32x4 w; w.x = cvt_pk_bf16(v0[0], v0[1]); w.y = cvt_pk_bf16(v0[2], v0[3]); w.z = cvt_pk_bf16(v1[0], v1[1]); w.w = cvt_pk_bf16(v1[2], v1[3]);
                    *(u32x4*)(rowp + bj * HALF) = w; }
            }
    }
};
}

struct Args {
    const float* x; const int* pos; const float* mem; const float* attn_g; const float* w_in; const float* w_pool; const float* pool_scale;
    const float* lq1; const float* lk1; const float* lq2; const float* lk2; const float* subln_g; const float* w_out; const float* xattn_g; const float* mem_g;
    const float* w_cq; const float* w_ckv; const float* w_co; const float* ffn_g; const float* w_router; const float* b_router; const float* w_gu; const float* b_gu;
    const float* w_down; const float* b_down; const float* final_g;
    float* out; unsigned char* ws; int ph_lo, ph_hi;
};

template <int MAP>
__device__ __forceinline__ int rowmap(int c) {
    if (MAP == 1) { if (c >= 512 && c < 1536) { const int d = c & 63; if (d < 16) return (c & ~63) + ((d < 8) ? 2 * d : 2 * (d - 8) + 1); } return c; }
    if (MAP == 2) { const int j = c & 1023; return ((j >> 7) << 8) + ((c >> 10) << 7) + (j & 127); }
    return c;
}
template <int MAP, bool OUT8>
__device__ __forceinline__ void p0_transpose_stream(const float* W, int K, int N, int nmat, void* WTv, int ldt, int kdst0, size_t dst_stride, const float* g, LAS float* scr, int gw, int NGW, int lane) {
    const int nblk = N / 32, ipm = (K / 64) * nblk, nitems = nmat * ipm;
    const int lr = lane >> 3, lc = (lane & 7) * 4;
    f32x4 cur[8], nxt[8];
#define P0_LOAD(dst, it) do { const int e_ = (it) / ipm, r_ = (it) % ipm, kb_ = r_ / nblk, nb_ = r_ % nblk; const float* p_ = W + ((size_t)e_ * K + 64 * kb_ + lr) * N + 32 * nb_ + lc; \
        _Pragma("unroll") for (int i_ = 0; i_ < 8; ++i_) dst[i_] = *(const f32x4*)(p_ + (size_t)(8 * i_) * N); } while (0)
    int it = gw;
    if (it < nitems) P0_LOAD(cur, it);
    while (it < nitems) {
        const int itn = it + NGW;
        if (itn < nitems) P0_LOAD(nxt, itn);
        const int e = it / ipm, r = it % ipm, kb = r / nblk, nb = r % nblk, k0 = 64 * kb, n0 = 32 * nb;
#pragma unroll
        for (int i = 0; i < 8; ++i) { const int kk = 8 * i + lr; f32x4 v = cur[i]; if (g) v = v * g[k0 + kk];
            LAS float* s = scr + kk * 33 + lc; s[0] = v[0]; s[1] = v[1]; s[2] = v[2]; s[3] = v[3]; }
        LDS_WAIT(); asm volatile("" ::: "memory");
        if constexpr (OUT8) {
            const int c = lane & 3; unsigned char* wt = (unsigned char*)WTv + (size_t)e * dst_stride;
#pragma unroll
            for (int j = 0; j < 2; ++j) { const int n = (lane >> 2) + 16 * j; const LAS float* s = scr + (16 * c) * 33 + n;
                u32x4 o; o.x = pk4_fp8(s[0 * 33] * 32.f, s[1 * 33] * 32.f, s[2 * 33] * 32.f, s[3 * 33] * 32.f); o.y = pk4_fp8(s[4 * 33] * 32.f, s[5 * 33] * 32.f, s[6 * 33] * 32.f, s[7 * 33] * 32.f);
                o.z = pk4_fp8(s[8 * 33] * 32.f, s[9 * 33] * 32.f, s[10 * 33] * 32.f, s[11 * 33] * 32.f); o.w = pk4_fp8(s[12 * 33] * 32.f, s[13 * 33] * 32.f, s[14 * 33] * 32.f, s[15 * 33] * 32.f);
                *(u32x4*)(wt + (size_t)rowmap<MAP>(n0 + n) * ldt + kdst0 + k0 + 16 * c) = o; }
        } else {
            const int c = lane & 7; bf16_t* wt = (bf16_t*)WTv + (size_t)e * dst_stride;
#pragma unroll
            for (int j = 0; j < 4; ++j) { const int n = (lane >> 3) + 8 * j; const LAS float* s = scr + (8 * c) * 33 + n;
                u32x4 o; o.x = pk2(s[0 * 33], s[1 * 33]); o.y = pk2(s[2 * 33], s[3 * 33]); o.z = pk2(s[4 * 33], s[5 * 33]); o.w = pk2(s[6 * 33], s[7 * 33]);
                *(u32x4*)(wt + (size_t)rowmap<MAP>(n0 + n) * ldt + kdst0 + k0 + 8 * c) = o; }
        }
        LDS_WAIT(); asm volatile("" ::: "memory");
#pragma unroll
        for (int i = 0; i < 8; ++i) cur[i] = nxt[i];
        it = itn;
    }
#undef P0_LOAD
}
__device__ __forceinline__ void rms_row_to_bf16(const float* xrow, const float* g, bf16_t* orow, int lane) {
    const f32x4* xr = (const f32x4*)xrow + lane; const f32x4* gr = (const f32x4*)g + lane;
    f32x4 v[4]; float s = 0.f;
#pragma unroll
    for (int j = 0; j < 4; ++j) { v[j] = xr[64 * j]; s += (v[j][0] * v[j][0] + v[j][1] * v[j][1]) + (v[j][2] * v[j][2] + v[j][3] * v[j][3]); }
    const float rstd = 1.0f / sqrtf(wave_sum(s) * (1.0f / D) + EPS);
    u32x2* o8 = (u32x2*)orow + lane;
#pragma unroll
    for (int j = 0; j < 4; ++j) { const f32x4 gg = gr[64 * j]; u32x2 w; w.x = pk2(v[j][0] * rstd * gg[0], v[j][1] * rstd * gg[1]); w.y = pk2(v[j][2] * rstd * gg[2], v[j][3] * rstd * gg[3]); o8[64 * j] = w; }
}

namespace dattn {
constexpr int KP = 144, VP = 320;
constexpr int K_BYTES = 2 * 64 * KP, V_BYTES = 64 * VP, STG = K_BYTES + V_BYTES;
__device__ __forceinline__ s16x4 vtr(const LAS unsigned char* p) { typedef short v4i16_t __attribute__((ext_vector_type(4))); return __builtin_bit_cast(s16x4, __builtin_amdgcn_ds_read_tr16_b64_v4i16((LAS v4i16_t*)p)); }
__device__ __forceinline__ void unit(LAS unsigned char* lds, const int wv, const bf16_t* U, bf16_t* CAT, const float* subln_g, float lam, int b, int hh, int j) {
    int tid_ = wv * 64 + lane_id(); asm volatile("" : "+v"(tid_));
    const int tid = tid_, lane = tid & 63, r32 = lane & 31, hi = lane >> 5; const int wid = __builtin_amdgcn_readfirstlane(tid >> 6);
    const int mp = wid & 1, rg = wid >> 1;
    const size_t tok0 = (size_t)b * SEQ;
    const int q0 = j * 128 + rg * 32;
    const int nt_all = 2 * j + 2, nt_mine = (rg < 2) ? nt_all - 1 : nt_all;
    bf16x8 qf[4];
    { const bf16_t* qp = U + (tok0 + q0 + r32) * INW + 512 + hh * 128 + mp * 64 + hi * 8;
#pragma unroll
      for (int ks = 0; ks < 4; ++ks) qf[ks] = *(const bf16x8*)(qp + ks * 16); }
    const int prow = tid >> 3, pc0 = (tid & 7) * 2;
    const bf16_t* kg = U + (tok0 + prow) * INW + 1024 + hh * 128 + pc0 * 8;
    const bf16_t* vg = U + (tok0 + prow) * INW + 1536 + hh * 128 + pc0 * 8;
    unsigned kdst[2], vdst[2];
#pragma unroll
    for (int i = 0; i < 2; ++i) { const int c16 = pc0 + i; kdst[i] = (unsigned)((c16 >> 3) * (64 * KP) + prow * KP + (c16 & 7) * 16); vdst[i] = (unsigned)(K_BYTES + prow * VP + c16 * 16); }
    u32x4 kr[2], vr[2];
#define DA_LOAD(t) do { const size_t go = (size_t)(t) * 64 * INW; kr[0] = *(const u32x4*)(kg + go); kr[1] = *(const u32x4*)(kg + go + 8); vr[0] = *(const u32x4*)(vg + go); vr[1] = *(const u32x4*)(vg + go + 8); } while (0)
#define DA_WRITE(s) do { LAS unsigned char* sb = lds + (s) * STG; *(LAS u32x4*)(sb + kdst[0]) = kr[0]; *(LAS u32x4*)(sb + kdst[1]) = kr[1]; *(LAS u32x4*)(sb + vdst[0]) = vr[0]; *(LAS u32x4*)(sb + vdst[1]) = vr[1]; } while (0)
    f32x16 o[4];
#pragma unroll
    for (int d0 = 0; d0 < 4; ++d0)
#pragma unroll
        for (int r = 0; r < 16; ++r) o[d0][r] = 0.f;
    float mrun = -INFINITY, lrun = 0.f;
    const int i16 = lane & 15, g16 = (lane >> 4) & 1;
    const unsigned kbase = (unsigned)(mp * (64 * KP) + r32 * KP + hi * 16);
    const unsigned vbase = (unsigned)(K_BYTES + (4 * hi + (i16 >> 2)) * VP + (16 * g16 + 4 * (i16 & 3)) * 2);
    DA_LOAD(0); DA_WRITE(0);
    __syncthreads();
    for (int kt = 0; kt < nt_all; ++kt) {
        const bool more = (kt + 1 < nt_all);
        if (more) DA_LOAD(kt + 1);
        if (kt < nt_mine) {
            const LAS unsigned char* sb = lds + (kt & 1) * STG;
            f32x16 p0, p1;
#pragma unroll
            for (int r = 0; r < 16; ++r) { p0[r] = 0.f; p1[r] = 0.f; }
#pragma unroll
            for (int ks = 0; ks < 4; ++ks) {
                const bf16x8 k0 = *(const LAS bf16x8*)(sb + kbase + ks * 32), k1 = *(const LAS bf16x8*)(sb + kbase + 32 * KP + ks * 32);
                p0 = __builtin_amdgcn_mfma_f32_32x32x16_bf16(k0, qf[ks], p0, 0, 0, 0);
                p1 = __builtin_amdgcn_mfma_f32_32x32x16_bf16(k1, qf[ks], p1, 0, 0, 0);
            }
            float mx = fmaxf(p0[0], p1[0]);
#pragma unroll
            for (int r = 1; r < 16; ++r) mx = fmaxf(mx, fmaxf(p0[r], p1[r]));
            mx = fmaxf(mx, __shfl_xor(mx, 32));
            const float mnew = fmaxf(mrun, mx), alpha = __builtin_amdgcn_exp2f(mrun - mnew); mrun = mnew;
            float ls = 0.f;
#pragma unroll
            for (int r = 0; r < 16; ++r) { p0[r] = __builtin_amdgcn_exp2f(p0[r] - mnew); p1[r] = __builtin_amdgcn_exp2f(p1[r] - mnew); ls += p0[r] + p1[r]; }
            lrun = lrun * alpha + ls;
#pragma unroll
            for (int d0 = 0; d0 < 4; ++d0)
#pragma unroll
                for (int r = 0; r < 16; ++r) o[d0][r] *= alpha;
            bf16x8 pf[4];
#pragma unroll
            for (int s = 0; s < 4; ++s) { u32x4 w;
                if (s < 2) { w.x = cvt_pk_bf16(p0[8 * s + 0], p0[8 * s + 1]); w.y = cvt_pk_bf16(p0[8 * s + 2], p0[8 * s + 3]); w.z = cvt_pk_bf16(p0[8 * s + 4], p0[8 * s + 5]); w.w = cvt_pk_bf16(p0[8 * s + 6], p0[8 * s + 7]); }
                else { const int s2 = s - 2; w.x = cvt_pk_bf16(p1[8 * s2 + 0], p1[8 * s2 + 1]); w.y = cvt_pk_bf16(p1[8 * s2 + 2], p1[8 * s2 + 3]); w.z = cvt_pk_bf16(p1[8 * s2 + 4], p1[8 * s2 + 5]); w.w = cvt_pk_bf16(p1[8 * s2 + 6], p1[8 * s2 + 7]); }
                pf[s] = __builtin_bit_cast(bf16x8, w); }
#pragma unroll
            for (int d0 = 0; d0 < 4; ++d0)
#pragma unroll
                for (int s = 0; s < 4; ++s) {
                    const s16x4 lo = vtr(sb + vbase + s * 16 * VP + d0 * 64), hv = vtr(sb + vbase + s * 16 * VP + 8 * VP + d0 * 64);
                    const bf16x8 vf = (bf16x8){lo[0], lo[1], lo[2], lo[3], hv[0], hv[1], hv[2], hv[3]};
                    o[d0] = __builtin_amdgcn_mfma_f32_32x32x16_bf16(vf, pf[s], o[d0], 0, 0, 0);
                }
        }
        if (more) DA_WRITE((kt + 1) & 1);
        __syncthreads();
    }
#undef DA_LOAD
#undef DA_WRITE
    const float ltot = lrun + __shfl_xor(lrun, 32), inv = 1.0f / ltot;
    LAS float* X = (LAS float*)lds + rg * 4096;
    if (mp == 1) {
#pragma unroll
        for (int d0 = 0; d0 < 4; ++d0)
#pragma unroll
            for (int r = 0; r < 16; ++r) { const int dv = 32 * d0 + (r & 3) + 8 * (r >> 2) + 4 * hi; X[dv * 32 + r32] = o[d0][r] * inv; }
    }
    __syncthreads();
    if (mp == 0) {
        float ss = 0.f;
#pragma unroll
        for (int d0 = 0; d0 < 4; ++d0)
#pragma unroll
            for (int r = 0; r < 16; ++r) { const int dv = 32 * d0 + (r & 3) + 8 * (r >> 2) + 4 * hi; const float v = o[d0][r] * inv - lam * X[dv * 32 + r32]; o[d0][r] = v; ss += v * v; }
        ss += __shfl_xor(ss, 32);
        const float rstd = 0.8f / sqrtf(ss * (1.0f / 128.0f) + EPS);
        bf16_t* op = CAT + (tok0 + q0 + r32) * D + 512 + hh * 128;
#pragma unroll
        for (int d0 = 0; d0 < 4; ++d0)
#pragma unroll
            for (int r4 = 0; r4 < 4; ++r4) { const int dv = 32 * d0 + 8 * r4 + 4 * hi; const f32x4 gg = *(const f32x4*)(subln_g + dv);
                u32x2 w; w.x = cvt_pk_bf16(o[d0][4 * r4 + 0] * rstd * gg[0], o[d0][4 * r4 + 1] * rstd * gg[1]); w.y = cvt_pk_bf16(o[d0][4 * r4 + 2] * rstd * gg[2], o[d0][4 * r4 + 3] * rstd * gg[3]);
                *(u32x2*)(op + dv) = w; }
    }
    __syncthreads();
}
}

typedef const __attribute__((address_space(4))) Args* KArgsP;
__device__ __forceinline__ KArgsP kargs() { KArgsP p = (KArgsP)__builtin_amdgcn_kernarg_segment_ptr(); asm volatile("" : "+s"(p)); return p; }
#define PH_PTRS() KArgsP ap = kargs(); unsigned char* ws = ap->ws; (void)ws; int tid = wave * 64 + lane_id(); asm volatile("" : "+v"(tid)); const int lane = tid & 63; (void)lane; \
    float* cs = (float*)(ws + WS_CS); float* ssp = (float*)(ws + WS_SSP); float* rstd2 = (float*)(ws + WS_RSTD2); \
    int* tokslot = (int*)(ws + WS_TOKSLOT); int* ltok = (int*)(ws + WS_LTOK); float* lgate = (float*)(ws + WS_LGATE); \
    bf16_t* Win_t = (bf16_t*)(ws + WS_WIN); bf16_t* Wout_t = (bf16_t*)(ws + WS_WOUT); bf16_t* Wcq_t = (bf16_t*)(ws + WS_WCQ); bf16_t* Wckv_t = (bf16_t*)(ws + WS_WCKV); \
    bf16_t* Wco_t = (bf16_t*)(ws + WS_WCO); bf16_t* Wgu_t = (bf16_t*)(ws + WS_WGU); bf16_t* Wdn_t = (bf16_t*)(ws + WS_WDN); \
    bf16_t* H0 = (bf16_t*)(ws + WS_H0); bf16_t* MEMN = (bf16_t*)(ws + WS_MEMN); bf16_t* KC = (bf16_t*)(ws + WS_KC); bf16_t* VT = (bf16_t*)(ws + WS_VT); \
    bf16_t* U = (bf16_t*)(ws + WS_U); bf16_t* CAT = (bf16_t*)(ws + WS_CAT); float* X1 = (float*)(ws + WS_X1); bf16_t* X1B = (bf16_t*)(ws + WS_X1B); \
    bf16_t* QC = (bf16_t*)(ws + WS_QC); bf16_t* PC = (bf16_t*)(ws + WS_PC); bf16_t* OC = (bf16_t*)(ws + WS_OC); float* X2 = (float*)(ws + WS_X2); bf16_t* X2B = (bf16_t*)(ws + WS_X2B); \
    bf16_t* HID = (bf16_t*)(ws + WS_HID); bf16_t* YR = (bf16_t*)(ws + WS_Y); \
    (void)cs; (void)ssp; (void)rstd2; (void)tokslot; (void)ltok; (void)lgate; (void)Win_t; (void)Wout_t; (void)Wcq_t; (void)Wckv_t; (void)Wco_t; (void)Wgu_t; (void)Wdn_t; (void)H0; (void)MEMN; (void)KC; (void)VT; \
    (void)U; (void)CAT; (void)X1; (void)X1B; (void)QC; (void)PC; (void)OC; (void)X2; (void)X2B; (void)HID; (void)YR

constexpr int NWAVES = 8;
constexpr int N_PHASES = 10;

__global__ void __launch_bounds__(NWAVES * 64, 2) fwd_kernel(Args a) {
    extern __shared__ __attribute__((aligned(16))) unsigned char lds_raw[];
    LAS unsigned char* lds = (LAS unsigned char*)lds_raw;
    const int wave = __builtin_amdgcn_readfirstlane((int)threadIdx.x >> 6);
    const int tid = wave * 64 + lane_id(), lane = tid & 63; (void)lane;
    const int G = gridDim.x, bx = blockIdx.x;
    const int gw = bx * NWAVES + wave, NGW = G * NWAVES;
    unsigned* ctl; { unsigned char* ws0 = a.ws; ctl = (unsigned*)(ws0 + WS_CTL); }
    volatile LAS unsigned* MISC = (volatile LAS unsigned*)(lds + MISC_OFF);
    if (tid < 32) ((LAS unsigned*)(lds + MISC_OFF))[tid] = 0u;
    __syncthreads();
    XcdBarrier bar; bar.bar = ctl + CW_BAR; bar.x = 0; bar.st = nullptr;
    if (MK_N_LAUNCHES == 1) bar = xcd_barrier_post(ctl + CW_BAR, MISC + 8, tid);
    const int lo = a.ph_lo, hi = a.ph_hi;
#define IN(k) (((PMASK >> (k)) & 1) && lo <= (k) && (k) < hi)
#define SEAM(k) do { if (IN(k) && IN((k) + 1)) xcd_barrier(bar, wave * 64 + lane_id()); } while (0)

    if (IN(0)) for (int rep_ = 0; rep_ < REPS(0); ++rep_) { PH_PTRS();
        LAS float* scr = (LAS float*)(lds + wave * 16384);
        p0_transpose_stream<2, true>(ap->w_gu, 1024, 2048, NE, Wgu_t, 1024, 0, (size_t)2048 * 1024, ap->ffn_g, scr, gw, NGW, lane);
        p0_transpose_stream<0, true>(ap->w_down, 1024, 1024, NE, Wdn_t, 1024, 0, (size_t)1024 * 1024, nullptr, scr, gw, NGW, lane);
        p0_transpose_stream<1, false>(ap->w_in, 1024, 2048, 1, Win_t, 1024, 0, 0, nullptr, scr, gw, NGW, lane);
        p0_transpose_stream<0, false>(ap->w_out + (size_t)512 * 1024, 512, 1024, 1, Wout_t, 1024, 512, 0, nullptr, scr, gw, NGW, lane);
        p0_transpose_stream<0, false>(ap->w_cq, 1024, 1024, 1, Wcq_t, 1024, 0, 0, ap->xattn_g, scr, gw, NGW, lane);
        p0_transpose_stream<0, false>(ap->w_ckv, 1024, 2048, 1, Wckv_t, 1024, 0, 0, nullptr, scr, gw, NGW, lane);
        p0_transpose_stream<0, false>(ap->w_co, 1024, 1024, 1, Wco_t, 1024, 0, 0, nullptr, scr, gw, NGW, lane);
        constexpr int I_WEFF = 1024, I_XR = T, I_MR = NMEM, I_ROPE = T * 8 / 64;
        constexpr int NITEMS = I_WEFF + I_XR + I_MR + I_ROPE;
        for (int it = gw; it < NITEMS; it += NGW) {
            int r = it;
            if (r < I_WEFF) {
                const int nb = r & 15, cb = r >> 4, n = nb * 64 + lane, kk0 = cb * 8, g = kk0 >> 7;
                float accv[8];
#pragma unroll
                for (int q = 0; q < 8; ++q) accv[q] = 0.f;
#pragma unroll 8
                for (int d = 0; d < 128; ++d) { const float wo = ap->w_out[(size_t)(g * 128 + d) * 1024 + n] * ap->pool_scale[g * 128 + d];
#pragma unroll
                    for (int q = 0; q < 8; ++q) accv[q] += ap->w_pool[(size_t)(kk0 + q) * 128 + d] * wo; }
                u32x4 o4; o4.x = pk2(accv[0], accv[1]); o4.y = pk2(accv[2], accv[3]); o4.z = pk2(accv[4], accv[5]); o4.w = pk2(accv[6], accv[7]);
                *(u32x4*)(Wout_t + (size_t)n * 1024 + kk0) = o4; continue; } r -= I_WEFF;
            if (r < I_XR) { rms_row_to_bf16(ap->x + (size_t)r * D, ap->attn_g, H0 + (size_t)r * D, lane); continue; } r -= I_XR;
            if (r < I_MR) { rms_row_to_bf16(ap->mem + (size_t)r * D, ap->mem_g, MEMN + (size_t)r * D, lane); continue; } r -= I_MR;
            {
                const int idx = r * 64 + lane, t = idx >> 3, i = idx & 7;
                const double inv_freq = exp2(-(double)i * (18.931568569324174 / 8.0));
                const double rev = (double)ap->pos[t] * inv_freq * 0.15915494309189535;
                const float fr = (float)(rev - floor(rev));
                cs[(size_t)idx * 2] = __builtin_amdgcn_cosf(fr); cs[(size_t)idx * 2 + 1] = __builtin_amdgcn_sinf(fr);
            }
        }
    }
    SEAM(0);

    if (IN(1)) for (int rep_ = 0; rep_ < REPS(1); ++rep_) { PH_PTRS();
        { pg8::StaticOrder S; S.init(H0, Win_t, T, INW, D, D, G, bx); pg8::EpiInProj E{U, cs};
          pg8::gemm_phase<pg8::EpiInProj, pg8::StaticOrder, true, false, false>(lds, wave, 2 * D, 2 * D, 2 * D, S, E); }
        { pg8::StaticOrder S; S.init(MEMN, Wckv_t, NMEM, 1024, D, D, G, bx); pg8::EpiBf16 E{KC, 1024, nullptr, 1.0f};
          pg8::gemm_phase<pg8::EpiBf16, pg8::StaticOrder, true, false, false>(lds, wave, 2 * D, 2 * D, 2 * D, S, E); }
        { pg8::StaticOrder S; S.init(Wckv_t + (size_t)1024 * 1024, MEMN, 1024, NMEM, D, D, G, (bx + 32) % G); pg8::EpiBf16 E{VT, NMEM, nullptr, 1.0f};
          pg8::gemm_phase<pg8::EpiBf16, pg8::StaticOrder, true, false, false>(lds, wave, 2 * D, 2 * D, 2 * D, S, E); }
    }
    SEAM(1);

    if (IN(2)) for (int rep_ = 0; rep_ < REPS(2); ++rep_) { PH_PTRS();
        float d1 = (lane < 64) ? ap->lq1[lane] * ap->lk1[lane] : 0.f, d2 = ap->lq2[lane] * ap->lk2[lane];
        d1 = wave_sum(d1); d2 = wave_sum(d2);
        const float lam = expf(d1) - expf(d2) + 0.2f;
        for (int un = bx; un < 256; un += G) {
            const int bh = un >> 3, jp = un & 7;
            dattn::unit(lds, wave, U, CAT, ap->subln_g, lam, bh >> 2, bh & 3, jp);
            dattn::unit(lds, wave, U, CAT, ap->subln_g, lam, bh >> 2, bh & 3, 15 - jp);
        }
        for (int it = gw; it < T / 8; it += NGW) {
            const int b = it >> 8, t0 = (it & 255) * 8, wnd = 2 << (lane >> 4);
            const bf16_t* up = U + (size_t)b * SEQ * INW + lane * 8;
#pragma unroll 1
            for (int tt = 0; tt < 8; ++tt) { const int t = t0 + tt; float s[8], c[8];
#pragma unroll
                for (int q = 0; q < 8; ++q) s[q] = 0.f;
                for (int jj = 0; jj < 16; ++jj) { if (jj < wnd && jj <= t) { const bf16x8 v = *(const bf16x8*)(up + (size_t)(t - jj) * INW);
#pragma unroll
                        for (int q = 0; q < 8; ++q) { const float f = bf2f((unsigned short)v[q]); s[q] += f; if (jj == 0) c[q] = f; } } }
                const float ic = 1.0f / (float)((t + 1 < wnd) ? t + 1 : wnd);
                u32x4 o4; o4.x = pk2(s[0] * ic - c[0], s[1] * ic - c[1]); o4.y = pk2(s[2] * ic - c[2], s[3] * ic - c[3]); o4.z = pk2(s[4] * ic - c[4], s[5] * ic - c[5]); o4.w = pk2(s[6] * ic - c[6], s[7] * ic - c[7]);
                *(u32x4*)(CAT + ((size_t)b * SEQ + t) * D + lane * 8) = o4; }
        }
    }
    SEAM(2);

    if (IN(3)) for (int rep_ = 0; rep_ < REPS(3); ++rep_) { PH_PTRS();
        pg8::StaticOrder S; S.init(CAT, Wout_t, T, D, D, D, G, bx); pg8::EpiRes<false> E{ap->x, X1, X1B, ssp};
        pg8::gemm_phase<pg8::EpiRes<false>, pg8::StaticOrder, true, false, false>(lds, wave, 2 * D, 2 * D, 2 * D, S, E);
    }
    SEAM(3);

    if (IN(4)) for (int rep_ = 0; rep_ < REPS(4); ++rep_) { PH_PTRS();
        LAS float* rs = (LAS float*)(lds + XTAB_OFF);
        for (int un = bx; un < 256; un += G) {
            const int pm = un >> 2, h = un & 3, b = pm >> 3;
            if (tid < 256) { const int row = pm * 256 + tid; float s = 0.f;
#pragma unroll
                for (int p = 0; p < 16; ++p) s += ssp[(size_t)p * T + row];
                rs[tid] = 1.0f / sqrtf(s * (1.0f / D) + EPS); }
            __syncthreads();
            { pg8::SingleUnit S; S.u = pg8::Unit{pm, h, 0, 0, 256, 0, (const char*)(X1B + (size_t)pm * 256 * D), (const char*)(Wcq_t + (size_t)h * 256 * D)};
              pg8::EpiBf16 E{QC, D, rs, QSCALE_X};
              pg8::gemm_phase<pg8::EpiBf16, pg8::SingleUnit, false, false, false>(lds, wave, 2 * D, 2 * D, 2 * D, S, E); }
            wg_global_sync(tid);
            { pg8::SingleUnit S; S.u = pg8::Unit{pm, h, 0, 0, 256, 0, (const char*)(QC + (size_t)pm * 256 * D + h * 256), (const char*)(KC + (size_t)b * 256 * D + h * 256)};
              pg8::EpiSoftmax E{PC, D};
              pg8::gemm_phase<pg8::EpiSoftmax, pg8::SingleUnit, false, false, false>(lds, wave, 2 * 256, 2 * D, 2 * D, S, E); }
            wg_global_sync(tid);
            { pg8::SingleUnit S; S.u = pg8::Unit{pm, h, 0, 0, 256, 0, (const char*)(PC + (size_t)pm * 256 * D + h * 256), (const char*)(VT + (size_t)h * 256 * NMEM + b * 256)};
              pg8::EpiBf16 E{OC, D, nullptr, 1.0f};
              pg8::gemm_phase<pg8::EpiBf16, pg8::SingleUnit, false, false, false>(lds, wave, 2 * 256, 2 * D, 2 * NMEM, S, E); }
            __syncthreads();
        }
    }
    SEAM(4);

    if (IN(5)) for (int rep_ = 0; rep_ < REPS(5); ++rep_) { PH_PTRS();
        pg8::StaticOrder S; S.init(OC, Wco_t, T, D, D, D, G, bx); pg8::EpiRes<true> E{X1, X2, X2B, nullptr};
        pg8::gemm_phase<pg8::EpiRes<true>, pg8::StaticOrder, true, false, false>(lds, wave, 2 * D, 2 * D, 2 * D, S, E);
    }
    SEAM(5);

    if (IN(6)) for (int rep_ = 0; rep_ < REPS(6); ++rep_) { PH_PTRS();
        LAS float* WR = (LAS float*)lds;
        LAS int* lcnt = (LAS int*)(lds + RT_OFF);
        LAS int* sel = (LAS int*)(lds + RT_OFF + 512);
        LAS float* selg = (LAS float*)(lds + RT_OFF + 512 + 1024);
        const int wave_ = __builtin_amdgcn_readfirstlane(tid >> 6);
        for (int tb = bx; tb < T / 64; tb += G) {
            for (int i = tid; i < 8192; i += NWAVES * 64) { const f32x4 w = ((const f32x4*)ap->w_router)[i]; *(LAS f32x4*)(WR + 4 * i) = w * ap->ffn_g[i >> 3]; }
            if (tid < 32) lcnt[tid] = 0;
            __syncthreads();
            const int tile = wave_ >> 2, kq = wave_ & 3, r32 = lane & 31, h = lane >> 5;
            const float* xp = X2 + (size_t)(tb * 64 + tile * 32 + r32) * D + kq * 256 + 32 * h;
            f32x16 accr;
#pragma unroll
            for (int r = 0; r < 16; ++r) accr[r] = 0.f;
            float ss = 0.f;
#pragma unroll 1
            for (int S = 0; S < 4; ++S) {
                f32x4 xv[8];
#pragma unroll
                for (int q = 0; q < 8; ++q) xv[q] = *(const f32x4*)(xp + 64 * S + 4 * q);
                const LAS float* wp = WR + (kq * 256 + 64 * S + 32 * h) * 32 + r32;
#pragma unroll
                for (int s = 0; s < 32; ++s) { const float av = xv[s >> 2][s & 3]; accr = __builtin_amdgcn_mfma_f32_32x32x2f32(av, wp[s * 32], accr, 0, 0, 0); ss += av * av; }
            }
            ss += __shfl_xor(ss, 32);
            __syncthreads();
            LAS float* PT = (LAS float*)lds + wave_ * (32 * 33);
            LAS float* PSS = (LAS float*)lds + 8 * 32 * 33;
#pragma unroll
            for (int r = 0; r < 16; ++r) PT[((r & 3) + 8 * (r >> 2) + 4 * h) * 33 + r32] = accr[r];
            if (h == 0) PSS[wave_ * 32 + r32] = ss;
            __syncthreads();
            if (tid < 64) {
                const int tl = tid & 31, tok = tb * 64 + tid; const LAS float* p0 = (LAS float*)lds + ((tid >> 5) * 4) * (32 * 33) + tl * 33; const LAS float* q0 = PSS + (tid >> 5) * 128 + tl;
                const float sq = (q0[0] + q0[32]) + (q0[64] + q0[96]);
                const float rstd = 1.0f / sqrtf(sq * (1.0f / D) + EPS);
                rstd2[tok] = rstd;
                float b0 = -INFINITY, b1 = -INFINITY, b2 = -INFINITY, b3 = -INFINITY; int i0 = 0, i1 = 0, i2 = 0, i3 = 0;
                for (int e = 0; e < 32; ++e) {
                    const float lg = ((p0[e] + p0[32 * 33 + e]) + (p0[2 * 32 * 33 + e] + p0[3 * 32 * 33 + e])) * rstd + ap->b_router[e];
                    if (lg > b3) { b3 = lg; i3 = e;
                        if (b3 > b2) { const float tf = b2; b2 = b3; b3 = tf; const int ti = i2; i2 = i3; i3 = ti; }
                        if (b2 > b1) { const float tf = b1; b1 = b2; b2 = tf; const int ti = i1; i1 = i2; i2 = ti; }
                        if (b1 > b0) { const float tf = b0; b0 = b1; b1 = tf; const int ti = i0; i0 = i1; i1 = ti; } }
                }
                const float e1 = expf(b1 - b0), e2 = expf(b2 - b0), e3 = expf(b3 - b0), isum = 1.0f / (1.0f + e1 + e2 + e3);
                int lr;
                lr = atomicAdd((int*)&lcnt[i0], 1); sel[tid * 4 + 0] = (i0 << 16) | lr; selg[tid * 4 + 0] = isum;
                lr = atomicAdd((int*)&lcnt[i1], 1); sel[tid * 4 + 1] = (i1 << 16) | lr; selg[tid * 4 + 1] = e1 * isum;
                lr = atomicAdd((int*)&lcnt[i2], 1); sel[tid * 4 + 2] = (i2 << 16) | lr; selg[tid * 4 + 2] = e2 * isum;
                lr = atomicAdd((int*)&lcnt[i3], 1); sel[tid * 4 + 3] = (i3 << 16) | lr; selg[tid * 4 + 3] = e3 * isum;
            }
            __syncthreads();
            if (tid < 32) { const int c = lcnt[tid]; lcnt[32 + tid] = (c > 0) ? (int)atomicAdd(ctl + CW_CNT + tid, (unsigned)c) : 0; }
            __syncthreads();
            if (tid < 256) { const int tl = tid >> 2, tok = tb * 64 + tl, sv = sel[tid], ee = sv >> 16, pos = lcnt[32 + ee] + (sv & 0xffff);
                ltok[ee * CAP + pos] = tok; lgate[ee * CAP + pos] = selg[tid]; tokslot[tok * 4 + (tid & 3)] = (ee << 16) | pos; }
            __syncthreads();
        }
    }
    SEAM(6);

    LAS int* ecnt = (LAS int*)(lds + ECNT_OFF);
    LAS int* etp = (LAS int*)(lds + ECNT_OFF + 128);
    LAS int* xe = (LAS int*)(lds + XE_OFF);
    LAS int* tokt = (LAS int*)(lds + TOKT_OFF);
    if (IN(7) || IN(8) || IN(9)) {
        __syncthreads();
        const int t_ = wave * 64 + lane_id();
        if (t_ == 0) { int acc = 0; for (int e = 0; e < NE; ++e) { const int c = (int)__hip_atomic_load(ctl + CW_CNT + e, __ATOMIC_RELAXED, __HIP_MEMORY_SCOPE_AGENT); ecnt[e] = c; etp[e] = acc; acc += (c + 255) >> 8; } etp[NE] = acc; }
        __syncthreads();
        if (t_ < NE) { const int e = t_, n = etp[e + 1] - etp[e]; int rank = 0;
            for (int o = 0; o < NE; ++o) { const int no = etp[o + 1] - etp[o]; rank += (no > n || (no == n && o < e)) ? 1 : 0; }
            const int rnd = rank >> 3, p = rank & 7, x = (rnd & 1) ? 7 - p : p; xe[x * 4 + rnd] = e; }
        __syncthreads();
    }

    if (IN(7)) for (int rep_ = 0; rep_ < REPS(7); ++rep_) { PH_PTRS();
        pg8::MoeOrder S; S.ecnt = ecnt; S.etp = etp; S.xe = xe; S.tokt = tokt; S.x = bx & 7; S.cl = bx >> 3; S.nloc = G >> 3; S.npn = 8;
        S.Abase = (const char*)X2B; S.Bbase = (const char*)Wgu_t; S.b_expert = (size_t)2048 * 1024; S.rowbytes = D; S.b_rowbytes = D; S.gather = true;
        { pg8::Unit u;
          for (int i = 0; i < MAXU && S.next(i, u); ++i) if (tid < 256) tokt[i * 256 + tid] = (tid < u.nvalid) ? ltok[u.e * CAP + u.r * 256 + tid] : 0; }
        __syncthreads();
        pg8::EpiSwiGLU E{(unsigned char*)HID, ap->b_gu, rstd2, tokt};
        pg8::gemm_phase<pg8::EpiSwiGLU, pg8::MoeOrder, true, true, true>(lds, wave, D, D, D, S, E);
    }
    SEAM(7);

    if (IN(8)) for (int rep_ = 0; rep_ < REPS(8); ++rep_) { PH_PTRS();
        pg8::MoeOrder S; S.ecnt = ecnt; S.etp = etp; S.xe = xe; S.tokt = tokt; S.x = bx & 7; S.cl = bx >> 3; S.nloc = G >> 3; S.npn = 4;
        S.Abase = (const char*)HID; S.Bbase = (const char*)Wdn_t; S.b_expert = (size_t)1024 * 1024; S.rowbytes = D; S.b_rowbytes = D; S.gather = true;
        { pg8::Unit u;
          for (int i = 0; i < MAXU && S.next(i, u); ++i) if (tid < 256) tokt[i * 256 + tid] = u.pm * 256 + tid; }
        __syncthreads();
        pg8::EpiDown E{YR, ap->b_down, lgate};
        pg8::gemm_phase<pg8::EpiDown, pg8::MoeOrder, true, true, true>(lds, wave, D, D, D, S, E);
    }
    SEAM(8);

    if (IN(9)) for (int rep_ = 0; rep_ < REPS(9); ++rep_) { PH_PTRS();
        for (int tok = gw; tok < T; tok += NGW) {
            int rowk[4];
#pragma unroll
            for (int k = 0; k < 4; ++k) { const int sv = tokslot[tok * 4 + k], ee = sv >> 16; rowk[k] = etp[ee] * 256 + (sv & 0xffff); }
            const f32x4* xr = (const f32x4*)(X2 + (size_t)tok * D) + lane;
            f32x4 v[4]; float s = 0.f;
#pragma unroll
            for (int j = 0; j < 4; ++j) { v[j] = xr[64 * j];
#pragma unroll
                for (int k = 0; k < 4; ++k) { const u32x2 y = *((const u32x2*)(YR + (size_t)rowk[k] * 1024) + lane + 64 * j);
                    v[j][0] += __builtin_bit_cast(float, y.x << 16); v[j][1] += __builtin_bit_cast(float, y.x & 0xffff0000u);
                    v[j][2] += __builtin_bit_cast(float, y.y << 16); v[j][3] += __builtin_bit_cast(float, y.y & 0xffff0000u); }
                s += (v[j][0] * v[j][0] + v[j][1] * v[j][1]) + (v[j][2] * v[j][2] + v[j][3] * v[j][3]); }
            const float rstd = 1.0f / sqrtf(wave_sum(s) * (1.0f / D) + EPS);
            f32x4* op = (f32x4*)(ap->out + (size_t)tok * D) + lane; const f32x4* gr = (const f32x4*)ap->final_g + lane;
#pragma unroll
            for (int j = 0; j < 4; ++j) op[64 * j] = v[j] * rstd * gr[64 * j];
        }
    }
#undef IN
#undef SEAM
}

extern "C" void kernel_launch(void* const* d_in, const int* in_sizes, int n_in, void* d_out, int out_size, void* d_ws, size_t ws_size, hipStream_t stream) {
    static int grid = 0;
    if (grid == 0) {
        if (n_in != 26 || in_sizes[0] != T * D || out_size != T * D || ws_size < WS_END) { fprintf(stderr, "kernel_launch: unexpected shapes (n_in %d, in0 %d, out %d, ws %zu); nothing launched\n", n_in, n_in > 0 ? in_sizes[0] : -1, out_size, ws_size); grid = -1; return; }
        int dev = 0, cus = 0, per_cu = 0;
        if (hipGetDevice(&dev) != hipSuccess || hipDeviceGetAttribute(&cus, hipDeviceAttributeMultiprocessorCount, dev) != hipSuccess) { grid = -1; return; }
        if (hipFuncSetAttribute((const void*)fwd_kernel, hipFuncAttributeMaxDynamicSharedMemorySize, LDS_BYTES) != hipSuccess) { fprintf(stderr, "kernel_launch: hipFuncSetAttribute failed\n"); grid = -1; return; }
        if (hipOccupancyMaxActiveBlocksPerMultiprocessor(&per_cu, (const void*)fwd_kernel, NWAVES * 64, LDS_BYTES) != hipSuccess || per_cu < 1) { fprintf(stderr, "kernel_launch: occupancy query says %d\n", per_cu); per_cu = 1; }
        (void)hipGetLastError();
        grid = cus;
    }
    if (grid < 0) return;
    (void)hipMemsetAsync((char*)d_ws + WS_CTL, 0, CTL_BYTES, stream);
    Args a{};
    a.x = (const float*)d_in[0]; a.pos = (const int*)d_in[1]; a.mem = (const float*)d_in[2]; a.attn_g = (const float*)d_in[3]; a.w_in = (const float*)d_in[4];
    a.w_pool = (const float*)d_in[5]; a.pool_scale = (const float*)d_in[6]; a.lq1 = (const float*)d_in[7]; a.lk1 = (const float*)d_in[8]; a.lq2 = (const float*)d_in[9];
    a.lk2 = (const float*)d_in[10]; a.subln_g = (const float*)d_in[11]; a.w_out = (const float*)d_in[12]; a.xattn_g = (const float*)d_in[13]; a.mem_g = (const float*)d_in[14];
    a.w_cq = (const float*)d_in[15]; a.w_ckv = (const float*)d_in[16]; a.w_co = (const float*)d_in[17]; a.ffn_g = (const float*)d_in[18]; a.w_router = (const float*)d_in[19];
    a.b_router = (const float*)d_in[20]; a.w_gu = (const float*)d_in[21]; a.b_gu = (const float*)d_in[22]; a.w_down = (const float*)d_in[23]; a.b_down = (const float*)d_in[24];
    a.final_g = (const float*)d_in[25]; a.out = (float*)d_out; a.ws = (unsigned char*)d_ws;
    if (MK_N_LAUNCHES == 1) {
        a.ph_lo = 0; a.ph_hi = N_PHASES;
        void* args[] = {&a};
        hipError_t e = hipLaunchCooperativeKernel((const void*)fwd_kernel, dim3(grid), dim3(NWAVES * 64), args, LDS_BYTES, stream);
        if (e != hipSuccess) fprintf(stderr, "kernel_launch: cooperative launch failed: %s (grid %d)\n", hipGetErrorString(e), grid);
    } else {
        for (int p = 0; p < N_PHASES; ++p) { a.ph_lo = p; a.ph_hi = p + 1; hipLaunchKernelGGL(fwd_kernel, dim3(grid), dim3(NWAVES * 64), LDS_BYTES, stream, a); }
    }
}
```

```cpp
#include <hip/hip_runtime.h>
#include <cstdio>
#include <cstdint>

#ifndef MK_N_LAUNCHES
#define MK_N_LAUNCHES 1
#endif

#ifndef REPMASK
#define REPMASK 0
#endif
#define REPS(k) (((REPMASK >> (k)) & 1) ? 2 : 1)
#ifndef REPA
#define REPA 1
#endif
#ifndef REPB
#define REPB 1
#endif
#ifndef KREPMASK
#define KREPMASK 0
#endif
#define KREPS(k) (((KREPMASK >> (k)) & 1) ? 2 : 1)
#ifndef PMASK
#define PMASK 0x3ff
#endif
#define LAS __attribute__((address_space(3)))
#define GAS __attribute__((address_space(1)))

typedef unsigned short bf16_t;
typedef short bf16x8 __attribute__((ext_vector_type(8)));
typedef short s16x4 __attribute__((ext_vector_type(4)));
typedef float f32x4 __attribute__((ext_vector_type(4)));
typedef float f32x2 __attribute__((ext_vector_type(2)));
typedef float f32x16 __attribute__((ext_vector_type(16)));
typedef unsigned u32x4 __attribute__((ext_vector_type(4)));
typedef unsigned u32x2 __attribute__((ext_vector_type(2)));
typedef int i32x4 __attribute__((ext_vector_type(4)));
typedef int i32x8 __attribute__((ext_vector_type(8)));

constexpr int NB = 8, SEQ = 2048, T = NB * SEQ, D = 1024, INW = 2048, MEM = 256, NMEM = NB * MEM;
constexpr int NE = 32, TOPK = 4, CAP = 16384, MAXRT = 288;
constexpr float EPS = 1e-5f;
constexpr float LOG2E = 1.4426950408889634f;
constexpr float QSCALE_D = 0.125f * LOG2E;
constexpr float QSCALE_X = 0.0625f * LOG2E;

constexpr size_t MiB = 1u << 20;
constexpr size_t WS_CTL = 0, CTL_BYTES = 1 * MiB;
constexpr size_t WS_CS = 1 * MiB;
constexpr size_t WS_SSP = 2 * MiB;
constexpr size_t WS_RSTD2 = 3 * MiB;
constexpr size_t WS_TOKSLOT = 3 * MiB + 256 * 1024;
constexpr size_t WS_LTOK = 4 * MiB;
constexpr size_t WS_LGATE = 6 * MiB;
constexpr size_t WS_WIN = 8 * MiB;
constexpr size_t WS_WOUT = 12 * MiB;
constexpr size_t WS_WCQ = 14 * MiB;
constexpr size_t WS_WCKV = 16 * MiB;
constexpr size_t WS_WCO = 20 * MiB;
constexpr size_t WS_WGU = 24 * MiB;
constexpr size_t WS_WDN = 152 * MiB;
constexpr size_t WS_H0 = 216 * MiB;
constexpr size_t WS_MEMN = 248 * MiB;
constexpr size_t WS_KC = 252 * MiB;
constexpr size_t WS_VT = 256 * MiB;
constexpr size_t WS_U = 260 * MiB;
constexpr size_t WS_CAT = 324 * MiB;
constexpr size_t WS_X1 = 356 * MiB;
constexpr size_t WS_X1B = 420 * MiB;
constexpr size_t WS_QC = 452 * MiB;
constexpr size_t WS_PC = 484 * MiB;
constexpr size_t WS_OC = 516 * MiB;
constexpr size_t WS_X2 = 548 * MiB;
constexpr size_t WS_X2B = 612 * MiB;
constexpr size_t WS_HID = 644 * MiB;
constexpr size_t WS_Y = 788 * MiB;
constexpr size_t WS_END = 932 * MiB;
constexpr int CW_CNT = 64;
constexpr int CW_BAR = 4096;

constexpr int RING_BYTES = 131072;
constexpr int XTAB_OFF = RING_BYTES;
constexpr int ECNT_OFF = RING_BYTES + 1024;
constexpr int RT_OFF = RING_BYTES + 1536;
constexpr int MISC_OFF = RING_BYTES + 4096;
static_assert(RT_OFF + 2560 <= MISC_OFF, "LDS map");
constexpr int XE_OFF = MISC_OFF + 128;
constexpr int TOKT_OFF = MISC_OFF + 512;
constexpr int MAXU = 24;
constexpr int LDS_BYTES = 163840;
static_assert(TOKT_OFF + MAXU * 1024 <= LDS_BYTES, "LDS map");

#define LDS_WAIT() asm volatile("s_waitcnt lgkmcnt(0)" ::: "memory")
#define VM_WAIT() asm volatile("s_waitcnt vmcnt(0)" ::: "memory")
__device__ __forceinline__ unsigned f2bf(float f) { unsigned u = __builtin_bit_cast(unsigned, f); return (u + 0x7fffu + ((u >> 16) & 1u)) >> 16; }
__device__ __forceinline__ unsigned pk2(float lo, float hi) { return f2bf(lo) | (f2bf(hi) << 16); }
__device__ __forceinline__ float bf2f(unsigned short v) { return __builtin_bit_cast(float, (unsigned)v << 16); }
__device__ __forceinline__ unsigned cvt_pk_bf16(float lo, float hi) { unsigned r; asm volatile("v_cvt_pk_bf16_f32 %0, %1, %2" : "=v"(r) : "v"(lo), "v"(hi)); return r; }
__device__ __forceinline__ unsigned pk4_fp8(float a, float b, float c, float d) { int w = 0; w = __builtin_amdgcn_cvt_pk_fp8_f32(a, b, w, false); w = __builtin_amdgcn_cvt_pk_fp8_f32(c, d, w, true); return (unsigned)w; }
__device__ __forceinline__ int lane_id() { int l; asm volatile("v_mbcnt_lo_u32_b32 %0, -1, 0\n\tv_mbcnt_hi_u32_b32 %0, -1, %0" : "=v"(l)); return l; }
__device__ __forceinline__ float wave_sum(float v) {
#pragma unroll
    for (int o = 1; o < 64; o <<= 1) v += __shfl_xor(v, o);
    return v;
}

#define XB_TMO      128
#define XB_XCNT(j)  (256  + 64 * (j))
#define XB_XSUB(j)  (1280 + 64 * (j))
#define XB_XGEN(j)  (2304 + 64 * (j))
#define XB_TOP      3328
#define XB_TOPGEN   3392
#define XCD_BAR_WORDS 3456
#define XB_SPIN_CAP (1u << 18)
__device__ __forceinline__ unsigned xb_ld(unsigned* p)              { return __hip_atomic_load(p, __ATOMIC_RELAXED, __HIP_MEMORY_SCOPE_AGENT); }
__device__ __forceinline__ unsigned xb_add(unsigned* p, unsigned v) { return __hip_atomic_fetch_add(p, v, __ATOMIC_RELAXED, __HIP_MEMORY_SCOPE_AGENT); }
__device__ __forceinline__ unsigned xb_xcc_id() { return (unsigned)__builtin_amdgcn_s_getreg((3 << 11) | 20) & 0xFu; }
#define XB_SPIN(cond, bar) do { unsigned _sp = 0; while (cond) { __builtin_amdgcn_s_sleep(1); \
    if ((++_sp & 255u) == 0u) { if (xb_ld(&(bar)[XB_TMO])) break; if (_sp > XB_SPIN_CAP) { atomicAdd(&(bar)[XB_TMO], 1u); break; } } } } while (0)
struct XcdBarrier { unsigned* bar; unsigned x; volatile LAS unsigned* st; };
__device__ __forceinline__ XcdBarrier xcd_barrier_post(unsigned* bar, volatile LAS unsigned* st, int tid) {
    XcdBarrier b; b.bar = bar; b.x = xb_xcc_id(); b.st = st;
    if (tid == 0) (void)xb_add(&bar[XB_XCNT(b.x)], 1u);
    return b;
}
__device__ __forceinline__ void xcd_barrier_complete(unsigned* bar, unsigned x, unsigned& nloc, unsigned& nx) {
    const unsigned G = gridDim.x * gridDim.y * gridDim.z;
    unsigned sum, cnt, mine, sp = 0u;
    for (;;) {
        sum = 0u; cnt = 0u; mine = 0u;
#pragma unroll
        for (unsigned j = 0; j < 16; ++j) { const unsigned c = xb_ld(&bar[XB_XCNT(j)]); sum += c; cnt += (c > 0u) ? 1u : 0u; mine = (j == x) ? c : mine; }
        if (sum == G) break;
        __builtin_amdgcn_s_sleep(1);
        if ((++sp & 255u) == 0u) { if (xb_ld(&bar[XB_TMO])) break; if (sp > XB_SPIN_CAP) { atomicAdd(&bar[XB_TMO], 1u); break; } }
    }
    nloc = mine > 0u ? mine : 1u; nx = cnt > 0u ? cnt : 1u;
}
__device__ __forceinline__ void xcd_barrier(const XcdBarrier& b, int tid) {
    asm volatile("s_waitcnt vmcnt(0)" ::: "memory");
    __syncthreads();
    if (tid == 0) {
        unsigned* bar = b.bar;
        __builtin_amdgcn_s_waitcnt(0);
        unsigned nloc = b.st[0], nx = b.st[1];
        if (nloc == 0u) { xcd_barrier_complete(bar, b.x, nloc, nx); b.st[0] = nloc; b.st[1] = nx; }
        const unsigned old = xb_add(&bar[XB_XSUB(b.x)], 1u);
        const unsigned gen = old / nloc;
        if (old + 1u == (gen + 1u) * nloc) {
            __builtin_amdgcn_fence(__ATOMIC_RELEASE, "agent");
            asm volatile("s_waitcnt vmcnt(0)" ::: "memory");
            const unsigned og = xb_add(&bar[XB_TOP], 1u);
            const unsigned tg = og / nx;
            if (og + 1u == (tg + 1u) * nx) xb_add(&bar[XB_TOPGEN], 1u);
            else XB_SPIN(xb_ld(&bar[XB_TOPGEN]) == tg, bar);
            __builtin_amdgcn_fence(__ATOMIC_ACQUIRE, "agent");
            xb_add(&bar[XB_XGEN(b.x)], 1u);
            asm volatile("s_waitcnt vmcnt(0)" ::: "memory");
        } else {
            XB_SPIN(xb_ld(&bar[XB_XGEN(b.x)]) == gen, bar);
            __builtin_amdgcn_fence(__ATOMIC_ACQUIRE, "agent");
            asm volatile("s_waitcnt vmcnt(0)" ::: "memory");
        }
    }
    __syncthreads();
}
__device__ __forceinline__ void wg_global_sync(int tid) {
    asm volatile("s_waitcnt vmcnt(0)" ::: "memory");
    __syncthreads();
    if (tid == 0) { __builtin_amdgcn_fence(__ATOMIC_ACQUIRE, "agent"); asm volatile("s_waitcnt vmcnt(0)" ::: "memory"); }
    __syncthreads();
}

namespace pg8 {
constexpr int BM = 256, BK = 64, HALF = 128, HTB = HALF * BK * 2, STAGE_BYTES = 8 * HTB, NXCD = 8, WGM = 8;
__host__ __device__ __forceinline__ int lds_byte(int r, int c) { const int st = (r >> 4) * 2 + (c >> 5), rr = r & 15, cc = c & 31, ob = rr * 64 + cc * 2; return st * 1024 + (ob ^ (((ob >> 9) & 1) << 5)); }
__host__ __device__ __forceinline__ void stage_rc(int b, int& R, int& C) { const int st = b / 1024, sb = b % 1024, swz = sb ^ (((sb >> 9) & 1) << 5); R = (st >> 1) * 16 + swz / 64; C = (st & 1) * 32 + (swz % 64) / 2; }
__host__ __device__ __forceinline__ int perm32(int rho) { const int n = rho >> 4, i = rho & 15; return 8 * (i >> 2) + 4 * n + (i & 3); }

struct Unit { int pm, pn, e, r, nvalid, ui; const char* pa; const char* pb; };

struct StaticOrder {
    int nM, nN, nwg, G, c; const char* A; const char* Bt; size_t atile, btile;
    __device__ void init(const void* A_, const void* Bt_, int M, int N, int lda, int ldb, int G_, int c_) { nM = M / BM; nN = N / BM; nwg = nM * nN; G = G_; c = c_; A = (const char*)A_; Bt = (const char*)Bt_; atile = (size_t)BM * lda * 2; btile = (size_t)BM * ldb * 2; }
    __device__ bool next(int i, Unit& u) const {
        const long L = (long)i * G + c; if (L >= nwg) return false;
        int wgid = (int)L; { const int q = nwg / NXCD, r = nwg % NXCD, xcd = wgid % NXCD, off = wgid / NXCD; wgid = (xcd < r ? xcd * (q + 1) : r * (q + 1) + (xcd - r) * q) + off; }
        const int nig = WGM * nN, gid = wgid / nig, fm = gid * WGM, gsz = (nM - fm) < WGM ? (nM - fm) : WGM;
        u.pm = fm + ((wgid % nig) % gsz); u.pn = (wgid % nig) / gsz; u.e = 0; u.r = 0; u.nvalid = 256; u.ui = i;
        u.pa = A + (size_t)u.pm * atile; u.pb = Bt + (size_t)u.pn * btile; return true;
    }
    __device__ __forceinline__ unsigned row_off(const Unit&, int) const { return 0u; }
};
struct KvOrder {
    const char* memn; const char* wkv; int G, c;
    __device__ bool next(int i, Unit& u) const {
        const int L = i * G + c; if (L >= 64) return false;
        u.r = 0; u.nvalid = 256; u.ui = i;
        if (L < 32) { u.e = 0; u.pm = L >> 2; u.pn = L & 3; u.pa = memn + (size_t)u.pm * 256 * 2048; u.pb = wkv + (size_t)u.pn * 256 * 2048; }
        else { const int l = L - 32; u.e = 1; u.pm = l >> 3; u.pn = l & 7; u.pa = wkv + (size_t)(1024 + u.pm * 256) * 2048; u.pb = memn + (size_t)u.pn * 256 * 2048; }
        return true;
    }
    __device__ __forceinline__ unsigned row_off(const Unit&, int) const { return 0u; }
};
struct SingleUnit {
    Unit u;
    __device__ bool next(int i, Unit& o) const { if (i != 0) return false; o = u; return true; }
    __device__ __forceinline__ unsigned row_off(const Unit&, int) const { return 0u; }
};
struct MoeOrder {
    const LAS int* ecnt; const LAS int* etp; const LAS int* xe; const LAS int* tokt;
    int x, cl, nloc, npn; const char* Abase; const char* Bbase; size_t b_expert; unsigned rowbytes, b_rowbytes; bool gather;
    __device__ bool next(int i, Unit& u) const {
        int j = i * nloc + cl;
        for (int k = 0; k < 4; ++k) { const int e = __builtin_amdgcn_readfirstlane(xe[x * 4 + k]), tp0 = __builtin_amdgcn_readfirstlane(etp[e]), nrt = __builtin_amdgcn_readfirstlane(etp[e + 1]) - tp0, n = nrt * npn;
            if (j < n) { const int pn = __builtin_amdgcn_readfirstlane(j / nrt), r = j - pn * nrt; u.pm = tp0 + r; u.pn = pn; u.e = e; u.r = r; u.nvalid = min(256, __builtin_amdgcn_readfirstlane(ecnt[e]) - r * 256); u.ui = i;
                u.pa = gather ? Abase : Abase + (size_t)u.pm * 256 * rowbytes; u.pb = Bbase + (size_t)e * b_expert + (size_t)pn * 256 * b_rowbytes; return true; }
            j -= n; }
        return false;
    }
    __device__ __forceinline__ unsigned row_off(const Unit& uu, int r) const { return (unsigned)tokt[uu.ui * 256 + r] * rowbytes; }
};

template <class Epi, class Sched, bool ALIGN_EPI, bool GATHER, bool F8>
__device__ __forceinline__ void gemm_phase(LAS unsigned char* lds, const int wv, const int KB, const int ldaB, const int ldbB, const Sched& S, const Epi& E, const int krep = 1) {
    int tid_ = wv * 64 + lane_id(); asm volatile("" : "+v"(tid_));
    const int tid = tid_, wid = __builtin_amdgcn_readfirstlane(tid >> 6), lane = tid & 63, wr = wid >> 2, wc = wid & 3, fr = lane & 15, fq = lane >> 4;
    const int nt1 = KB / 128, nt = nt1 * krep;
    Unit cur, nxt; int ui = 0;
    if (!S.next(0, cur)) return;
    unsigned voffA[GATHER ? 2 : 1][2], voffB[2];
#pragma unroll
    for (int i = 0; i < 2; ++i) { int R, C; stage_rc(tid * 16 + i * 8192, R, C); const int Rb = Epi::PERM ? ((R & ~31) + perm32(R & 31)) : R;
        if constexpr (GATHER) { voffA[0][i] = S.row_off(cur, R) + (unsigned)C * 2u; voffA[1][i] = S.row_off(cur, R + HALF) + (unsigned)C * 2u; }
        else { voffA[0][i] = (unsigned)(R * ldaB + C * 2); }
        voffB[i] = (unsigned)(Rb * ldbB + C * 2); }
    const size_t kstep = (size_t)(BK * 2);
    const size_t hstepA = GATHER ? (size_t)0 : (size_t)HALF * ldaB, hstepB = (size_t)HALF * ldbB;
    const unsigned ldsw = (unsigned)wid * 1024u;
    const int aoff = lds_byte(wr * 64 + fr, fq * 8), boff = lds_byte(wc * 32 + fr, fq * 8);
#define PG8_SA(b, h) (((b) * 2 + (h)) * HTB)
#define PG8_SB(b, h) ((4 + (b) * 2 + (h)) * HTB)
#define PG8_STAGE(bufoff, gbase, voff) do { _Pragma("unroll") for (int _i = 0; _i < 2; ++_i) \
        __builtin_amdgcn_global_load_lds((const unsigned*)((const char*)(gbase) + (voff)[_i]), (LAS unsigned*)(lds + (bufoff) + ldsw + _i * 8192), 16, 0, 0); } while (0)
#define PG8_STAGEA(bufoff, gbase, h) PG8_STAGE(bufoff, (gbase) + (h) * hstepA, voffA[GATHER ? (h) : 0])
#define PG8_STAGEB(bufoff, gbase, h) PG8_STAGE(bufoff, (gbase) + (h) * hstepB, voffB)
#define PG8_RD(off) (*(const LAS i32x4*)(lds + (off)))
#define PG8_CAT8(x0, x1) __builtin_shufflevector(x0, x1, 0, 1, 2, 3, 4, 5, 6, 7)
#define PG8_LDA(dst, b, h) do { if constexpr (F8) { _Pragma("unroll") for (int m = 0; m < 4; ++m) { const i32x4 l_ = PG8_RD(PG8_SA(b, h) + aoff + m * 2048), h_ = PG8_RD(PG8_SA(b, h) + aoff + m * 2048 + 1024); dst##8[m] = PG8_CAT8(l_, h_); } } \
        else { _Pragma("unroll") for (int m = 0; m < 4; ++m) _Pragma("unroll") for (int k = 0; k < 2; ++k) dst[m][k] = *(const LAS bf16x8*)(lds + PG8_SA(b, h) + aoff + m * 2048 + k * 1024); } } while (0)
#define PG8_LDB(dst, b, h) do { if constexpr (F8) { _Pragma("unroll") for (int n = 0; n < 2; ++n) { const i32x4 l_ = PG8_RD(PG8_SB(b, h) + boff + n * 2048), h_ = PG8_RD(PG8_SB(b, h) + boff + n * 2048 + 1024); dst##8[n] = PG8_CAT8(l_, h_); } } \
        else { _Pragma("unroll") for (int n = 0; n < 2; ++n) _Pragma("unroll") for (int k = 0; k < 2; ++k) dst[n][k] = *(const LAS bf16x8*)(lds + PG8_SB(b, h) + boff + n * 2048 + k * 1024); } } while (0)
#define PG8_MMA(ai, bj, At, Bt) do { __builtin_amdgcn_s_setprio(1); \
        if constexpr (F8) { _Pragma("unroll") for (int m = 0; m < 4; ++m) _Pragma("unroll") for (int n = 0; n < 2; ++n) \
            acc[ai][bj][m][n] = __builtin_amdgcn_mfma_scale_f32_16x16x128_f8f6f4(Bt##8[n], At##8[m], acc[ai][bj][m][n], 0, 0, 0, 0x7f7f7f7f, 0, 0x7f7f7f7f); } \
        else { _Pragma("unroll") for (int m = 0; m < 4; ++m) _Pragma("unroll") for (int n = 0; n < 2; ++n) _Pragma("unroll") for (int k = 0; k < 2; ++k) \
            acc[ai][bj][m][n] = __builtin_amdgcn_mfma_f32_16x16x32_bf16(Bt[n][k], At[m][k], acc[ai][bj][m][n], 0, 0, 0); } \
        __builtin_amdgcn_s_setprio(0); } while (0)
#define PG8_WAIT_V(n) asm volatile("s_waitcnt vmcnt(" #n ")" ::: "memory")
#define PG8_WAIT_L(n) asm volatile("s_waitcnt lgkmcnt(" #n ")" ::: "memory")
#define PG8_BAR __builtin_amdgcn_s_barrier()
#define PG8_SCHED __builtin_amdgcn_sched_barrier(0)
    f32x4 acc[2][2][4][2];
#pragma unroll
    for (int a = 0; a < 2; ++a)
#pragma unroll
        for (int b = 0; b < 2; ++b)
#pragma unroll
            for (int m = 0; m < 4; ++m)
#pragma unroll
                for (int n = 0; n < 2; ++n) acc[a][b][m][n] = (f32x4){0.f, 0.f, 0.f, 0.f};
    bf16x8 At[4][2], B0[2][2], B1[2][2]; i32x8 At8[4], B08[2], B18[2]; (void)At; (void)B0; (void)B1; (void)At8; (void)B08; (void)B18;
    const char* cA = cur.pa; const char* cB = cur.pb;
    PG8_STAGEB(PG8_SB(0, 0), cB, 0); PG8_STAGEB(PG8_SB(0, 1), cB, 1); PG8_STAGEA(PG8_SA(0, 0), cA, 0); PG8_STAGEA(PG8_SA(0, 1), cA, 1);
    if (wr == 1) PG8_BAR;
    PG8_WAIT_V(2); PG8_BAR;
    PG8_STAGEB(PG8_SB(1, 0), cB + kstep, 0); PG8_STAGEA(PG8_SA(1, 0), cA + kstep, 0); PG8_STAGEB(PG8_SB(1, 1), cB + kstep, 1);
    PG8_WAIT_V(6); PG8_BAR;
    for (;;) {
        const bool has_next = S.next(ui + 1, nxt);
        const char* nA = has_next ? nxt.pa : cA; const char* nB = has_next ? nxt.pb : cB;
#pragma unroll 1
        for (int t = 0; t < nt; t += 2) {
            const bool last = (t == nt - 2);
            const char* a1 = cA + (size_t)((t + 1) & (nt1 - 1)) * kstep;
            const char* a2 = last ? nA : cA + (size_t)((t + 2) & (nt1 - 1)) * kstep; const char* b2 = last ? nB : cB + (size_t)((t + 2) & (nt1 - 1)) * kstep;
            const char* a3 = a2 + kstep; const char* b3 = b2 + kstep;
            PG8_LDB(B0, 0, 0); PG8_LDB(B1, 0, 1); PG8_SCHED; PG8_LDA(At, 0, 0); PG8_STAGEA(PG8_SA(1, 1), a1, 1);
            if constexpr (GATHER) { if (last && has_next) {
#pragma unroll
                for (int i = 0; i < 2; ++i) { int R, C; stage_rc(tid * 16 + i * 8192, R, C); voffA[0][i] = S.row_off(nxt, R) + (unsigned)C * 2u; voffA[1][i] = S.row_off(nxt, R + HALF) + (unsigned)C * 2u; } } }
            PG8_WAIT_V(8); PG8_WAIT_L(0); PG8_BAR; PG8_MMA(0, 0, At, B0); PG8_MMA(0, 1, At, B1); PG8_BAR; PG8_SCHED;
            PG8_LDA(At, 0, 1); PG8_STAGEB(PG8_SB(0, 0), b2, 0); PG8_STAGEB(PG8_SB(0, 1), b2, 1); PG8_STAGEA(PG8_SA(0, 0), a2, 0);
            PG8_WAIT_V(8); PG8_WAIT_L(0); PG8_BAR; PG8_MMA(1, 0, At, B0); PG8_MMA(1, 1, At, B1); PG8_BAR; PG8_SCHED;
            PG8_LDB(B0, 1, 0); PG8_LDB(B1, 1, 1); PG8_SCHED; PG8_LDA(At, 1, 0); PG8_STAGEA(PG8_SA(0, 1), a2, 1);
            PG8_WAIT_V(8); PG8_WAIT_L(0); PG8_BAR; PG8_MMA(0, 0, At, B0); PG8_MMA(0, 1, At, B1); PG8_BAR; PG8_SCHED;
            PG8_LDA(At, 1, 1); PG8_STAGEB(PG8_SB(1, 0), b3, 0); PG8_STAGEB(PG8_SB(1, 1), b3, 1); PG8_STAGEA(PG8_SA(1, 0), a3, 0);
            PG8_WAIT_V(8); PG8_WAIT_L(0); PG8_BAR; PG8_MMA(1, 0, At, B0); PG8_MMA(1, 1, At, B1); PG8_BAR; PG8_SCHED;
        }
        if constexpr (ALIGN_EPI) { if (wr == 0) PG8_BAR; }
        if (krep > 1) { const float sc_ = 1.0f / (float)krep;
#pragma unroll
            for (int a = 0; a < 2; ++a)
#pragma unroll
                for (int b = 0; b < 2; ++b)
#pragma unroll
                    for (int m = 0; m < 4; ++m)
#pragma unroll
                        for (int n = 0; n < 2; ++n) acc[a][b][m][n] = acc[a][b][m][n] * sc_; }
        if constexpr (!Epi::AFTER_DRAIN) { int fr_ = fr, fq_ = fq; asm volatile("" : "+v"(fr_), "+v"(fq_));
            E(acc, cur, wr, wc, fr_, fq_); }
        if (!has_next) break;
#pragma unroll
        for (int a = 0; a < 2; ++a)
#pragma unroll
            for (int b = 0; b < 2; ++b)
#pragma unroll
                for (int m = 0; m < 4; ++m)
#pragma unroll
                    for (int n = 0; n < 2; ++n) acc[a][b][m][n] = (f32x4){0.f, 0.f, 0.f, 0.f};
        cur = nxt; cA = nA; cB = nB; ++ui;
        if constexpr (ALIGN_EPI) { if (wr == 1) PG8_BAR; }
    }
    PG8_WAIT_V(0);
    if constexpr (!ALIGN_EPI) { if (wr == 0) PG8_BAR; }
    PG8_BAR;
    if constexpr (Epi::AFTER_DRAIN) { int fr_ = fr, fq_ = fq; asm volatile("" : "+v"(fr_), "+v"(fq_)); E.fused(acc, cur, wr, wc, fr_, fq_, lds, wid, lane); }
#undef PG8_SA
#undef PG8_SB
#undef PG8_STAGE
#undef PG8_STAGEA
#undef PG8_STAGEB
#undef PG8_LDA
#undef PG8_LDB
#undef PG8_MMA
#undef PG8_CAT8
#undef PG8_RD
#undef PG8_WAIT_V
#undef PG8_WAIT_L
#undef PG8_BAR
#undef PG8_SCHED
}

typedef const f32x4 (&AccC)[2][2][4][2];
typedef f32x4 (&AccM)[2][2][4][2];

struct EpiInProj {
    static constexpr bool PERM = true, AFTER_DRAIN = false;
    bf16_t* U; const float* cs;
    __device__ __forceinline__ void operator()(AccC acc, const Unit& u, int wr, int wc, int fr, int fq) const {
        const int row0 = u.pm * BM + wr * 64 + fr, col0 = u.pn * BM + wc * 32 + 8 * fq;
        const bool rot = (u.pn >= 2) && (u.pn < 6) && ((wc & 1) == 0) && (fq < 2);
        const float sc = (u.pn == 2 || u.pn == 3) ? QSCALE_D : 1.f;
#pragma unroll
        for (int ai = 0; ai < 2; ++ai)
#pragma unroll
            for (int m = 0; m < 4; ++m) {
                const int row = row0 + ai * HALF + m * 16;
                f32x4 c0 = (f32x4){1.f, 0.f, 1.f, 0.f}, c1 = (f32x4){1.f, 0.f, 1.f, 0.f};
                if (rot) { const f32x4* cp = (const f32x4*)(cs + (size_t)row * 16 + 8 * fq); c0 = cp[0]; c1 = cp[1]; }
                bf16_t* rowp = U + (size_t)row * INW + col0;
#pragma unroll
                for (int bj = 0; bj < 2; ++bj) {
                    f32x4 v0 = acc[ai][bj][m][0], v1 = acc[ai][bj][m][1];
                    f32x4 w0, w1;
                    w0[0] = v0[0] * c0[0] - v0[1] * c0[1]; w0[1] = v0[1] * c0[0] + v0[0] * c0[1];
                    w0[2] = v0[2] * c0[2] - v0[3] * c0[3]; w0[3] = v0[3] * c0[2] + v0[2] * c0[3];
                    w1[0] = v1[0] * c1[0] - v1[1] * c1[1]; w1[1] = v1[1] * c1[0] + v1[0] * c1[1];
                    w1[2] = v1[2] * c1[2] - v1[3] * c1[3]; w1[3] = v1[3] * c1[2] + v1[2] * c1[3];
                    w0 = w0 * sc; w1 = w1 * sc;
                    u32x4 w; w.x = cvt_pk_bf16(w0[0], w0[1]); w.y = cvt_pk_bf16(w0[2], w0[3]); w.z = cvt_pk_bf16(w1[0], w1[1]); w.w = cvt_pk_bf16(w1[2], w1[3]);
                    *(u32x4*)(rowp + bj * HALF) = w; }
            }
    }
};
struct EpiBf16 {
    static constexpr bool PERM = true, AFTER_DRAIN = false;
    bf16_t* O; int ldc; const LAS float* rs; float mul;
    __device__ __forceinline__ void operator()(AccC acc, const Unit& u, int wr, int wc, int fr, int fq) const {
        const int rt0 = wr * 64 + fr, col0 = u.pn * BM + wc * 32 + 8 * fq;
#pragma unroll
        for (int ai = 0; ai < 2; ++ai)
#pragma unroll
            for (int m = 0; m < 4; ++m) {
                const int rt = rt0 + ai * HALF + m * 16;
                const float s = rs ? rs[rt] * mul : mul;
                bf16_t* rowp = O + (size_t)(u.pm * BM + rt) * ldc + col0;
#pragma unroll
                for (int bj = 0; bj < 2; ++bj) { const f32x4 v0 = acc[ai][bj][m][0] * s, v1 = acc[ai][bj][m][1] * s;
                    u32x4 w; w.x = cvt_pk_bf16(v0[0], v0[1]); w.y = cvt_pk_bf16(v0[2], v0[3]); w.z = cvt_pk_bf16(v1[0], v1[1]); w.w = cvt_pk_bf16(v1[2], v1[3]);
                    *(u32x4*)(rowp + bj * HALF) = w; }
            }
    }
};
struct EpiBf16Sel {
    static constexpr bool PERM = true, AFTER_DRAIN = false;
    bf16_t* O0; int ldc0; bf16_t* O1; int ldc1;
    __device__ __forceinline__ void operator()(AccC acc, const Unit& u, int wr, int wc, int fr, int fq) const {
        bf16_t* O = u.e ? O1 : O0; const int ldc = u.e ? ldc1 : ldc0;
        const int rt0 = wr * 64 + fr, col0 = u.pn * BM + wc * 32 + 8 * fq;
#pragma unroll
        for (int ai = 0; ai < 2; ++ai)
#pragma unroll
            for (int m = 0; m < 4; ++m) {
                const int rt = rt0 + ai * HALF + m * 16;
                bf16_t* rowp = O + (size_t)(u.pm * BM + rt) * ldc + col0;
#pragma unroll
                for (int bj = 0; bj < 2; ++bj) { const f32x4 v0 = acc[ai][bj][m][0], v1 = acc[ai][bj][m][1];
                    u32x4 w; w.x = cvt_pk_bf16(v0[0], v0[1]); w.y = cvt_pk_bf16(v0[2], v0[3]); w.z = cvt_pk_bf16(v1[0], v1[1]); w.w = cvt_pk_bf16(v1[2], v1[3]);
                    *(u32x4*)(rowp + bj * HALF) = w; }
            }
    }
};
template <bool F8OUT> struct EpiRes {
    static constexpr bool PERM = false, AFTER_DRAIN = false;
    const float* resid; float* xo; void* xb; float* ssp;
    __device__ __forceinline__ void operator()(AccC acc, const Unit& u, int wr, int wc, int fr, int fq) const {
        const int row0 = u.pm * BM + wr * 64 + fr, col0 = u.pn * BM + wc * 32 + 4 * fq;
#pragma unroll
        for (int ai = 0; ai < 2; ++ai)
#pragma unroll
            for (int m = 0; m < 4; ++m) {
                const int row = row0 + ai * HALF + m * 16; const size_t off = (size_t)row * D + col0; float ss = 0.f;
#pragma unroll
                for (int bj = 0; bj < 2; ++bj)
#pragma unroll
                    for (int n = 0; n < 2; ++n) { const size_t o2 = off + bj * HALF + n * 16; const f32x4 v = *(const f32x4*)(resid + o2) + acc[ai][bj][m][n];
                        *(f32x4*)(xo + o2) = v; ss += (v[0] * v[0] + v[1] * v[1]) + (v[2] * v[2] + v[3] * v[3]);
                        if constexpr (F8OUT) { *(unsigned*)((unsigned char*)xb + o2) = pk4_fp8(v[0], v[1], v[2], v[3]); }
                        else { u32x2 w; w.x = cvt_pk_bf16(v[0], v[1]); w.y = cvt_pk_bf16(v[2], v[3]); *(u32x2*)((bf16_t*)xb + o2) = w; } }
                if (ssp) { ss += __shfl_xor(ss, 16); ss += __shfl_xor(ss, 32); if (fq == 0) ssp[(size_t)(u.pn * 4 + wc) * T + row] = ss; }
            }
    }
};
struct EpiSoftmax {
    static constexpr bool PERM = true, AFTER_DRAIN = true;
    bf16_t* O; int ldc;
    __device__ __forceinline__ void fused(AccM acc, const Unit& u, int wr, int wc, int fr, int fq, LAS unsigned char* lds, int wid, int lane) const {
        LAS float* PM = (LAS float*)lds; LAS float* PS = (LAS float*)(lds + 4096);
#pragma unroll
        for (int ai = 0; ai < 2; ++ai)
#pragma unroll
            for (int m = 0; m < 4; ++m) { float v = -INFINITY;
#pragma unroll
                for (int bj = 0; bj < 2; ++bj)
#pragma unroll
                    for (int n = 0; n < 2; ++n) { const f32x4 x = acc[ai][bj][m][n]; v = fmaxf(v, fmaxf(fmaxf(x[0], x[1]), fmaxf(x[2], x[3]))); }
                v = fmaxf(v, __shfl_xor(v, 16)); v = fmaxf(v, __shfl_xor(v, 32));
                if (fq == 0) PM[(ai * HALF + wr * 64 + m * 16 + fr) * 4 + wc] = v; }
        LDS_WAIT(); __builtin_amdgcn_s_barrier(); asm volatile("" ::: "memory");
#pragma unroll
        for (int ai = 0; ai < 2; ++ai)
#pragma unroll
            for (int m = 0; m < 4; ++m) { const int rt = ai * HALF + wr * 64 + m * 16 + fr; const f32x4 q = *(const LAS f32x4*)(PM + rt * 4);
                const float mx = fmaxf(fmaxf(q[0], q[1]), fmaxf(q[2], q[3])); float s = 0.f;
#pragma unroll
                for (int bj = 0; bj < 2; ++bj)
#pragma unroll
                    for (int n = 0; n < 2; ++n) { f32x4 x = acc[ai][bj][m][n];
                        x[0] = __builtin_amdgcn_exp2f(x[0] - mx); x[1] = __builtin_amdgcn_exp2f(x[1] - mx); x[2] = __builtin_amdgcn_exp2f(x[2] - mx); x[3] = __builtin_amdgcn_exp2f(x[3] - mx);
                        s += (x[0] + x[1]) + (x[2] + x[3]); acc[ai][bj][m][n] = x; }
                s += __shfl_xor(s, 16); s += __shfl_xor(s, 32);
                if (fq == 0) PS[rt * 4 + wc] = s; }
        LDS_WAIT(); __builtin_amdgcn_s_barrier(); asm volatile("" ::: "memory");
        const int col0 = u.pn * BM + wc * 32 + 8 * fq;
#pragma unroll
        for (int ai = 0; ai < 2; ++ai)
#pragma unroll
            for (int m = 0; m < 4; ++m) { const int rt = ai * HALF + wr * 64 + m * 16 + fr; const f32x4 q = *(const LAS f32x4*)(PS + rt * 4);
                const float inv = 1.0f / ((q[0] + q[1]) + (q[2] + q[3]));
                bf16_t* rowp = O + (size_t)(u.pm * BM + rt) * ldc + col0;
#pragma unroll
                for (int bj = 0; bj < 2; ++bj) { const f32x4 v0 = acc[ai][bj][m][0] * inv, v1 = acc[ai][bj][m][1] * inv;
                    u32x4 w; w.x = cvt_pk_bf16(v0[0], v0[1]); w.y = cvt_pk_bf16(v0[2], v0[3]); w.z = cvt_pk_bf16(v1[0], v1[1]); w.w = cvt_pk_bf16(v1[2], v1[3]);
                    *(u32x4*)(rowp + bj * HALF) = w; }
            }
        LDS_WAIT(); __builtin_amdgcn_s_barrier(); asm volatile("" ::: "memory");
    }
};
struct EpiSwiGLU {
    static constexpr bool PERM = true, AFTER_DRAIN = false;
    unsigned char* H; const float* bgu; const float* rstd; const LAS int* tokt;
    __device__ __forceinline__ void operator()(AccC acc, const Unit& u, int wr, int wc, int fr, int fq) const {
        const int rt0 = wr * 64 + fr, c0 = u.pn * HALF + wc * 32 + 8 * fq; const float* bg_ = bgu + (size_t)u.e * 2048;
        f32x4 bg[2], bu[2];
#pragma unroll
        for (int n = 0; n < 2; ++n) { bg[n] = *(const f32x4*)(bg_ + c0 + 4 * n); bu[n] = *(const f32x4*)(bg_ + 1024 + c0 + 4 * n); }
#pragma unroll
        for (int ai = 0; ai < 2; ++ai)
#pragma unroll
            for (int m = 0; m < 4; ++m) {
                const int rt = rt0 + ai * HALF + m * 16;
                const float rs = rstd[tokt[u.ui * 256 + rt]] * 0.03125f;
                unsigned w[2];
#pragma unroll
                for (int n = 0; n < 2; ++n) { const f32x4 g4 = acc[ai][0][m][n] * rs + bg[n], u4 = acc[ai][1][m][n] * rs + bu[n]; float h[4];
#pragma unroll
                    for (int j = 0; j < 4; ++j) { const float g = fminf(g4[j], 7.0f), up = fminf(fmaxf(u4[j], -7.0f), 7.0f);
                        const float sg = __builtin_amdgcn_rcpf(1.0f + __builtin_amdgcn_exp2f(-1.702f * LOG2E * g)); h[j] = (up + 1.0f) * g * sg; }
                    w[n] = pk4_fp8(h[0] * 4.0f, h[1] * 4.0f, h[2] * 4.0f, h[3] * 4.0f); }
                *(u32x2*)(H + (size_t)(u.pm * BM + rt) * 1024 + c0) = (u32x2){w[0], w[1]};
            }
    }
};
struct EpiDown {
    static constexpr bool PERM = true, AFTER_DRAIN = false;
    bf16_t* Y; const float* bd; const float* gates;
    __device__ __forceinline__ void operator()(AccC acc, const Unit& u, int wr, int wc, int fr, int fq) const {
        const int rt0 = wr * 64 + fr, col0 = u.pn * BM + wc * 32 + 8 * fq; const float* bd_ = bd + (size_t)u.e * 1024; const float* gt_ = gates + (size_t)u.e * CAP + u.r * 256;
        f32x4 bv[2][2];
#pragma unroll
        for (int bj = 0; bj < 2; ++bj)
#pragma unroll
            for (int n = 0; n < 2; ++n) bv[bj][n] = *(const f32x4*)(bd_ + col0 + bj * HALF + 4 * n);
#pragma unroll
        for (int ai = 0; ai < 2; ++ai)
#pragma unroll
            for (int m = 0; m < 4; ++m) {
                const int rt = rt0 + ai * HALF + m * 16;
                const float g = (rt < u.nvalid) ? gt_[rt] : 0.f;
                bf16_t* rowp = Y + (size_t)(u.pm * BM + rt) * 1024 + col0;
#pragma unroll
                for (int bj = 0; bj < 2; ++bj) { const f32x4 v0 = (acc[ai][bj][m][0] * 0.0078125f + bv[bj][0]) * g, v1 = (acc[ai][bj][m][1] * 0.0078125f + bv[bj][1]) * g;
                    u32x4 w; w.x = cvt_pk_bf16(v0[0], v0[1]); w.y = cvt_pk_bf16(v0[2], v0[3]); w.z = cvt_pk_bf16(v1[0], v1[1]); w.w = cvt_pk_bf16(v1[2], v1[3]);
                    *(u32x4*)(rowp + bj * HALF) = w; }
            }
    }
};
}

struct Args {
    const float* x; const int* pos; const float* mem; const float* attn_g; const float* w_in; const float* w_pool; const float* pool_scale;
    const float* lq1; const float* lk1; const float* lq2; const float* lk2; const float* subln_g; const float* w_out; const float* xattn_g; const float* mem_g;
    const float* w_cq; const float* w_ckv; const float* w_co; const float* ffn_g; const float* w_router; const float* b_router; const float* w_gu; const float* b_gu;
    const float* w_down; const float* b_down; const float* final_g;
    float* out; unsigned char* ws; int ph_lo, ph_hi;
};

template <int MAP>
__device__ __forceinline__ int rowmap(int c) {
    if (MAP == 1) { if (c >= 512 && c < 1536) { const int d = c & 63; if (d < 16) return (c & ~63) + ((d < 8) ? 2 * d : 2 * (d - 8) + 1); } return c; }
    if (MAP == 2) { const int j = c & 1023; return ((j >> 7) << 8) + ((c >> 10) << 7) + (j & 127); }
    return c;
}
template <int MAP, bool OUT8>
__device__ __forceinline__ void p0_transpose_stream(const float* W, int K, int N, int nmat, void* WTv, int ldt, int kdst0, size_t dst_stride, const float* g, LAS float* scr, int gw, int NGW, int lane) {
    const int nblk = N / 32, ipm = (K / 64) * nblk, nitems = nmat * ipm;
    const int lr = lane >> 3, lc = (lane & 7) * 4;
    f32x4 cur[8], nxt[8];
#define P0_LOAD(dst, it) do { const int e_ = (it) / ipm, r_ = (it) % ipm, kb_ = r_ / nblk, nb_ = r_ % nblk; const float* p_ = W + ((size_t)e_ * K + 64 * kb_ + lr) * N + 32 * nb_ + lc; \
        _Pragma("unroll") for (int i_ = 0; i_ < 8; ++i_) dst[i_] = *(const f32x4*)(p_ + (size_t)(8 * i_) * N); } while (0)
    int it = gw;
    if (it < nitems) P0_LOAD(cur, it);
    while (it < nitems) {
        const int itn = it + NGW;
        if (itn < nitems) P0_LOAD(nxt, itn);
        const int e = it / ipm, r = it % ipm, kb = r / nblk, nb = r % nblk, k0 = 64 * kb, n0 = 32 * nb;
#pragma unroll
        for (int i = 0; i < 8; ++i) { const int kk = 8 * i + lr; f32x4 v = cur[i]; if (g) v = v * g[k0 + kk];
            LAS float* s = scr + kk * 33 + lc; s[0] = v[0]; s[1] = v[1]; s[2] = v[2]; s[3] = v[3]; }
        LDS_WAIT(); asm volatile("" ::: "memory");
        if constexpr (OUT8) {
            const int c = lane & 3; unsigned char* wt = (unsigned char*)WTv + (size_t)e * dst_stride;
#pragma unroll
            for (int j = 0; j < 2; ++j) { const int n = (lane >> 2) + 16 * j; const LAS float* s = scr + (16 * c) * 33 + n;
                u32x4 o; o.x = pk4_fp8(s[0 * 33] * 32.f, s[1 * 33] * 32.f, s[2 * 33] * 32.f, s[3 * 33] * 32.f); o.y = pk4_fp8(s[4 * 33] * 32.f, s[5 * 33] * 32.f, s[6 * 33] * 32.f, s[7 * 33] * 32.f);
                o.z = pk4_fp8(s[8 * 33] * 32.f, s[9 * 33] * 32.f, s[10 * 33] * 32.f, s[11 * 33] * 32.f); o.w = pk4_fp8(s[12 * 33] * 32.f, s[13 * 33] * 32.f, s[14 * 33] * 32.f, s[15 * 33] * 32.f);
                *(u32x4*)(wt + (size_t)rowmap<MAP>(n0 + n) * ldt + kdst0 + k0 + 16 * c) = o; }
        } else {
            const int c = lane & 7; bf16_t* wt = (bf16_t*)WTv + (size_t)e * dst_stride;
#pragma unroll
            for (int j = 0; j < 4; ++j) { const int n = (lane >> 3) + 8 * j; const LAS float* s = scr + (8 * c) * 33 + n;
                u32x4 o; o.x = pk2(s[0 * 33], s[1 * 33]); o.y = pk2(s[2 * 33], s[3 * 33]); o.z = pk2(s[4 * 33], s[5 * 33]); o.w = pk2(s[6 * 33], s[7 * 33]);
                *(u32x4*)(wt + (size_t)rowmap<MAP>(n0 + n) * ldt + kdst0 + k0 + 8 * c) = o; }
        }
        LDS_WAIT(); asm volatile("" ::: "memory");
#pragma unroll
        for (int i = 0; i < 8; ++i) cur[i] = nxt[i];
        it = itn;
    }
#undef P0_LOAD
}
__device__ __forceinline__ void rms_row_to_bf16(const float* xrow, const float* g, bf16_t* orow, int lane) {
    const f32x4* xr = (const f32x4*)xrow + lane; const f32x4* gr = (const f32x4*)g + lane;
    f32x4 v[4]; float s = 0.f;
#pragma unroll
    for (int j = 0; j < 4; ++j) { v[j] = xr[64 * j]; s += (v[j][0] * v[j][0] + v[j][1] * v[j][1]) + (v[j][2] * v[j][2] + v[j][3] * v[j][3]); }
    const float rstd = 1.0f / sqrtf(wave_sum(s) * (1.0f / D) + EPS);
    u32x2* o8 = (u32x2*)orow + lane;
#pragma unroll
    for (int j = 0; j < 4; ++j) { const f32x4 gg = gr[64 * j]; u32x2 w; w.x = pk2(v[j][0] * rstd * gg[0], v[j][1] * rstd * gg[1]); w.y = pk2(v[j][2] * rstd * gg[2], v[j][3] * rstd * gg[3]); o8[64 * j] = w; }
}

namespace dattn {
constexpr int KP = 144, VP = 320;
constexpr int K_BYTES = 2 * 64 * KP, V_BYTES = 64 * VP;
constexpr int V_OFF = 2 * K_BYTES;
constexpr float THR = 4.0f;
__device__ __forceinline__ s16x4 vtr(const LAS unsigned char* p) { typedef short v4i16_t __attribute__((ext_vector_type(4))); return __builtin_bit_cast(s16x4, __builtin_amdgcn_ds_read_tr16_b64_v4i16((LAS v4i16_t*)p)); }
__device__ __forceinline__ void pv_tile(f32x16 (&o)[4], const bf16x8 (&pf)[4], const float alpha, const bool resc, const LAS unsigned char* vb_) {
    unsigned vbo = (unsigned)(uintptr_t)vb_; asm volatile("" : "+v"(vbo));
    const LAS unsigned char* vb = (const LAS unsigned char*)(uintptr_t)vbo;
    if (resc) {
#pragma unroll
        for (int d0 = 0; d0 < 4; ++d0)
#pragma unroll
            for (int r = 0; r < 16; ++r) o[d0][r] *= alpha;
    }
    s16x4 lo[2][4], hv[2][4];
#define PV_RD(buf, s) do { _Pragma("unroll") for (int d0 = 0; d0 < 4; ++d0) { lo[buf][d0] = vtr(vb + (s) * 16 * VP + d0 * 64); hv[buf][d0] = vtr(vb + (s) * 16 * VP + 8 * VP + d0 * 64); } } while (0)
#define PV_MM(buf, s) do { _Pragma("unroll") for (int d0 = 0; d0 < 4; ++d0) { const bf16x8 vf = (bf16x8){lo[buf][d0][0], lo[buf][d0][1], lo[buf][d0][2], lo[buf][d0][3], hv[buf][d0][0], hv[buf][d0][1], hv[buf][d0][2], hv[buf][d0][3]}; \
        o[d0] = __builtin_amdgcn_mfma_f32_32x32x16_bf16(vf, pf[s], o[d0], 0, 0, 0); } } while (0)
    PV_RD(0, 0); __builtin_amdgcn_sched_barrier(0);
    PV_RD(1, 1); __builtin_amdgcn_sched_barrier(0);
    PV_MM(0, 0); __builtin_amdgcn_sched_barrier(0);
    PV_RD(0, 2); __builtin_amdgcn_sched_barrier(0);
    PV_MM(1, 1); __builtin_amdgcn_sched_barrier(0);
    PV_RD(1, 3); __builtin_amdgcn_sched_barrier(0);
    PV_MM(0, 2); __builtin_amdgcn_sched_barrier(0);
    PV_MM(1, 3); __builtin_amdgcn_sched_barrier(0);
#undef PV_RD
#undef PV_MM
}
__device__ __forceinline__ void unit(LAS unsigned char* lds, const int wv, const bf16_t* U, bf16_t* CAT, const float* subln_g, float lam, int b, int hh, int j) {
    int tid_ = wv * 64 + lane_id(); asm volatile("" : "+v"(tid_));
    const int tid = tid_, lane = tid & 63, r32 = lane & 31, hi = lane >> 5; const int wid = __builtin_amdgcn_readfirstlane(tid >> 6);
    const int mp = wid & 1, rg = wid >> 1, grp = wid >> 2;
    const size_t tok0 = (size_t)b * SEQ;
    const int q0 = j * 128 + rg * 32;
    const int nt_all = 2 * j + 2, nt_mine = (rg < 2) ? nt_all - 1 : nt_all;
    bf16x8 qf[4];
    { const bf16_t* qp = U + (tok0 + q0 + r32) * INW + 512 + hh * 128 + mp * 64 + hi * 8;
#pragma unroll
      for (int ks = 0; ks < 4; ++ks) qf[ks] = *(const bf16x8*)(qp + ks * 16); }
    const int prow = tid >> 3, pc0 = (tid & 7) * 2;
    const bf16_t* kg = U + (tok0 + prow) * INW + 1024 + hh * 128 + pc0 * 8;
    const bf16_t* vg = U + (tok0 + prow) * INW + 1536 + hh * 128 + pc0 * 8;
    unsigned kdst[2], vdst[2];
#pragma unroll
    for (int i = 0; i < 2; ++i) { const int c16 = pc0 + i; kdst[i] = (unsigned)((c16 >> 3) * (64 * KP) + prow * KP + (c16 & 7) * 16); vdst[i] = (unsigned)(V_OFF + prow * VP + c16 * 16); }
    u32x4 kr[2], vr[2];
#define DA_LOAD(t) do { const size_t go = (size_t)(t) * 64 * INW; kr[0] = *(const u32x4*)(kg + go); kr[1] = *(const u32x4*)(kg + go + 8); vr[0] = *(const u32x4*)(vg + go); vr[1] = *(const u32x4*)(vg + go + 8); } while (0)
#define DA_WRITE(t) do { LAS unsigned char* kb_ = lds + ((t) & 1) * K_BYTES; LAS unsigned char* vb_ = lds + ((t) % 3) * V_BYTES; \
        *(LAS u32x4*)(kb_ + kdst[0]) = kr[0]; *(LAS u32x4*)(kb_ + kdst[1]) = kr[1]; *(LAS u32x4*)(vb_ + vdst[0]) = vr[0]; *(LAS u32x4*)(vb_ + vdst[1]) = vr[1]; } while (0)
    f32x16 o[4];
#pragma unroll
    for (int d0 = 0; d0 < 4; ++d0)
#pragma unroll
        for (int r = 0; r < 16; ++r) o[d0][r] = 0.f;
    float mrun = -INFINITY, lrun = 0.f, alpha = 1.f; bool resc = false;
    bf16x8 pf[4];
#pragma unroll
    for (int s = 0; s < 4; ++s) pf[s] = (bf16x8){0, 0, 0, 0, 0, 0, 0, 0};
    const int i16 = lane & 15, g16 = (lane >> 4) & 1;
    const unsigned kbase = (unsigned)(mp * (64 * KP) + r32 * KP + hi * 16);
    const unsigned vbase = (unsigned)(V_OFF + (4 * hi + (i16 >> 2)) * VP + (16 * g16 + 4 * (i16 & 3)) * 2);
    DA_LOAD(0); DA_WRITE(0);
    __syncthreads();
#pragma unroll 1
    for (int kt = 0; kt < nt_all; ++kt) {
        const bool more = (kt + 1 < nt_all);
        if (more) DA_LOAD(kt + 1);
        if (grp == 1 && kt >= 1) pv_tile(o, pf, alpha, resc, lds + vbase + ((unsigned)(kt + 2) % 3u) * (unsigned)V_BYTES);
        if (kt < nt_mine) {
            const LAS unsigned char* sb = lds + (kt & 1) * K_BYTES;
            f32x16 p0, p1;
#pragma unroll
            for (int r = 0; r < 16; ++r) { p0[r] = 0.f; p1[r] = 0.f; }
#pragma unroll
            for (int ks = 0; ks < 4; ++ks) {
                const bf16x8 k0 = *(const LAS bf16x8*)(sb + kbase + ks * 32), k1 = *(const LAS bf16x8*)(sb + kbase + 32 * KP + ks * 32);
                p0 = __builtin_amdgcn_mfma_f32_32x32x16_bf16(k0, qf[ks], p0, 0, 0, 0);
                p1 = __builtin_amdgcn_mfma_f32_32x32x16_bf16(k1, qf[ks], p1, 0, 0, 0);
            }
            float mx = fmaxf(p0[0], p1[0]);
#pragma unroll
            for (int r = 1; r < 16; ++r) mx = fmaxf(mx, fmaxf(p0[r], p1[r]));
            mx = fmaxf(mx, __shfl_xor(mx, 32));
            resc = __any(mx - mrun > THR) != 0;
            alpha = 1.f;
            if (resc) { const float mnew = fmaxf(mrun, mx); alpha = __builtin_amdgcn_exp2f(mrun - mnew); mrun = mnew; }
            float ls = 0.f;
#pragma unroll
            for (int r = 0; r < 16; ++r) { p0[r] = __builtin_amdgcn_exp2f(p0[r] - mrun); p1[r] = __builtin_amdgcn_exp2f(p1[r] - mrun); ls += p0[r] + p1[r]; }
            lrun = lrun * alpha + ls;
#pragma unroll
            for (int s = 0; s < 4; ++s) { u32x4 w;
                if (s < 2) { w.x = cvt_pk_bf16(p0[8 * s + 0], p0[8 * s + 1]); w.y = cvt_pk_bf16(p0[8 * s + 2], p0[8 * s + 3]); w.z = cvt_pk_bf16(p0[8 * s + 4], p0[8 * s + 5]); w.w = cvt_pk_bf16(p0[8 * s + 6], p0[8 * s + 7]); }
                else { const int s2 = s - 2; w.x = cvt_pk_bf16(p1[8 * s2 + 0], p1[8 * s2 + 1]); w.y = cvt_pk_bf16(p1[8 * s2 + 2], p1[8 * s2 + 3]); w.z = cvt_pk_bf16(p1[8 * s2 + 4], p1[8 * s2 + 5]); w.w = cvt_pk_bf16(p1[8 * s2 + 6], p1[8 * s2 + 7]); }
                pf[s] = __builtin_bit_cast(bf16x8, w); }
            if (grp == 0) pv_tile(o, pf, alpha, resc, lds + vbase + ((unsigned)kt % 3u) * (unsigned)V_BYTES);
        }
        if (more) DA_WRITE(kt + 1);
        __syncthreads();
    }
    if (grp == 1) pv_tile(o, pf, alpha, resc, lds + vbase + ((unsigned)(nt_all + 2) % 3u) * (unsigned)V_BYTES);
    __syncthreads();
#undef DA_LOAD
#undef DA_WRITE
    const float ltot = lrun + __shfl_xor(lrun, 32), inv = 1.0f / ltot;
    LAS float* X = (LAS float*)lds + rg * 4096;
    if (mp == 1) {
#pragma unroll
        for (int d0 = 0; d0 < 4; ++d0)
#pragma unroll
            for (int r = 0; r < 16; ++r) { const int dv = 32 * d0 + (r & 3) + 8 * (r >> 2) + 4 * hi; X[dv * 32 + r32] = o[d0][r] * inv; }
    }
    __syncthreads();
    if (mp == 0) {
        float ss = 0.f;
#pragma unroll
        for (int d0 = 0; d0 < 4; ++d0)
#pragma unroll
            for (int r = 0; r < 16; ++r) { const int dv = 32 * d0 + (r & 3) + 8 * (r >> 2) + 4 * hi; const float v = o[d0][r] * inv - lam * X[dv * 32 + r32]; o[d0][r] = v; ss += v * v; }
        ss += __shfl_xor(ss, 32);
        const float rstd = 0.8f / sqrtf(ss * (1.0f / 128.0f) + EPS);
        bf16_t* op = CAT + (tok0 + q0 + r32) * D + 512 + hh * 128;
#pragma unroll
        for (int d0 = 0; d0 < 4; ++d0)
#pragma unroll
            for (int r4 = 0; r4 < 4; ++r4) { const int dv = 32 * d0 + 8 * r4 + 4 * hi; const f32x4 gg = *(const f32x4*)(subln_g + dv);
                u32x2 w; w.x = cvt_pk_bf16(o[d0][4 * r4 + 0] * rstd * gg[0], o[d0][4 * r4 + 1] * rstd * gg[1]); w.y = cvt_pk_bf16(o[d0][4 * r4 + 2] * rstd * gg[2], o[d0][4 * r4 + 3] * rstd * gg[3]);
                *(u32x2*)(op + dv) = w; }
    }
    __syncthreads();
}
}

typedef const __attribute__((address_space(4))) Args* KArgsP;
__device__ __forceinline__ KArgsP kargs() { KArgsP p = (KArgsP)__builtin_amdgcn_kernarg_segment_ptr(); asm volatile("" : "+s"(p)); return p; }
#define PH_PTRS() KArgsP ap = kargs(); unsigned char* ws = ap->ws; (void)ws; int tid = wave * 64 + lane_id(); asm volatile("" : "+v"(tid)); const int lane = tid & 63; (void)lane; \
    float* cs = (float*)(ws + WS_CS); float* ssp = (float*)(ws + WS_SSP); float* rstd2 = (float*)(ws + WS_RSTD2); \
    int* tokslot = (int*)(ws + WS_TOKSLOT); int* ltok = (int*)(ws + WS_LTOK); float* lgate = (float*)(ws + WS_LGATE); \
    bf16_t* Win_t = (bf16_t*)(ws + WS_WIN); bf16_t* Wout_t = (bf16_t*)(ws + WS_WOUT); bf16_t* Wcq_t = (bf16_t*)(ws + WS_WCQ); bf16_t* Wckv_t = (bf16_t*)(ws + WS_WCKV); \
    bf16_t* Wco_t = (bf16_t*)(ws + WS_WCO); bf16_t* Wgu_t = (bf16_t*)(ws + WS_WGU); bf16_t* Wdn_t = (bf16_t*)(ws + WS_WDN); \
    bf16_t* H0 = (bf16_t*)(ws + WS_H0); bf16_t* MEMN = (bf16_t*)(ws + WS_MEMN); bf16_t* KC = (bf16_t*)(ws + WS_KC); bf16_t* VT = (bf16_t*)(ws + WS_VT); \
    bf16_t* U = (bf16_t*)(ws + WS_U); bf16_t* CAT = (bf16_t*)(ws + WS_CAT); float* X1 = (float*)(ws + WS_X1); bf16_t* X1B = (bf16_t*)(ws + WS_X1B); \
    bf16_t* QC = (bf16_t*)(ws + WS_QC); bf16_t* PC = (bf16_t*)(ws + WS_PC); bf16_t* OC = (bf16_t*)(ws + WS_OC); float* X2 = (float*)(ws + WS_X2); bf16_t* X2B = (bf16_t*)(ws + WS_X2B); \
    bf16_t* HID = (bf16_t*)(ws + WS_HID); bf16_t* YR = (bf16_t*)(ws + WS_Y); \
    (void)cs; (void)ssp; (void)rstd2; (void)tokslot; (void)ltok; (void)lgate; (void)Win_t; (void)Wout_t; (void)Wcq_t; (void)Wckv_t; (void)Wco_t; (void)Wgu_t; (void)Wdn_t; (void)H0; (void)MEMN; (void)KC; (void)VT; \
    (void)U; (void)CAT; (void)X1; (void)X1B; (void)QC; (void)PC; (void)OC; (void)X2; (void)X2B; (void)HID; (void)YR

constexpr int NWAVES = 8;
constexpr int N_PHASES = 10;

__global__ void __launch_bounds__(NWAVES * 64, 2) fwd_kernel(Args a) {
    extern __shared__ __attribute__((aligned(16))) unsigned char lds_raw[];
    LAS unsigned char* lds = (LAS unsigned char*)lds_raw;
    const int wave = __builtin_amdgcn_readfirstlane((int)threadIdx.x >> 6);
    const int tid = wave * 64 + lane_id(), lane = tid & 63; (void)lane;
    const int G = gridDim.x, bx = blockIdx.x;
    const int gw = bx * NWAVES + wave, NGW = G * NWAVES;
    unsigned* ctl; { unsigned char* ws0 = a.ws; ctl = (unsigned*)(ws0 + WS_CTL); }
    volatile LAS unsigned* MISC = (volatile LAS unsigned*)(lds + MISC_OFF);
    if (tid < 32) ((LAS unsigned*)(lds + MISC_OFF))[tid] = 0u;
    __syncthreads();
    XcdBarrier bar; bar.bar = ctl + CW_BAR; bar.x = 0; bar.st = nullptr;
    if (MK_N_LAUNCHES == 1) bar = xcd_barrier_post(ctl + CW_BAR, MISC + 8, tid);
    const int lo = a.ph_lo, hi = a.ph_hi;
#define IN(k) (((PMASK >> (k)) & 1) && lo <= (k) && (k) < hi)
#define SEAM(k) do { if (IN(k) && IN((k) + 1)) xcd_barrier(bar, wave * 64 + lane_id()); } while (0)

    if (IN(0)) for (int rep_ = 0; rep_ < REPS(0); ++rep_) { PH_PTRS();
        LAS float* scr = (LAS float*)(lds + wave * 16384);
        p0_transpose_stream<2, true>(ap->w_gu, 1024, 2048, NE, Wgu_t, 1024, 0, (size_t)2048 * 1024, ap->ffn_g, scr, gw, NGW, lane);
        p0_transpose_stream<0, true>(ap->w_down, 1024, 1024, NE, Wdn_t, 1024, 0, (size_t)1024 * 1024, nullptr, scr, gw, NGW, lane);
        p0_transpose_stream<1, false>(ap->w_in, 1024, 2048, 1, Win_t, 1024, 0, 0, nullptr, scr, gw, NGW, lane);
        p0_transpose_stream<0, false>(ap->w_out + (size_t)512 * 1024, 512, 1024, 1, Wout_t, 1024, 512, 0, nullptr, scr, gw, NGW, lane);
        p0_transpose_stream<0, false>(ap->w_cq, 1024, 1024, 1, Wcq_t, 1024, 0, 0, ap->xattn_g, scr, gw, NGW, lane);
        p0_transpose_stream<0, false>(ap->w_ckv, 1024, 2048, 1, Wckv_t, 1024, 0, 0, nullptr, scr, gw, NGW, lane);
        p0_transpose_stream<0, false>(ap->w_co, 1024, 1024, 1, Wco_t, 1024, 0, 0, nullptr, scr, gw, NGW, lane);
        constexpr int I_WEFF = 1024, I_XR = T, I_MR = NMEM, I_ROPE = T * 8 / 64;
        constexpr int NITEMS = I_WEFF + I_XR + I_MR + I_ROPE;
        for (int it = gw; it < NITEMS; it += NGW) {
            int r = it;
            if (r < I_WEFF) {
                const int nb = r & 15, cb = r >> 4, n = nb * 64 + lane, kk0 = cb * 8, g = kk0 >> 7;
                float accv[8];
#pragma unroll
                for (int q = 0; q < 8; ++q) accv[q] = 0.f;
#pragma unroll 8
                for (int d = 0; d < 128; ++d) { const float wo = ap->w_out[(size_t)(g * 128 + d) * 1024 + n] * ap->pool_scale[g * 128 + d];
#pragma unroll
                    for (int q = 0; q < 8; ++q) accv[q] += ap->w_pool[(size_t)(kk0 + q) * 128 + d] * wo; }
                u32x4 o4; o4.x = pk2(accv[0], accv[1]); o4.y = pk2(accv[2], accv[3]); o4.z = pk2(accv[4], accv[5]); o4.w = pk2(accv[6], accv[7]);
                *(u32x4*)(Wout_t + (size_t)n * 1024 + kk0) = o4; continue; } r -= I_WEFF;
            if (r < I_XR) { rms_row_to_bf16(ap->x + (size_t)r * D, ap->attn_g, H0 + (size_t)r * D, lane); continue; } r -= I_XR;
            if (r < I_MR) { rms_row_to_bf16(ap->mem + (size_t)r * D, ap->mem_g, MEMN + (size_t)r * D, lane); continue; } r -= I_MR;
            {
                const int idx = r * 64 + lane, t = idx >> 3, i = idx & 7;
                const double inv_freq = exp2(-(double)i * (18.931568569324174 / 8.0));
                const double rev = (double)ap->pos[t] * inv_freq * 0.15915494309189535;
                const float fr = (float)(rev - floor(rev));
                cs[(size_t)idx * 2] = __builtin_amdgcn_cosf(fr); cs[(size_t)idx * 2 + 1] = __builtin_amdgcn_sinf(fr);
            }
        }
    }
    SEAM(0);

    if (IN(1)) for (int rep_ = 0; rep_ < REPS(1); ++rep_) { PH_PTRS();
        { pg8::StaticOrder S; S.init(H0, Win_t, T, INW, D, D, G, bx); pg8::EpiInProj E{U, cs};
          pg8::gemm_phase<pg8::EpiInProj, pg8::StaticOrder, true, false, false>(lds, wave, 2 * D, 2 * D, 2 * D, S, E, KREPS(1)); }
        { pg8::KvOrder S; S.memn = (const char*)MEMN; S.wkv = (const char*)Wckv_t; S.G = G; S.c = (bx + 128) % G; pg8::EpiBf16Sel E{KC, 1024, VT, NMEM};
          pg8::gemm_phase<pg8::EpiBf16Sel, pg8::KvOrder, true, false, false>(lds, wave, 2 * D, 2 * D, 2 * D, S, E, KREPS(1)); }
    }
    SEAM(1);

    if (IN(2)) for (int rep_ = 0; rep_ < REPS(2); ++rep_) { PH_PTRS();
        float d1 = (lane < 64) ? ap->lq1[lane] * ap->lk1[lane] : 0.f, d2 = ap->lq2[lane] * ap->lk2[lane];
        d1 = wave_sum(d1); d2 = wave_sum(d2);
        const float lam = expf(d1) - expf(d2) + 0.2f;
        for (int ra_ = 0; ra_ < REPA; ++ra_)
        for (int un = bx; un < 256; un += G) {
            const int bh = un >> 3, jp = un & 7;
            dattn::unit(lds, wave, U, CAT, ap->subln_g, lam, bh >> 2, bh & 3, jp);
            dattn::unit(lds, wave, U, CAT, ap->subln_g, lam, bh >> 2, bh & 3, 15 - jp);
        }
        for (int rb_ = 0; rb_ < REPB; ++rb_)
        for (int it = gw; it < T / 16; it += NGW) {
            const int b = it >> 7, t0 = (it & 127) * 16, g = lane >> 4, wnd = 2 << g;
            const bf16_t* up = U + ((size_t)b * SEQ + t0) * INW + lane * 8;
            u32x4 rows[32];
#pragma unroll
            for (int i = 0; i < 32; ++i) { if (i >= 16 || t0 > 0) rows[i] = *(const u32x4*)(up + (ptrdiff_t)(i - 16) * INW); else rows[i] = (u32x4){0u, 0u, 0u, 0u}; }
#define PL_ADD(a, r, sgn) do { a[0] += sgn __builtin_bit_cast(float, (r).x << 16); a[1] += sgn __builtin_bit_cast(float, (r).x & 0xffff0000u); a[2] += sgn __builtin_bit_cast(float, (r).y << 16); a[3] += sgn __builtin_bit_cast(float, (r).y & 0xffff0000u); \
            a[4] += sgn __builtin_bit_cast(float, (r).z << 16); a[5] += sgn __builtin_bit_cast(float, (r).z & 0xffff0000u); a[6] += sgn __builtin_bit_cast(float, (r).w << 16); a[7] += sgn __builtin_bit_cast(float, (r).w & 0xffff0000u); } while (0)
            float sacc[8];
#pragma unroll
            for (int q = 0; q < 8; ++q) sacc[q] = 0.f;
#pragma unroll
            for (int jj = 1; jj < 16; ++jj) { const u32x4 r = rows[16 - jj] & ((jj < wnd) ? 0xffffffffu : 0u); PL_ADD(sacc, r, +); }
            const unsigned mk0 = (g == 0) ? 0xffffffffu : 0u, mk1 = (g == 1) ? 0xffffffffu : 0u, mk2 = (g == 2) ? 0xffffffffu : 0u, mk3 = (g == 3) ? 0xffffffffu : 0u;
            bf16_t* op = CAT + ((size_t)b * SEQ + t0) * D + lane * 8;
#pragma unroll
            for (int tt = 0; tt < 16; ++tt) {
                PL_ADD(sacc, rows[16 + tt], +);
                float cur[8];
#pragma unroll
                for (int q = 0; q < 8; ++q) cur[q] = 0.f;
                PL_ADD(cur, rows[16 + tt], +);
                const int t = t0 + tt; const float ic = 1.0f / (float)((t + 1 < wnd) ? t + 1 : wnd);
                u32x4 o4; o4.x = pk2(sacc[0] * ic - cur[0], sacc[1] * ic - cur[1]); o4.y = pk2(sacc[2] * ic - cur[2], sacc[3] * ic - cur[3]);
                o4.z = pk2(sacc[4] * ic - cur[4], sacc[5] * ic - cur[5]); o4.w = pk2(sacc[6] * ic - cur[6], sacc[7] * ic - cur[7]);
                *(u32x4*)(op + (size_t)tt * D) = o4;
                const u32x4 lv = (rows[16 + tt - 1] & mk0) | (rows[16 + tt - 3] & mk1) | (rows[16 + tt - 7] & mk2) | (rows[16 + tt - 15] & mk3);
                PL_ADD(sacc, lv, -);
            }
#undef PL_ADD
        }
    }
    SEAM(2);

    if (IN(3)) for (int rep_ = 0; rep_ < REPS(3); ++rep_) { PH_PTRS();
        pg8::StaticOrder S; S.init(CAT, Wout_t, T, D, D, D, G, bx); pg8::EpiRes<false> E{ap->x, X1, X1B, ssp};
        pg8::gemm_phase<pg8::EpiRes<false>, pg8::StaticOrder, true, false, false>(lds, wave, 2 * D, 2 * D, 2 * D, S, E, KREPS(3));
    }
    SEAM(3);

    if (IN(4)) for (int rep_ = 0; rep_ < REPS(4); ++rep_) { PH_PTRS();
        LAS float* rs = (LAS float*)(lds + XTAB_OFF);
        for (int un = bx; un < 256; un += G) {
            const int pm = un >> 2, h = un & 3, b = pm >> 3;
            if (tid < 256) { const int row = pm * 256 + tid; float s = 0.f;
#pragma unroll
                for (int p = 0; p < 16; ++p) s += ssp[(size_t)p * T + row];
                rs[tid] = 1.0f / sqrtf(s * (1.0f / D) + EPS); }
            __syncthreads();
            { pg8::SingleUnit S; S.u = pg8::Unit{pm, h, 0, 0, 256, 0, (const char*)(X1B + (size_t)pm * 256 * D), (const char*)(Wcq_t + (size_t)h * 256 * D)};
              pg8::EpiBf16 E{QC, D, rs, QSCALE_X};
              pg8::gemm_phase<pg8::EpiBf16, pg8::SingleUnit, false, false, false>(lds, wave, 2 * D, 2 * D, 2 * D, S, E, KREPS(4)); }
            wg_global_sync(tid);
            { pg8::SingleUnit S; S.u = pg8::Unit{pm, h, 0, 0, 256, 0, (const char*)(QC + (size_t)pm * 256 * D + h * 256), (const char*)(KC + (size_t)b * 256 * D + h * 256)};
              pg8::EpiSoftmax E{PC, D};
              pg8::gemm_phase<pg8::EpiSoftmax, pg8::SingleUnit, false, false, false>(lds, wave, 2 * 256, 2 * D, 2 * D, S, E, KREPS(4)); }
            wg_global_sync(tid);
            { pg8::SingleUnit S; S.u = pg8::Unit{pm, h, 0, 0, 256, 0, (const char*)(PC + (size_t)pm * 256 * D + h * 256), (const char*)(VT + (size_t)h * 256 * NMEM + b * 256)};
              pg8::EpiBf16 E{OC, D, nullptr, 1.0f};
              pg8::gemm_phase<pg8::EpiBf16, pg8::SingleUnit, false, false, false>(lds, wave, 2 * 256, 2 * D, 2 * NMEM, S, E, KREPS(4)); }
            __syncthreads();
        }
    }
    SEAM(4);

    if (IN(5)) for (int rep_ = 0; rep_ < REPS(5); ++rep_) { PH_PTRS();
        pg8::StaticOrder S; S.init(OC, Wco_t, T, D, D, D, G, bx); pg8::EpiRes<true> E{X1, X2, X2B, nullptr};
        pg8::gemm_phase<pg8::EpiRes<true>, pg8::StaticOrder, true, false, false>(lds, wave, 2 * D, 2 * D, 2 * D, S, E, KREPS(5));
    }
    SEAM(5);

    if (IN(6)) for (int rep_ = 0; rep_ < REPS(6); ++rep_) { PH_PTRS();
        LAS float* WR = (LAS float*)lds;
        LAS int* lcnt = (LAS int*)(lds + RT_OFF);
        LAS int* sel = (LAS int*)(lds + RT_OFF + 512);
        LAS float* selg = (LAS float*)(lds + RT_OFF + 512 + 1024);
        const int wave_ = __builtin_amdgcn_readfirstlane(tid >> 6);
        for (int tb = bx; tb < T / 64; tb += G) {
            for (int i = tid; i < 8192; i += NWAVES * 64) { const f32x4 w = ((const f32x4*)ap->w_router)[i]; *(LAS f32x4*)(WR + 4 * i) = w * ap->ffn_g[i >> 3]; }
            if (tid < 32) lcnt[tid] = 0;
            __syncthreads();
            const int tile = wave_ >> 2, kq = wave_ & 3, r32 = lane & 31, h = lane >> 5;
            const float* xp = X2 + (size_t)(tb * 64 + tile * 32 + r32) * D + kq * 256 + 32 * h;
            f32x16 accr;
#pragma unroll
            for (int r = 0; r < 16; ++r) accr[r] = 0.f;
            float ss = 0.f;
#pragma unroll 1
            for (int S = 0; S < 4; ++S) {
                f32x4 xv[8];
#pragma unroll
                for (int q = 0; q < 8; ++q) xv[q] = *(const f32x4*)(xp + 64 * S + 4 * q);
                const LAS float* wp = WR + (kq * 256 + 64 * S + 32 * h) * 32 + r32;
#pragma unroll
                for (int s = 0; s < 32; ++s) { const float av = xv[s >> 2][s & 3]; accr = __builtin_amdgcn_mfma_f32_32x32x2f32(av, wp[s * 32], accr, 0, 0, 0); ss += av * av; }
            }
            ss += __shfl_xor(ss, 32);
            __syncthreads();
            LAS float* PT = (LAS float*)lds + wave_ * (32 * 33);
            LAS float* PSS = (LAS float*)lds + 8 * 32 * 33;
#pragma unroll
            for (int r = 0; r < 16; ++r) PT[((r & 3) + 8 * (r >> 2) + 4 * h) * 33 + r32] = accr[r];
            if (h == 0) PSS[wave_ * 32 + r32] = ss;
            __syncthreads();
            if (tid < 64) {
                const int tl = tid & 31, tok = tb * 64 + tid; const LAS float* p0 = (LAS float*)lds + ((tid >> 5) * 4) * (32 * 33) + tl * 33; const LAS float* q0 = PSS + (tid >> 5) * 128 + tl;
                const float sq = (q0[0] + q0[32]) + (q0[64] + q0[96]);
                const float rstd = 1.0f / sqrtf(sq * (1.0f / D) + EPS);
                rstd2[tok] = rstd;
                float b0 = -INFINITY, b1 = -INFINITY, b2 = -INFINITY, b3 = -INFINITY; int i0 = 0, i1 = 0, i2 = 0, i3 = 0;
                for (int e = 0; e < 32; ++e) {
                    const float lg = ((p0[e] + p0[32 * 33 + e]) + (p0[2 * 32 * 33 + e] + p0[3 * 32 * 33 + e])) * rstd + ap->b_router[e];
                    if (lg > b3) { b3 = lg; i3 = e;
                        if (b3 > b2) { const float tf = b2; b2 = b3; b3 = tf; const int ti = i2; i2 = i3; i3 = ti; }
                        if (b2 > b1) { const float tf = b1; b1 = b2; b2 = tf; const int ti = i1; i1 = i2; i2 = ti; }
                        if (b1 > b0) { const float tf = b0; b0 = b1; b1 = tf; const int ti = i0; i0 = i1; i1 = ti; } }
                }
                const float e1 = expf(b1 - b0), e2 = expf(b2 - b0), e3 = expf(b3 - b0), isum = 1.0f / (1.0f + e1 + e2 + e3);
                int lr;
                lr = atomicAdd((int*)&lcnt[i0], 1); sel[tid * 4 + 0] = (i0 << 16) | lr; selg[tid * 4 + 0] = isum;
                lr = atomicAdd((int*)&lcnt[i1], 1); sel[tid * 4 + 1] = (i1 << 16) | lr; selg[tid * 4 + 1] = e1 * isum;
                lr = atomicAdd((int*)&lcnt[i2], 1); sel[tid * 4 + 2] = (i2 << 16) | lr; selg[tid * 4 + 2] = e2 * isum;
                lr = atomicAdd((int*)&lcnt[i3], 1); sel[tid * 4 + 3] = (i3 << 16) | lr; selg[tid * 4 + 3] = e3 * isum;
            }
            __syncthreads();
            if (tid < 32) { const int c = lcnt[tid]; lcnt[32 + tid] = (c > 0) ? (int)atomicAdd(ctl + CW_CNT + tid, (unsigned)c) : 0; }
            __syncthreads();
            if (tid < 256) { const int tl = tid >> 2, tok = tb * 64 + tl, sv = sel[tid], ee = sv >> 16, pos = lcnt[32 + ee] + (sv & 0xffff);
                ltok[ee * CAP + pos] = tok; lgate[ee * CAP + pos] = selg[tid]; tokslot[tok * 4 + (tid & 3)] = (ee << 16) | pos; }
            __syncthreads();
        }
    }
    SEAM(6);

    LAS int* ecnt = (LAS int*)(lds + ECNT_OFF);
    LAS int* etp = (LAS int*)(lds + ECNT_OFF + 128);
    LAS int* xe = (LAS int*)(lds + XE_OFF);
    LAS int* tokt = (LAS int*)(lds + TOKT_OFF);
    if (IN(7) || IN(8) || IN(9)) {
        __syncthreads();
        const int t_ = wave * 64 + lane_id();
        if (t_ == 0) { int acc = 0; for (int e = 0; e < NE; ++e) { const int c = (int)__hip_atomic_load(ctl + CW_CNT + e, __ATOMIC_RELAXED, __HIP_MEMORY_SCOPE_AGENT); ecnt[e] = c; etp[e] = acc; acc += (c + 255) >> 8; } etp[NE] = acc; }
        __syncthreads();
        if (t_ < NE) { const int e = t_, n = etp[e + 1] - etp[e]; int rank = 0;
            for (int o = 0; o < NE; ++o) { const int no = etp[o + 1] - etp[o]; rank += (no > n || (no == n && o < e)) ? 1 : 0; }
            const int rnd = rank >> 3, p = rank & 7, x = (rnd & 1) ? 7 - p : p; xe[x * 4 + rnd] = e; }
        __syncthreads();
    }

    if (IN(7)) for (int rep_ = 0; rep_ < REPS(7); ++rep_) { PH_PTRS();
        pg8::MoeOrder S; S.ecnt = ecnt; S.etp = etp; S.xe = xe; S.tokt = tokt; S.x = bx & 7; S.cl = bx >> 3; S.nloc = G >> 3; S.npn = 8;
        S.Abase = (const char*)X2B; S.Bbase = (const char*)Wgu_t; S.b_expert = (size_t)2048 * 1024; S.rowbytes = D; S.b_rowbytes = D; S.gather = true;
        { pg8::Unit u;
          for (int i = 0; i < MAXU && S.next(i, u); ++i) if (tid < 256) tokt[i * 256 + tid] = (tid < u.nvalid) ? ltok[u.e * CAP + u.r * 256 + tid] : 0; }
        __syncthreads();
        pg8::EpiSwiGLU E{(unsigned char*)HID, ap->b_gu, rstd2, tokt};
        pg8::gemm_phase<pg8::EpiSwiGLU, pg8::MoeOrder, true, true, true>(lds, wave, D, D, D, S, E, KREPS(7));
    }
    SEAM(7);

    if (IN(8)) for (int rep_ = 0; rep_ < REPS(8); ++rep_) { PH_PTRS();
        pg8::MoeOrder S; S.ecnt = ecnt; S.etp = etp; S.xe = xe; S.tokt = tokt; S.x = bx & 7; S.cl = bx >> 3; S.nloc = G >> 3; S.npn = 4;
        S.Abase = (const char*)HID; S.Bbase = (const char*)Wdn_t; S.b_expert = (size_t)1024 * 1024; S.rowbytes = D; S.b_rowbytes = D; S.gather = true;
        { pg8::Unit u;
          for (int i = 0; i < MAXU && S.next(i, u); ++i) if (tid < 256) tokt[i * 256 + tid] = u.pm * 256 + tid; }
        __syncthreads();
        pg8::EpiDown E{YR, ap->b_down, lgate};
        pg8::gemm_phase<pg8::EpiDown, pg8::MoeOrder, true, true, true>(lds, wave, D, D, D, S, E, KREPS(8));
    }
    SEAM(8);

    if (IN(9)) for (int rep_ = 0; rep_ < REPS(9); ++rep_) { PH_PTRS();
        for (int tok = gw; tok < T; tok += NGW) {
            int rowk[4];
#pragma unroll
            for (int k = 0; k < 4; ++k) { const int sv = tokslot[tok * 4 + k], ee = sv >> 16; rowk[k] = etp[ee] * 256 + (sv & 0xffff); }
            const f32x4* xr = (const f32x4*)(X2 + (size_t)tok * D) + lane;
            f32x4 v[4]; float s = 0.f;
#pragma unroll
            for (int j = 0; j < 4; ++j) { v[j] = xr[64 * j];
#pragma unroll
                for (int k = 0; k < 4; ++k) { const u32x2 y = *((const u32x2*)(YR + (size_t)rowk[k] * 1024) + lane + 64 * j);
                    v[j][0] += __builtin_bit_cast(float, y.x << 16); v[j][1] += __builtin_bit_cast(float, y.x & 0xffff0000u);
                    v[j][2] += __builtin_bit_cast(float, y.y << 16); v[j][3] += __builtin_bit_cast(float, y.y & 0xffff0000u); }
                s += (v[j][0] * v[j][0] + v[j][1] * v[j][1]) + (v[j][2] * v[j][2] + v[j][3] * v[j][3]); }
            const float rstd = 1.0f / sqrtf(wave_sum(s) * (1.0f / D) + EPS);
            f32x4* op = (f32x4*)(ap->out + (size_t)tok * D) + lane; const f32x4* gr = (const f32x4*)ap->final_g + lane;
#pragma unroll
            for (int j = 0; j < 4; ++j) op[64 * j] = v[j] * rstd * gr[64 * j];
        }
    }
#undef IN
#undef SEAM
}

extern "C" void kernel_launch(void* const* d_in, const int* in_sizes, int n_in, void* d_out, int out_size, void* d_ws, size_t ws_size, hipStream_t stream) {
    static int grid = 0;
    if (grid == 0) {
        if (n_in != 26 || in_sizes[0] != T * D || out_size != T * D || ws_size < WS_END) { fprintf(stderr, "kernel_launch: unexpected shapes (n_in %d, in0 %d, out %d, ws %zu); nothing launched\n", n_in, n_in > 0 ? in_sizes[0] : -1, out_size, ws_size); grid = -1; return; }
        int dev = 0, cus = 0, per_cu = 0;
        if (hipGetDevice(&dev) != hipSuccess || hipDeviceGetAttribute(&cus, hipDeviceAttributeMultiprocessorCount, dev) != hipSuccess) { grid = -1; return; }
        if (hipFuncSetAttribute((const void*)fwd_kernel, hipFuncAttributeMaxDynamicSharedMemorySize, LDS_BYTES) != hipSuccess) { fprintf(stderr, "kernel_launch: hipFuncSetAttribute failed\n"); grid = -1; return; }
        if (hipOccupancyMaxActiveBlocksPerMultiprocessor(&per_cu, (const void*)fwd_kernel, NWAVES * 64, LDS_BYTES) != hipSuccess || per_cu < 1) { fprintf(stderr, "kernel_launch: occupancy query says %d\n", per_cu); per_cu = 1; }
        (void)hipGetLastError();
        grid = cus;
    }
    if (grid < 0) return;
    (void)hipMemsetAsync((char*)d_ws + WS_CTL, 0, CTL_BYTES, stream);
    Args a{};
    a.x = (const float*)d_in[0]; a.pos = (const int*)d_in[1]; a.mem = (const float*)d_in[2]; a.attn_g = (const float*)d_in[3]; a.w_in = (const float*)d_in[4];
    a.w_pool = (const float*)d_in[5]; a.pool_scale = (const float*)d_in[6]; a.lq1 = (const float*)d_in[7]; a.lk1 = (const float*)d_in[8]; a.lq2 = (const float*)d_in[9];
    a.lk2 = (const float*)d_in[10]; a.subln_g = (const float*)d_in[11]; a.w_out = (const float*)d_in[12]; a.xattn_g = (const float*)d_in[13]; a.mem_g = (const float*)d_in[14];
    a.w_cq = (const float*)d_in[15]; a.w_ckv = (const float*)d_in[16]; a.w_co = (const float*)d_in[17]; a.ffn_g = (const float*)d_in[18]; a.w_router = (const float*)d_in[19];
    a.b_router = (const float*)d_in[20]; a.w_gu = (const float*)d_in[21]; a.b_gu = (const float*)d_in[22]; a.w_down = (const float*)d_in[23]; a.b_down = (const float*)d_in[24];
    a.final_g = (const float*)d_in[25]; a.out = (float*)d_out; a.ws = (unsigned char*)d_ws;
    if (MK_N_LAUNCHES == 1) {
        a.ph_lo = 0; a.ph_hi = N_PHASES;
        void* args[] = {&a};
        hipError_t e = hipLaunchCooperativeKernel((const void*)fwd_kernel, dim3(grid), dim3(NWAVES * 64), args, LDS_BYTES, stream);
        if (e != hipSuccess) fprintf(stderr, "kernel_launch: cooperative launch failed: %s (grid %d)\n", hipGetErrorString(e), grid);
    } else {
        for (int p = 0; p < N_PHASES; ++p) { a.ph_lo = p; a.ph_hi = p + 1; hipLaunchKernelGGL(fwd_kernel, dim3(grid), dim3(NWAVES * 64), LDS_BYTES, stream, a); }
    }
}
```

```cpp
#include <hip/hip_runtime.h>
#include <cstdio>
#include <cstdint>

#ifndef MK_N_LAUNCHES
#define MK_N_LAUNCHES 1
#endif

#ifndef REPMASK
#define REPMASK 0
#endif
#define REPS(k) (((REPMASK >> (k)) & 1) ? 2 : 1)
#ifndef TP_LO
#define TP_LO -1
#endif
#ifndef TP_HI
#define TP_HI -1
#endif
#ifndef REPM
#define REPM 1
#endif
#ifndef REPC
#define REPC 1
#endif
#ifndef REPA
#define REPA 1
#endif
#ifndef REPB
#define REPB 1
#endif
#ifndef KREPMASK
#define KREPMASK 0
#endif
#define KREPS(k) (((KREPMASK >> (k)) & 1) ? 2 : 1)
#ifndef EPIREP_SW
#define EPIREP_SW 1
#endif
#ifndef EPIREP_DN
#define EPIREP_DN 1
#endif
#ifndef PMASK
#define PMASK 0x3ff
#endif
#define LAS __attribute__((address_space(3)))
#define GAS __attribute__((address_space(1)))

typedef unsigned short bf16_t;
typedef short bf16x8 __attribute__((ext_vector_type(8)));
typedef short s16x4 __attribute__((ext_vector_type(4)));
typedef float f32x4 __attribute__((ext_vector_type(4)));
typedef float f32x2 __attribute__((ext_vector_type(2)));
typedef float f32x16 __attribute__((ext_vector_type(16)));
typedef unsigned u32x4 __attribute__((ext_vector_type(4)));
typedef unsigned u32x2 __attribute__((ext_vector_type(2)));
typedef int i32x4 __attribute__((ext_vector_type(4)));
typedef int i32x8 __attribute__((ext_vector_type(8)));

constexpr int NB = 8, SEQ = 2048, T = NB * SEQ, D = 1024, INW = 2048, MEM = 256, NMEM = NB * MEM;
constexpr int NE = 32, TOPK = 4, CAP = 16384, MAXRT = 288;
constexpr float EPS = 1e-5f;
constexpr float LOG2E = 1.4426950408889634f;
constexpr float QSCALE_D = 0.125f * LOG2E;
constexpr float QSCALE_X = 0.0625f * LOG2E;

constexpr size_t MiB = 1u << 20;
constexpr size_t WS_CTL = 0, CTL_BYTES = 128 * 1024;
constexpr size_t WS_CS = 1 * MiB;
constexpr size_t WS_SSP = 2 * MiB;
constexpr size_t WS_RSTD2 = 3 * MiB;
constexpr size_t WS_TOKSLOT = 3 * MiB + 256 * 1024;
constexpr size_t WS_LTOK = 4 * MiB;
constexpr size_t WS_LGATE = 6 * MiB;
constexpr size_t WS_WIN = 8 * MiB;
constexpr size_t WS_WOUT = 12 * MiB;
constexpr size_t WS_WCQ = 14 * MiB;
constexpr size_t WS_WCKV = 16 * MiB;
constexpr size_t WS_WCO = 20 * MiB;
constexpr size_t WS_WRH = 22 * MiB;
constexpr size_t WS_WGU = 24 * MiB;
constexpr size_t WS_WDN = 152 * MiB;
constexpr size_t WS_H0 = 216 * MiB;
constexpr size_t WS_MEMN = 248 * MiB;
constexpr size_t WS_KC = 252 * MiB;
constexpr size_t WS_VT = 256 * MiB;
constexpr size_t WS_U = 260 * MiB;
constexpr size_t WS_CAT = 324 * MiB;
constexpr size_t WS_X1 = 356 * MiB;
constexpr size_t WS_X1B = 420 * MiB;
constexpr size_t WS_QC = 452 * MiB;
constexpr size_t WS_PC = 484 * MiB;
constexpr size_t WS_OC = 516 * MiB;
constexpr size_t WS_X2 = 548 * MiB;
constexpr size_t WS_X2B = 612 * MiB;
constexpr size_t WS_HID = 644 * MiB;
constexpr size_t WS_Y = 788 * MiB;
constexpr size_t WS_END = 932 * MiB;
constexpr int CW_CNT = 64;
constexpr int CW_BAR = 4096;
constexpr int CW_XCC = 512;
constexpr int CW_FLAG = 8192, FLAG_STRIDE = 64;
static_assert((size_t)(CW_FLAG + MAXRT * FLAG_STRIDE) * 4 <= CTL_BYTES, "control words");

constexpr int RING_BYTES = 131072;
constexpr int XTAB_OFF = RING_BYTES;
constexpr int ECNT_OFF = RING_BYTES + 1024;
constexpr int RT_OFF = RING_BYTES + 1536;
constexpr int MISC_OFF = RING_BYTES + 4096;
static_assert(RT_OFF + 2560 <= MISC_OFF, "LDS map");
constexpr int XE_OFF = MISC_OFF + 128;
constexpr int TOKT_OFF = MISC_OFF + 512;
constexpr int MAXU = 24;
constexpr int LDS_BYTES = 163840;
static_assert(TOKT_OFF + MAXU * 1024 <= LDS_BYTES, "LDS map");

#define LDS_WAIT() asm volatile("s_waitcnt lgkmcnt(0)" ::: "memory")
#define VM_WAIT() asm volatile("s_waitcnt vmcnt(0)" ::: "memory")
__device__ __forceinline__ unsigned f2bf(float f) { unsigned u = __builtin_bit_cast(unsigned, f); return (u + 0x7fffu + ((u >> 16) & 1u)) >> 16; }
__device__ __forceinline__ unsigned pk2(float lo, float hi) { return f2bf(lo) | (f2bf(hi) << 16); }
__device__ __forceinline__ float bf2f(unsigned short v) { return __builtin_bit_cast(float, (unsigned)v << 16); }
__device__ __forceinline__ unsigned cvt_pk_bf16(float lo, float hi) { unsigned r; asm volatile("v_cvt_pk_bf16_f32 %0, %1, %2" : "=v"(r) : "v"(lo), "v"(hi)); return r; }
__device__ __forceinline__ unsigned pk4_fp8(float a, float b, float c, float d) { int w = __builtin_bit_cast(int, a); w = __builtin_amdgcn_cvt_pk_fp8_f32(a, b, w, false);      w = __builtin_amdgcn_cvt_pk_fp8_f32(c, d, w, true); return (unsigned)w; }
__device__ __forceinline__ int lane_id() { int l; asm volatile("v_mbcnt_lo_u32_b32 %0, -1, 0\n\tv_mbcnt_hi_u32_b32 %0, -1, %0" : "=v"(l)); return l; }
__device__ __forceinline__ float wave_sum(float v) {
#pragma unroll
    for (int o = 1; o < 64; o <<= 1) v += __shfl_xor(v, o);
    return v;
}

#define XB_TMO      128
#define XB_XCNT(j)  (256  + 64 * (j))
#define XB_XSUB(j)  (1280 + 64 * (j))
#define XB_XGEN(j)  (2304 + 64 * (j))
#define XB_TOP      3328
#define XB_TOPGEN   3392
#define XCD_BAR_WORDS 3456
#define XB_SPIN_CAP (1u << 18)
__device__ __forceinline__ unsigned xb_ld(unsigned* p)              { return __hip_atomic_load(p, __ATOMIC_RELAXED, __HIP_MEMORY_SCOPE_AGENT); }
__device__ __forceinline__ unsigned xb_add(unsigned* p, unsigned v) { return __hip_atomic_fetch_add(p, v, __ATOMIC_RELAXED, __HIP_MEMORY_SCOPE_AGENT); }
__device__ __forceinline__ unsigned xb_xcc_id() { return (unsigned)__builtin_amdgcn_s_getreg((3 << 11) | 20) & 0xFu; }
#define XB_SPIN(cond, bar) do { unsigned _sp = 0; while (cond) { __builtin_amdgcn_s_sleep(1); \
    if ((++_sp & 255u) == 0u) { if (xb_ld(&(bar)[XB_TMO])) break; if (_sp > XB_SPIN_CAP) { atomicAdd(&(bar)[XB_TMO], 1u); break; } } } } while (0)
struct XcdBarrier { unsigned* bar; unsigned x; volatile LAS unsigned* st; };
__device__ __forceinline__ XcdBarrier xcd_barrier_post(unsigned* bar, volatile LAS unsigned* st, int tid) {
    XcdBarrier b; b.bar = bar; b.x = xb_xcc_id(); b.st = st;
    if (tid == 0) (void)xb_add(&bar[XB_XCNT(b.x)], 1u);
    return b;
}
__device__ __forceinline__ void xcd_barrier_complete(unsigned* bar, unsigned x, unsigned& nloc, unsigned& nx) {
    const unsigned G = gridDim.x * gridDim.y * gridDim.z;
    unsigned sum, cnt, mine, sp = 0u;
    for (;;) {
        sum = 0u; cnt = 0u; mine = 0u;
#pragma unroll
        for (unsigned j = 0; j < 16; ++j) { const unsigned c = xb_ld(&bar[XB_XCNT(j)]); sum += c; cnt += (c > 0u) ? 1u : 0u; mine = (j == x) ? c : mine; }
        if (sum == G) break;
        __builtin_amdgcn_s_sleep(1);
        if ((++sp & 255u) == 0u) { if (xb_ld(&bar[XB_TMO])) break; if (sp > XB_SPIN_CAP) { atomicAdd(&bar[XB_TMO], 1u); break; } }
    }
    nloc = mine > 0u ? mine : 1u; nx = cnt > 0u ? cnt : 1u;
}
__device__ __forceinline__ void xcd_barrier(const XcdBarrier& b, int tid) {
    asm volatile("s_waitcnt vmcnt(0)" ::: "memory");
    __syncthreads();
    if (tid == 0) {
        unsigned* bar = b.bar;
        __builtin_amdgcn_s_waitcnt(0);
        unsigned nloc = b.st[0], nx = b.st[1];
        if (nloc == 0u) { xcd_barrier_complete(bar, b.x, nloc, nx); b.st[0] = nloc; b.st[1] = nx; }
        const unsigned old = xb_add(&bar[XB_XSUB(b.x)], 1u);
        const unsigned gen = old / nloc;
        if (old + 1u == (gen + 1u) * nloc) {
            __builtin_amdgcn_fence(__ATOMIC_RELEASE, "agent");
            asm volatile("s_waitcnt vmcnt(0)" ::: "memory");
            const unsigned og = xb_add(&bar[XB_TOP], 1u);
            const unsigned tg = og / nx;
            if (og + 1u == (tg + 1u) * nx) xb_add(&bar[XB_TOPGEN], 1u);
            else XB_SPIN(xb_ld(&bar[XB_TOPGEN]) == tg, bar);
            __builtin_amdgcn_fence(__ATOMIC_ACQUIRE, "agent");
            xb_add(&bar[XB_XGEN(b.x)], 1u);
            asm volatile("s_waitcnt vmcnt(0)" ::: "memory");
        } else {
            XB_SPIN(xb_ld(&bar[XB_XGEN(b.x)]) == gen, bar);
            __builtin_amdgcn_fence(__ATOMIC_ACQUIRE, "agent");
            asm volatile("s_waitcnt vmcnt(0)" ::: "memory");
        }
    }
    __syncthreads();
}
__device__ __forceinline__ void hid_wait(unsigned* flags, int pm) {
    unsigned* f = flags + (size_t)pm * FLAG_STRIDE; unsigned sp = 0u;
    while (xb_ld(f) < 8u) { __builtin_amdgcn_s_sleep(1); if (++sp > XB_SPIN_CAP) break; }
}
__device__ __forceinline__ void wg_global_sync(int tid) {
    asm volatile("s_waitcnt vmcnt(0)" ::: "memory");
    __syncthreads();
    if (tid == 0) { __builtin_amdgcn_fence(__ATOMIC_ACQUIRE, "agent"); asm volatile("s_waitcnt vmcnt(0)" ::: "memory"); }
    __syncthreads();
}

namespace pg8 {
constexpr int BM = 256, BK = 64, HALF = 128, HTB = HALF * BK * 2, STAGE_BYTES = 8 * HTB, NXCD = 8, WGM = 8;
__host__ __device__ __forceinline__ int lds_byte(int r, int c) { const int st = (r >> 4) * 2 + (c >> 5), rr = r & 15, cc = c & 31, ob = rr * 64 + cc * 2; return st * 1024 + (ob ^ (((ob >> 9) & 1) << 5)); }
__host__ __device__ __forceinline__ void stage_rc(int b, int& R, int& C) { const int st = b / 1024, sb = b % 1024, swz = sb ^ (((sb >> 9) & 1) << 5); R = (st >> 1) * 16 + swz / 64; C = (st & 1) * 32 + (swz % 64) / 2; }
__host__ __device__ __forceinline__ int perm32(int rho) { const int n = rho >> 4, i = rho & 15; return 8 * (i >> 2) + 4 * n + (i & 3); }

struct Unit { int pm, pn, e, r, nvalid, ui; const char* pa; const char* pb; };

struct StaticOrder {
    int nM, nN, nwg, G, c; const char* A; const char* Bt; size_t atile, btile, bbatch = 0;
    __device__ void init(const void* A_, const void* Bt_, int M, int N, int lda, int ldb, int G_, int c_) { nM = M / BM; nN = N / BM; nwg = nM * nN; G = G_; c = c_; A = (const char*)A_; Bt = (const char*)Bt_; atile = (size_t)BM * lda * 2; btile = (size_t)BM * ldb * 2; }
    __device__ __forceinline__ bool next(int i, Unit& u) const {
        const long L = (long)i * G + c; if (L >= nwg) return false;
        int wgid = (int)L; { const int q = nwg / NXCD, r = nwg % NXCD, xcd = wgid % NXCD, off = wgid / NXCD; wgid = (xcd < r ? xcd * (q + 1) : r * (q + 1) + (xcd - r) * q) + off; }
        const int nig = WGM * nN, gid = wgid / nig, fm = gid * WGM, gsz = (nM - fm) < WGM ? (nM - fm) : WGM;
        u.pm = fm + ((wgid % nig) % gsz); u.pn = (wgid % nig) / gsz; u.e = 0; u.r = 0; u.nvalid = 256; u.ui = i;
        u.pa = A + (size_t)u.pm * atile; u.pb = Bt + (size_t)u.pn * btile + (size_t)(u.pm >> 3) * bbatch; return true;
    }
    __device__ __forceinline__ unsigned row_off(const Unit&, int) const { return 0u; }
};
struct KvOrder {
    const char* memn; const char* wkv; int G, c;
    __device__ __forceinline__ bool next(int i, Unit& u) const {
        const int L = i * G + c; if (L >= 64) return false;
        u.r = 0; u.nvalid = 256; u.ui = i;
        if (L < 32) { u.e = 0; u.pm = L >> 2; u.pn = L & 3; u.pa = memn + (size_t)u.pm * 256 * 2048; u.pb = wkv + (size_t)u.pn * 256 * 2048; }
        else { const int l = L - 32; u.e = 1; u.pm = l >> 3; u.pn = l & 7; u.pa = wkv + (size_t)(1024 + u.pm * 256) * 2048; u.pb = memn + (size_t)u.pn * 256 * 2048; }
        return true;
    }
    __device__ __forceinline__ unsigned row_off(const Unit&, int) const { return 0u; }
};
struct LdsOrder {
    const LAS int* ent; const LAS int* tokt; const char* Abase; const char* Bbase; size_t btile, bbatch; unsigned rowbytes;
    __device__ __forceinline__ bool next(int i, Unit& u) const {
        const int pm = __builtin_amdgcn_readfirstlane(ent[4 * i]); if (pm < 0) return false;
        const int pn = __builtin_amdgcn_readfirstlane(ent[4 * i + 1]);
        u.pm = pm; u.pn = pn; u.e = 0; u.r = 0; u.nvalid = 256; u.ui = i; u.pa = Abase; u.pb = Bbase + (size_t)pn * btile + (size_t)(pm >> 3) * bbatch; return true;
    }
    __device__ __forceinline__ unsigned row_off(const Unit& uu, int r) const { return (unsigned)tokt[uu.ui * 256 + r] * rowbytes; }
};
struct SingleUnit {
    Unit u;
    __device__ __forceinline__ bool next(int i, Unit& o) const { if (i != 0) return false; o = u; return true; }
    __device__ __forceinline__ unsigned row_off(const Unit&, int) const { return 0u; }
};
struct MoeOrder {
    const LAS int* ecnt; const LAS int* etp; const LAS int* xe; const LAS int* tokt;
    int x, cl, nloc, npn; const char* Abase; const char* Bbase; size_t b_expert; unsigned rowbytes, b_rowbytes; bool gather;
    __device__ __forceinline__ bool next(int i, Unit& u) const {
        int j = i * nloc + cl;
        for (int k = 0; k < 4; ++k) { const int e = __builtin_amdgcn_readfirstlane(xe[x * 4 + k]), tp0 = __builtin_amdgcn_readfirstlane(etp[e]), nrt = __builtin_amdgcn_readfirstlane(etp[e + 1]) - tp0, n = nrt * npn;
            if (j < n) { const int pn = __builtin_amdgcn_readfirstlane(j / nrt), r = j - pn * nrt; u.pm = tp0 + r; u.pn = pn; u.e = e; u.r = r; u.nvalid = min(256, __builtin_amdgcn_readfirstlane(ecnt[e]) - r * 256); u.ui = i;
                u.pa = gather ? Abase : Abase + (size_t)u.pm * 256 * rowbytes; u.pb = Bbase + (size_t)e * b_expert + (size_t)pn * 256 * b_rowbytes; return true; }
            j -= n; }
        return false;
    }
    __device__ __forceinline__ unsigned row_off(const Unit& uu, int r) const { return (unsigned)tokt[uu.ui * 256 + r] * rowbytes; }
};

template <class E, class = void> struct epi_aaux { static constexpr int v = 0; };
template <class E> struct epi_aaux<E, decltype((void)E::A_AUX)> { static constexpr int v = E::A_AUX; };
template <class E, class = void> struct epi_rep { static constexpr int v = 1; };
template <class E> struct epi_rep<E, decltype((void)E::REP)> { static constexpr int v = E::REP; };
template <class Epi, class Sched, bool ALIGN_EPI, bool GATHER, bool F8>
__device__ __forceinline__ void gemm_phase(LAS unsigned char* lds, const int wv, const int KB, const int ldaB, const int ldbB, const Sched& S, const Epi& E, const int krep = 1) {
    int tid_ = wv * 64 + lane_id(); asm volatile("" : "+v"(tid_));
    const int tid = tid_, wid = __builtin_amdgcn_readfirstlane(tid >> 6), lane = tid & 63, wr = wid >> 2, wc = wid & 3, fr = lane & 15, fq = lane >> 4;
    const int nt1 = KB / 128, nt = nt1 * krep;
    Unit cur, nxt; int ui = 0;
    if (!S.next(0, cur)) return;
    unsigned voffA[GATHER ? 2 : 1][2], voffB[2];
#pragma unroll
    for (int i = 0; i < 2; ++i) { int R, C; stage_rc(tid * 16 + i * 8192, R, C); const int Rb = Epi::PERM ? ((R & ~31) + perm32(R & 31)) : R;
        if constexpr (GATHER) { voffA[0][i] = S.row_off(cur, R) + (unsigned)C * 2u; voffA[1][i] = S.row_off(cur, R + HALF) + (unsigned)C * 2u; }
        else { voffA[0][i] = (unsigned)(R * ldaB + C * 2); }
        voffB[i] = (unsigned)(Rb * ldbB + C * 2); }
    const size_t kstep = (size_t)(BK * 2);
    const size_t hstepA = GATHER ? (size_t)0 : (size_t)HALF * ldaB, hstepB = (size_t)HALF * ldbB;
    const unsigned ldsw = (unsigned)wid * 1024u;
    const int aoff = lds_byte(wr * 64 + fr, fq * 8), boff = lds_byte(wc * 32 + fr, fq * 8);
#define PG8_SA(b, h) (((b) * 2 + (h)) * HTB)
#define PG8_SB(b, h) ((4 + (b) * 2 + (h)) * HTB)
#define PG8_STAGE(bufoff, gbase, voff, aux) do { _Pragma("unroll") for (int _i = 0; _i < 2; ++_i) \
        __builtin_amdgcn_global_load_lds((const unsigned*)((const char*)(gbase) + (voff)[_i]), (LAS unsigned*)(lds + (bufoff) + ldsw + _i * 8192), 16, 0, aux); } while (0)
#define PG8_STAGEA(bufoff, gbase, h) PG8_STAGE(bufoff, (gbase) + (h) * hstepA, voffA[GATHER ? (h) : 0], epi_aaux<Epi>::v)
#define PG8_STAGEB(bufoff, gbase, h) PG8_STAGE(bufoff, (gbase) + (h) * hstepB, voffB, 0)
#define PG8_RD(off) (*(const LAS i32x4*)(lds + (off)))
#define PG8_CAT8(x0, x1) __builtin_shufflevector(x0, x1, 0, 1, 2, 3, 4, 5, 6, 7)
#define PG8_LDA(dst, b, h) do { if constexpr (F8) { _Pragma("unroll") for (int m = 0; m < 4; ++m) { const i32x4 l_ = PG8_RD(PG8_SA(b, h) + aoff + m * 2048), h_ = PG8_RD(PG8_SA(b, h) + aoff + m * 2048 + 1024); dst##8[m] = PG8_CAT8(l_, h_); } } \
        else { _Pragma("unroll") for (int m = 0; m < 4; ++m) _Pragma("unroll") for (int k = 0; k < 2; ++k) dst[m][k] = *(const LAS bf16x8*)(lds + PG8_SA(b, h) + aoff + m * 2048 + k * 1024); } } while (0)
#define PG8_LDB(dst, b, h) do { if constexpr (F8) { _Pragma("unroll") for (int n = 0; n < 2; ++n) { const i32x4 l_ = PG8_RD(PG8_SB(b, h) + boff + n * 2048), h_ = PG8_RD(PG8_SB(b, h) + boff + n * 2048 + 1024); dst##8[n] = PG8_CAT8(l_, h_); } } \
        else { _Pragma("unroll") for (int n = 0; n < 2; ++n) _Pragma("unroll") for (int k = 0; k < 2; ++k) dst[n][k] = *(const LAS bf16x8*)(lds + PG8_SB(b, h) + boff + n * 2048 + k * 1024); } } while (0)
#define PG8_MMA(ai, bj, At, Bt) do { __builtin_amdgcn_s_setprio(1); \
        if constexpr (F8) { _Pragma("unroll") for (int m = 0; m < 4; ++m) _Pragma("unroll") for (int n = 0; n < 2; ++n) \
            acc[ai][bj][m][n] = __builtin_amdgcn_mfma_scale_f32_16x16x128_f8f6f4(Bt##8[n], At##8[m], acc[ai][bj][m][n], 0, 0, 0, 0x7f7f7f7f, 0, 0x7f7f7f7f); } \
        else { _Pragma("unroll") for (int m = 0; m < 4; ++m) _Pragma("unroll") for (int n = 0; n < 2; ++n) _Pragma("unroll") for (int k = 0; k < 2; ++k) \
            acc[ai][bj][m][n] = __builtin_amdgcn_mfma_f32_16x16x32_bf16(Bt[n][k], At[m][k], acc[ai][bj][m][n], 0, 0, 0); } \
        __builtin_amdgcn_s_setprio(0); } while (0)
#define PG8_WAIT_V(n) asm volatile("s_waitcnt vmcnt(" #n ")" ::: "memory")
#define PG8_WAIT_L(n) asm volatile("s_waitcnt lgkmcnt(" #n ")" ::: "memory")
#define PG8_BAR __builtin_amdgcn_s_barrier()
#define PG8_SCHED __builtin_amdgcn_sched_barrier(0)
    f32x4 acc[2][2][4][2];
#pragma unroll
    for (int a = 0; a < 2; ++a)
#pragma unroll
        for (int b = 0; b < 2; ++b)
#pragma unroll
            for (int m = 0; m < 4; ++m)
#pragma unroll
                for (int n = 0; n < 2; ++n) acc[a][b][m][n] = (f32x4){0.f, 0.f, 0.f, 0.f};
    bf16x8 At[4][2], B0[2][2], B1[2][2]; i32x8 At8[4], B08[2], B18[2]; (void)At; (void)B0; (void)B1; (void)At8; (void)B08; (void)B18;
    const char* cA = cur.pa; const char* cB = cur.pb;
    PG8_STAGEB(PG8_SB(0, 0), cB, 0); PG8_STAGEB(PG8_SB(0, 1), cB, 1); PG8_STAGEA(PG8_SA(0, 0), cA, 0); PG8_STAGEA(PG8_SA(0, 1), cA, 1);
    if (wr == 1) PG8_BAR;
    PG8_WAIT_V(2); PG8_BAR;
    PG8_STAGEB(PG8_SB(1, 0), cB + kstep, 0); PG8_STAGEA(PG8_SA(1, 0), cA + kstep, 0); PG8_STAGEB(PG8_SB(1, 1), cB + kstep, 1);
    PG8_WAIT_V(6); PG8_BAR;
    for (;;) {
        const bool has_next = S.next(ui + 1, nxt);
        const char* nA = has_next ? nxt.pa : cA; const char* nB = has_next ? nxt.pb : cB;
#pragma unroll 1
        for (int t = 0; t < nt; t += 2) {
            const bool last = (t == nt - 2);
            const char* a1 = cA + (size_t)((t + 1) & (nt1 - 1)) * kstep;
            const char* a2 = last ? nA : cA + (size_t)((t + 2) & (nt1 - 1)) * kstep; const char* b2 = last ? nB : cB + (size_t)((t + 2) & (nt1 - 1)) * kstep;
            const char* a3 = a2 + kstep; const char* b3 = b2 + kstep;
            PG8_LDB(B0, 0, 0); PG8_LDB(B1, 0, 1); PG8_SCHED; PG8_LDA(At, 0, 0); PG8_STAGEA(PG8_SA(1, 1), a1, 1);
            if constexpr (GATHER) { if (last && has_next) {
#pragma unroll
                for (int i = 0; i < 2; ++i) { int R, C; stage_rc(tid * 16 + i * 8192, R, C); voffA[0][i] = S.row_off(nxt, R) + (unsigned)C * 2u; voffA[1][i] = S.row_off(nxt, R + HALF) + (unsigned)C * 2u; } } }
            PG8_WAIT_V(8); PG8_WAIT_L(0); PG8_BAR; PG8_MMA(0, 0, At, B0); PG8_MMA(0, 1, At, B1); PG8_BAR; PG8_SCHED;
            PG8_LDA(At, 0, 1); PG8_STAGEB(PG8_SB(0, 0), b2, 0); PG8_STAGEB(PG8_SB(0, 1), b2, 1); PG8_STAGEA(PG8_SA(0, 0), a2, 0);
            PG8_WAIT_V(8); PG8_WAIT_L(0); PG8_BAR; PG8_MMA(1, 0, At, B0); PG8_MMA(1, 1, At, B1); PG8_BAR; PG8_SCHED;
            PG8_LDB(B0, 1, 0); PG8_LDB(B1, 1, 1); PG8_SCHED; PG8_LDA(At, 1, 0); PG8_STAGEA(PG8_SA(0, 1), a2, 1);
            PG8_WAIT_V(8); PG8_WAIT_L(0); PG8_BAR; PG8_MMA(0, 0, At, B0); PG8_MMA(0, 1, At, B1); PG8_BAR; PG8_SCHED;
            PG8_LDA(At, 1, 1); PG8_STAGEB(PG8_SB(1, 0), b3, 0); PG8_STAGEB(PG8_SB(1, 1), b3, 1); PG8_STAGEA(PG8_SA(1, 0), a3, 0);
            PG8_WAIT_V(8); PG8_WAIT_L(0); PG8_BAR; PG8_MMA(1, 0, At, B0); PG8_MMA(1, 1, At, B1); PG8_BAR; PG8_SCHED;
        }
        if constexpr (ALIGN_EPI) { if (wr == 0) PG8_BAR; }
        if (krep > 1) { const float sc_ = 1.0f / (float)krep;
#pragma unroll
            for (int a = 0; a < 2; ++a)
#pragma unroll
                for (int b = 0; b < 2; ++b)
#pragma unroll
                    for (int m = 0; m < 4; ++m)
#pragma unroll
                        for (int n = 0; n < 2; ++n) acc[a][b][m][n] = acc[a][b][m][n] * sc_; }
        if constexpr (!Epi::AFTER_DRAIN) {
#pragma unroll 1
            for (int er = 0; er < epi_rep<Epi>::v; ++er) {
            int fr_ = fr, fq_ = fq; asm volatile("" : "+v"(fr_), "+v"(fq_));
            E(acc, cur, wr, wc, fr_, fq_); } }
        if (!has_next) break;
#pragma unroll
        for (int a = 0; a < 2; ++a)
#pragma unroll
            for (int b = 0; b < 2; ++b)
#pragma unroll
                for (int m = 0; m < 4; ++m)
#pragma unroll
                    for (int n = 0; n < 2; ++n) acc[a][b][m][n] = (f32x4){0.f, 0.f, 0.f, 0.f};
        cur = nxt; cA = nA; cB = nB; ++ui;
        if constexpr (ALIGN_EPI) { if (wr == 1) PG8_BAR; }
    }
    PG8_WAIT_V(0);
    if constexpr (!ALIGN_EPI) { if (wr == 0) PG8_BAR; }
    PG8_BAR;
    if constexpr (Epi::AFTER_DRAIN) { int fr_ = fr, fq_ = fq; asm volatile("" : "+v"(fr_), "+v"(fq_)); E.fused(acc, cur, wr, wc, fr_, fq_, lds, wid, lane); }
#undef PG8_SA
#undef PG8_SB
#undef PG8_STAGE
#undef PG8_STAGEA
#undef PG8_STAGEB
#undef PG8_LDA
#undef PG8_LDB
#undef PG8_MMA
#undef PG8_CAT8
#undef PG8_RD
#undef PG8_WAIT_V
#undef PG8_WAIT_L
#undef PG8_BAR
#undef PG8_SCHED
}

__device__ __forceinline__ u32x4 widen8(u32x2 X, u32x2 Y) {
    const auto r0 = __builtin_amdgcn_permlane32_swap(X.x, Y.x, false, false); const auto r1 = __builtin_amdgcn_permlane32_swap(X.y, Y.y, false, false);
    const auto s0 = __builtin_amdgcn_permlane16_swap(r0[0], r0[1], false, false); const auto s1 = __builtin_amdgcn_permlane16_swap(r1[0], r1[1], false, false);
    return (u32x4){s0[0], s1[0], s0[1], s1[1]};
}
typedef const f32x4 (&AccC)[2][2][4][2];
typedef f32x4 (&AccM)[2][2][4][2];

struct EpiInProj {
    static constexpr bool PERM = true, AFTER_DRAIN = false;
    bf16_t* U; const float* cs;
    __device__ __forceinline__ void operator()(AccC acc, const Unit& u, int wr, int wc, int fr, int fq) const {
        const int row0 = u.pm * BM + wr * 64 + fr, col0 = u.pn * BM + wc * 32 + 8 * fq;
        const bool rot = (u.pn >= 2) && (u.pn < 6) && ((wc & 1) == 0) && (fq < 2);
        const float sc = (u.pn == 2 || u.pn == 3) ? QSCALE_D : 1.f;
        f32x4 c0v[2][4], c1v[2][4]; u32x4 pk[2][4][2];
#define IP_LOAD(ai) do { _Pragma("unroll") for (int m = 0; m < 4; ++m) { const f32x4* cp = (const f32x4*)(cs + (size_t)(row0 + (ai) * HALF + m * 16) * 16 + 8 * (fq & 1)); c0v[ai][m] = cp[0]; c1v[ai][m] = cp[1]; } } while (0)
#define IP_ROT(ai) do { _Pragma("unroll") for (int m = 0; m < 4; ++m) { \
            const f32x4 c0 = rot ? c0v[ai][m] : (f32x4){1.f, 0.f, 1.f, 0.f}, c1 = rot ? c1v[ai][m] : (f32x4){1.f, 0.f, 1.f, 0.f}; \
            _Pragma("unroll") for (int bj = 0; bj < 2; ++bj) { const f32x4 v0 = acc[ai][bj][m][0], v1 = acc[ai][bj][m][1]; f32x4 w0, w1; \
                w0[0] = v0[0] * c0[0] - v0[1] * c0[1]; w0[1] = v0[1] * c0[0] + v0[0] * c0[1]; w0[2] = v0[2] * c0[2] - v0[3] * c0[3]; w0[3] = v0[3] * c0[2] + v0[2] * c0[3]; \
                w1[0] = v1[0] * c1[0] - v1[1] * c1[1]; w1[1] = v1[1] * c1[0] + v1[0] * c1[1]; w1[2] = v1[2] * c1[2] - v1[3] * c1[3]; w1[3] = v1[3] * c1[2] + v1[2] * c1[3]; \
                w0 = w0 * sc; w1 = w1 * sc; \
                u32x4 w; w.x = cvt_pk_bf16(w0[0], w0[1]); w.y = cvt_pk_bf16(w0[2], w0[3]); w.z = cvt_pk_bf16(w1[0], w1[1]); w.w = cvt_pk_bf16(w1[2], w1[3]); pk[ai][m][bj] = w; } } } while (0)
#define IP_STORE(ai) do { _Pragma("unroll") for (int m = 0; m < 4; ++m) { bf16_t* rowp = U + (size_t)(row0 + (ai) * HALF + m * 16) * INW + col0; \
            _Pragma("unroll") for (int bj = 0; bj < 2; ++bj) *(u32x4*)(rowp + bj * HALF) = pk[ai][m][bj]; } } while (0)
        IP_LOAD(0); IP_ROT(0); asm volatile("" ::: "memory");
        IP_LOAD(1); asm volatile("" ::: "memory");
        IP_STORE(0); IP_ROT(1); IP_STORE(1);
#undef IP_LOAD
#undef IP_ROT
#undef IP_STORE
    }
};
template <bool F8O> struct EpiTile {
    static constexpr bool PERM = true, AFTER_DRAIN = false;
    void* O; int ldc; const LAS float* rs; float mul;
    __device__ __forceinline__ void operator()(AccC acc, const Unit& u, int wr, int wc, int fr, int fq) const {
        const int rt0 = wr * 64 + fr, col0 = u.pn * BM + wc * 32 + 8 * fq;
        u32x2 wprev[2] = {(u32x2){0u, 0u}, (u32x2){0u, 0u}};
#pragma unroll
        for (int ai = 0; ai < 2; ++ai)
#pragma unroll
            for (int m = 0; m < 4; ++m) {
                const int rt = rt0 + ai * HALF + m * 16;
                const float s = rs ? rs[rt] * mul : mul;
                const size_t o0 = (size_t)(u.pm * BM + rt) * ldc + col0;
#pragma unroll
                for (int bj = 0; bj < 2; ++bj) { const f32x4 v0 = acc[ai][bj][m][0] * s, v1 = acc[ai][bj][m][1] * s;
                    if constexpr (F8O) { const u32x2 wv = (u32x2){pk4_fp8(v0[0], v0[1], v0[2], v0[3]), pk4_fp8(v1[0], v1[1], v1[2], v1[3])};
                        if ((m & 1) == 0) wprev[bj] = wv; else *(u32x4*)((unsigned char*)O + (size_t)(u.pm * BM + rt - 16 + (fq >> 1) * 16) * ldc + u.pn * BM + wc * 32 + (fq & 1) * 16 + bj * HALF) = widen8(wprev[bj], wv); }
                    else { u32x4 w; w.x = cvt_pk_bf16(v0[0], v0[1]); w.y = cvt_pk_bf16(v0[2], v0[3]); w.z = cvt_pk_bf16(v1[0], v1[1]); w.w = cvt_pk_bf16(v1[2], v1[3]);
                        *(u32x4*)((bf16_t*)O + o0 + bj * HALF) = w; } }
            }
    }
};
typedef EpiTile<false> EpiBf16;
struct EpiBf16Sel {
    static constexpr bool PERM = true, AFTER_DRAIN = false;
    bf16_t* O0; int ldc0; bf16_t* O1; int ldc1;
    __device__ __forceinline__ void operator()(AccC acc, const Unit& u, int wr, int wc, int fr, int fq) const {
        bf16_t* O = u.e ? O1 : O0; const int ldc = u.e ? ldc1 : ldc0;
        const int rt0 = wr * 64 + fr, col0 = u.pn * BM + wc * 32 + 8 * fq;
#pragma unroll
        for (int ai = 0; ai < 2; ++ai)
#pragma unroll
            for (int m = 0; m < 4; ++m) {
                const int rt = rt0 + ai * HALF + m * 16;
                bf16_t* rowp = O + (size_t)(u.pm * BM + rt) * ldc + col0;
#pragma unroll
                for (int bj = 0; bj < 2; ++bj) { const f32x4 v0 = acc[ai][bj][m][0], v1 = acc[ai][bj][m][1];
                    u32x4 w; w.x = cvt_pk_bf16(v0[0], v0[1]); w.y = cvt_pk_bf16(v0[2], v0[3]); w.z = cvt_pk_bf16(v1[0], v1[1]); w.w = cvt_pk_bf16(v1[2], v1[3]);
                    *(u32x4*)(rowp + bj * HALF) = w; }
            }
    }
};
template <bool RF32, bool F8OUT> struct EpiRes {
    static constexpr bool PERM = true, AFTER_DRAIN = false;
    const void* resid; bf16_t* xb; unsigned char* x8; float* ssp; float amul;
    __device__ __forceinline__ void operator()(AccC acc, const Unit& u, int wr, int wc, int fr, int fq) const {
        const int row0 = u.pm * BM + wr * 64 + fr, col0 = u.pn * BM + wc * 32 + 8 * fq;
        f32x4 v[4][2][2][2];
        u32x2 p8[2] = {(u32x2){0u, 0u}, (u32x2){0u, 0u}}; const int cb8 = u.pn * BM + wc * 32 + (fq & 1) * 16;
#define ER_ROW(b, mm) (row0 + ((b) >> 1) * HALF + (((b) & 1) * 2 + (mm)) * 16)
#define ER_LOAD(b) do { _Pragma("unroll") for (int mm = 0; mm < 2; ++mm) _Pragma("unroll") for (int bj = 0; bj < 2; ++bj) { const size_t o2 = (size_t)ER_ROW(b, mm) * D + col0 + bj * HALF; \
            if constexpr (RF32) { v[b][mm][bj][0] = *(const f32x4*)((const float*)resid + o2); v[b][mm][bj][1] = *(const f32x4*)((const float*)resid + o2 + 4); } \
            else { const u32x4 r = *(const u32x4*)((const bf16_t*)resid + o2); \
                v[b][mm][bj][0] = (f32x4){__builtin_bit_cast(float, r.x << 16), __builtin_bit_cast(float, r.x & 0xffff0000u), __builtin_bit_cast(float, r.y << 16), __builtin_bit_cast(float, r.y & 0xffff0000u)}; \
                v[b][mm][bj][1] = (f32x4){__builtin_bit_cast(float, r.z << 16), __builtin_bit_cast(float, r.z & 0xffff0000u), __builtin_bit_cast(float, r.w << 16), __builtin_bit_cast(float, r.w & 0xffff0000u)}; } } } while (0)
#define ER_SUM(b) do { _Pragma("unroll") for (int mm = 0; mm < 2; ++mm) _Pragma("unroll") for (int bj = 0; bj < 2; ++bj) _Pragma("unroll") for (int n = 0; n < 2; ++n) { \
            v[b][mm][bj][n] = v[b][mm][bj][n] + acc[(b) >> 1][bj][((b) & 1) * 2 + mm][n] * amul; asm volatile("" : "+v"(v[b][mm][bj][n])); } } while (0)
#define ER_STORE(b) do { _Pragma("unroll") for (int mm = 0; mm < 2; ++mm) { const int row = ER_ROW(b, mm); float ss = 0.f; \
            _Pragma("unroll") for (int bj = 0; bj < 2; ++bj) { const size_t o2 = (size_t)row * D + col0 + bj * HALF; const f32x4 x0 = v[b][mm][bj][0], x1 = v[b][mm][bj][1]; \
                ss += ((x0[0] * x0[0] + x0[1] * x0[1]) + (x0[2] * x0[2] + x0[3] * x0[3])) + ((x1[0] * x1[0] + x1[1] * x1[1]) + (x1[2] * x1[2] + x1[3] * x1[3])); \
                u32x4 w; w.x = cvt_pk_bf16(x0[0], x0[1]); w.y = cvt_pk_bf16(x0[2], x0[3]); w.z = cvt_pk_bf16(x1[0], x1[1]); w.w = cvt_pk_bf16(x1[2], x1[3]); *(u32x4*)(xb + o2) = w; \
                if constexpr (F8OUT) { const u32x2 wv = (u32x2){pk4_fp8(x0[0], x0[1], x0[2], x0[3]), pk4_fp8(x1[0], x1[1], x1[2], x1[3])}; \
                    if (mm == 0) p8[bj] = wv; else *(u32x4*)(x8 + (size_t)(row - 16 + (fq >> 1) * 16) * D + cb8 + bj * HALF) = widen8(p8[bj], wv); } } \
            if (ssp) { ss += __shfl_xor(ss, 16); ss += __shfl_xor(ss, 32); if (fq == 0) ssp[(size_t)(u.pn * 4 + wc) * T + row] = ss; } } } while (0)
#define ER_FENCE() asm volatile("" ::: "memory")
        ER_LOAD(0); ER_SUM(0); ER_FENCE();
        ER_LOAD(1); ER_FENCE(); ER_STORE(0); ER_SUM(1); ER_FENCE();
        ER_LOAD(2); ER_FENCE(); ER_STORE(1); ER_SUM(2); ER_FENCE();
        ER_LOAD(3); ER_FENCE(); ER_STORE(2); ER_SUM(3); ER_FENCE();
        ER_STORE(3);
#undef ER_ROW
#undef ER_LOAD
#undef ER_SUM
#undef ER_STORE
#undef ER_FENCE
    }
};
struct EpiSoftmax {
    static constexpr bool PERM = true, AFTER_DRAIN = true;
    bf16_t* O; int ldc; const LAS float* rs; float mul;
    __device__ __forceinline__ void fused(AccM acc, const Unit& u, int wr, int wc, int fr, int fq, LAS unsigned char* lds, int wid, int lane) const {
        LAS float* PM = (LAS float*)lds; LAS float* PS = (LAS float*)(lds + 4096);
#pragma unroll
        for (int ai = 0; ai < 2; ++ai)
#pragma unroll
            for (int m = 0; m < 4; ++m) { const float s_ = rs[ai * HALF + wr * 64 + m * 16 + fr] * mul;
#pragma unroll
                for (int bj = 0; bj < 2; ++bj)
#pragma unroll
                    for (int n = 0; n < 2; ++n) acc[ai][bj][m][n] = acc[ai][bj][m][n] * s_; }
#pragma unroll
        for (int ai = 0; ai < 2; ++ai)
#pragma unroll
            for (int m = 0; m < 4; ++m) { float v = -INFINITY;
#pragma unroll
                for (int bj = 0; bj < 2; ++bj)
#pragma unroll
                    for (int n = 0; n < 2; ++n) { const f32x4 x = acc[ai][bj][m][n]; v = fmaxf(v, fmaxf(fmaxf(x[0], x[1]), fmaxf(x[2], x[3]))); }
                v = fmaxf(v, __shfl_xor(v, 16)); v = fmaxf(v, __shfl_xor(v, 32));
                if (fq == 0) PM[(ai * HALF + wr * 64 + m * 16 + fr) * 4 + wc] = v; }
        LDS_WAIT(); __builtin_amdgcn_s_barrier(); asm volatile("" ::: "memory");
#pragma unroll
        for (int ai = 0; ai < 2; ++ai)
#pragma unroll
            for (int m = 0; m < 4; ++m) { const int rt = ai * HALF + wr * 64 + m * 16 + fr; const f32x4 q = *(const LAS f32x4*)(PM + rt * 4);
                const float mx = fmaxf(fmaxf(q[0], q[1]), fmaxf(q[2], q[3])); float s = 0.f;
#pragma unroll
                for (int bj = 0; bj < 2; ++bj)
#pragma unroll
                    for (int n = 0; n < 2; ++n) { f32x4 x = acc[ai][bj][m][n];
                        x = x - mx; x[0] = __builtin_amdgcn_exp2f(x[0]); x[1] = __builtin_amdgcn_exp2f(x[1]); x[2] = __builtin_amdgcn_exp2f(x[2]); x[3] = __builtin_amdgcn_exp2f(x[3]);
                        s += (x[0] + x[1]) + (x[2] + x[3]); acc[ai][bj][m][n] = x; }
                s += __shfl_xor(s, 16); s += __shfl_xor(s, 32);
                if (fq == 0) PS[rt * 4 + wc] = s; }
        LDS_WAIT(); __builtin_amdgcn_s_barrier(); asm volatile("" ::: "memory");
        const int col0 = u.pn * BM + wc * 32 + 8 * fq;
        u32x2 wprev[2] = {(u32x2){0u, 0u}, (u32x2){0u, 0u}};
#pragma unroll
        for (int ai = 0; ai < 2; ++ai)
#pragma unroll
            for (int m = 0; m < 4; ++m) { const int rt = ai * HALF + wr * 64 + m * 16 + fr; const f32x4 q = *(const LAS f32x4*)(PS + rt * 4);
                const float inv = 1.0f / ((q[0] + q[1]) + (q[2] + q[3]));
                unsigned char* rowp = (unsigned char*)O + (size_t)(u.pm * BM + rt - 16 + (fq >> 1) * 16) * ldc + col0 - 8 * fq + (fq & 1) * 16;
#pragma unroll
                for (int bj = 0; bj < 2; ++bj) { const f32x4 v0 = acc[ai][bj][m][0] * (inv * 256.0f), v1 = acc[ai][bj][m][1] * (inv * 256.0f);
                    const u32x2 wv = (u32x2){pk4_fp8(v0[0], v0[1], v0[2], v0[3]), pk4_fp8(v1[0], v1[1], v1[2], v1[3])};
                    if ((m & 1) == 0) wprev[bj] = wv; else *(u32x4*)(rowp + bj * HALF) = widen8(wprev[bj], wv); }
            }
        LDS_WAIT(); __builtin_amdgcn_s_barrier(); asm volatile("" ::: "memory");
    }
};
#define SW_STAGE(x) asm volatile("" : "+v"(x[0]), "+v"(x[1]), "+v"(x[2]), "+v"(x[3]))
struct EpiSwiGLU {
    static constexpr bool PERM = true, AFTER_DRAIN = false; static constexpr int REP = EPIREP_SW;
    unsigned char* H; const float* bgu; const float* rstd; const LAS int* tokt; const MoeOrder* S; unsigned* flags;
    __device__ __forceinline__ void operator()(AccC acc, const Unit& u, int wr, int wc, int fr, int fq) const {
        if (u.ui > 1 && (wr | wc) == 0) { Unit pv; (void)S->next(u.ui - 2, pv); if ((fr | fq) == 0) (void)xb_add(flags + (size_t)pv.pm * FLAG_STRIDE, 1u); }
        const int rt0 = wr * 64 + fr, c0 = u.pn * HALF + wc * 32 + 8 * fq; const float* bg_ = bgu + (size_t)u.e * 2048;
        constexpr float CP = 1.702f * LOG2E, ICP = 1.0f / CP;
        f32x4 tb[2], ub[2];
#pragma unroll
        for (int n = 0; n < 2; ++n) { tb[n] = *(const f32x4*)(bg_ + c0 + 4 * n) * (-CP); ub[n] = (*(const f32x4*)(bg_ + 1024 + c0 + 4 * n) * 4.0f + 4.0f) * (-ICP); }
        u32x2 wprev = (u32x2){0u, 0u};
        float rsv[2][4];
#pragma unroll
        for (int ai = 0; ai < 2; ++ai)
#pragma unroll
            for (int m = 0; m < 4; ++m) rsv[ai][m] = rstd[tokt[u.ui * 256 + rt0 + ai * HALF + m * 16]];
        asm volatile("s_waitcnt vmcnt(0)" ::: "memory");
        const int cb = u.pn * HALF + wc * 32 + (fq & 1) * 16, rsel = (fq >> 1) * 16;
#pragma unroll
        for (int ai = 0; ai < 2; ++ai)
#pragma unroll
            for (int m = 0; m < 4; ++m) {
                const int rt = rt0 + ai * HALF + m * 16;
                const float rst = rsv[ai][m] * (-CP * 0.03125f), rsu = rsv[ai][m] * (-4.0f * ICP * 0.03125f);
                unsigned w[2];
                f32x2 t[4], ut[4], d[4];
#pragma unroll
                for (int n = 0; n < 2; ++n) { const f32x4 t4 = acc[ai][0][m][n] * rst + tb[n], u4 = acc[ai][1][m][n] * rsu + ub[n];
#pragma unroll
                    for (int j = 0; j < 2; ++j) {
                        t[2 * n + j] = __builtin_elementwise_max((f32x2){t4[2 * j], t4[2 * j + 1]}, (f32x2){-7.0f * CP, -7.0f * CP});
                        const f32x2 uu = __builtin_elementwise_min(__builtin_elementwise_max((f32x2){u4[2 * j], u4[2 * j + 1]}, (f32x2){-32.0f * ICP, -32.0f * ICP}), (f32x2){24.0f * ICP, 24.0f * ICP});
                        ut[2 * n + j] = uu * t[2 * n + j]; } }
#pragma unroll
                for (int k = 0; k < 4; ++k) { d[k].x = __builtin_amdgcn_exp2f(t[k].x); d[k].y = __builtin_amdgcn_exp2f(t[k].y); }
                SW_STAGE(d);
#pragma unroll
                for (int k = 0; k < 4; ++k) d[k] = d[k] + 1.0f;
                SW_STAGE(d);
#pragma unroll
                for (int k = 0; k < 4; ++k) { d[k].x = __builtin_amdgcn_rcpf(d[k].x); d[k].y = __builtin_amdgcn_rcpf(d[k].y); }
                SW_STAGE(d);
#pragma unroll
                for (int k = 0; k < 4; ++k) d[k] = ut[k] * d[k];
                w[0] = pk4_fp8(d[0].x, d[0].y, d[1].x, d[1].y); w[1] = pk4_fp8(d[2].x, d[2].y, d[3].x, d[3].y);
                if ((m & 1) == 0) { wprev = (u32x2){w[0], w[1]}; }
                else { const u32x4 ww = widen8(wprev, (u32x2){w[0], w[1]}); *(u32x4*)(H + (size_t)(u.pm * BM + rt - 16 + rsel) * 1024 + cb) = ww; }
            }
    }
};
struct EpiDown {
    static constexpr bool PERM = true, AFTER_DRAIN = false; static constexpr int REP = EPIREP_DN; static constexpr int A_AUX = 16;
    unsigned char* Y; const float* bd; const float* gates; const MoeOrder* S; unsigned* flags;
    __device__ __forceinline__ void operator()(AccC acc, const Unit& u, int wr, int wc, int fr, int fq) const {
        const int rt0 = wr * 64 + fr, col0 = u.pn * BM + wc * 32 + 8 * fq; const float* bd_ = bd + (size_t)u.e * 1024; const float* gt_ = gates + (size_t)u.e * CAP + u.r * 256;
        f32x4 bv[2][2];
#pragma unroll
        for (int bj = 0; bj < 2; ++bj)
#pragma unroll
            for (int n = 0; n < 2; ++n) bv[bj][n] = *(const f32x4*)(bd_ + col0 + bj * HALF + 4 * n);
        u32x2 wprev[2] = {(u32x2){0u, 0u}, (u32x2){0u, 0u}};
        float gv[2][4];
#pragma unroll
        for (int ai = 0; ai < 2; ++ai)
#pragma unroll
            for (int m = 0; m < 4; ++m) gv[ai][m] = gt_[rt0 + ai * HALF + m * 16];
        asm volatile("" ::: "memory");
        unsigned fv2 = 8u; int pm2 = 0;
        if ((wr | wc) == 0) { Unit n2; const bool h2 = S->next(u.ui + 2, n2); pm2 = h2 ? n2.pm : u.pm; fv2 = xb_ld(flags + (size_t)pm2 * FLAG_STRIDE); }
#pragma unroll
        for (int ai = 0; ai < 2; ++ai)
#pragma unroll
            for (int m = 0; m < 4; ++m) {
                const int rt = rt0 + ai * HALF + m * 16;
                const float g = gv[ai][m] * 16.0f;
                unsigned char* rowp = Y + (size_t)(u.pm * BM + rt - 16 + (fq >> 1) * 16) * 1024 + u.pn * BM + wc * 32 + (fq & 1) * 16;
#pragma unroll
                for (int bj = 0; bj < 2; ++bj) { const f32x4 v0 = (acc[ai][bj][m][0] * 0.0078125f + bv[bj][0]) * g, v1 = (acc[ai][bj][m][1] * 0.0078125f + bv[bj][1]) * g;
                    const u32x2 wv = (u32x2){pk4_fp8(v0[0], v0[1], v0[2], v0[3]), pk4_fp8(v1[0], v1[1], v1[2], v1[3])};
                    if ((m & 1) == 0) wprev[bj] = wv; else *(u32x4*)(rowp + bj * HALF) = widen8(wprev[bj], wv); }
            }
        if (fv2 < 8u) hid_wait(flags, pm2);
    }
};
}

struct Args {
    const float* x; const int* pos; const float* mem; const float* attn_g; const float* w_in; const float* w_pool; const float* pool_scale;
    const float* lq1; const float* lk1; const float* lq2; const float* lk2; const float* subln_g; const float* w_out; const float* xattn_g; const float* mem_g;
    const float* w_cq; const float* w_ckv; const float* w_co; const float* ffn_g; const float* w_router; const float* b_router; const float* w_gu; const float* b_gu;
    const float* w_down; const float* b_down; const float* final_g;
    float* out; unsigned char* ws; int ph_lo, ph_hi;
};

template <int MAP>
__device__ __forceinline__ int rowmap(int c) {
    if (MAP == 1) { if (c >= 512 && c < 1536) { const int d = c & 63; if (d < 16) return (c & ~63) + ((d < 8) ? 2 * d : 2 * (d - 8) + 1); } return c; }
    if (MAP == 2) { const int j = c & 1023; return ((j >> 7) << 8) + ((c >> 10) << 7) + (j & 127); }
    return c;
}
template <int MAP, bool OUT8>
__device__ __forceinline__ void p0_transpose_stream(const float* W, int K, int N, int nmat, void* WTv, int ldt, int kdst0, size_t dst_stride, const float* g, LAS float* scr, int gw, int NGW, int lane, int it_lo = 0, int it_hi = 0x7fffffff) {
    const int nblk = N / 32, ipm = (K / 64) * nblk, nitems = min(nmat * ipm, it_hi);
    const int lr = lane >> 3, lc = (lane & 7) * 4;
    f32x4 cur[8], nxt[8];
#define P0_LOAD(dst, it) do { const int e_ = (it) / ipm, r_ = (it) % ipm, kb_ = r_ / nblk, nb_ = r_ % nblk; const float* p_ = W + ((size_t)e_ * K + 64 * kb_ + lr) * N + 32 * nb_ + lc; \
        _Pragma("unroll") for (int i_ = 0; i_ < 8; ++i_) dst[i_] = __builtin_nontemporal_load((const f32x4*)(p_ + (size_t)(8 * i_) * N)); } while (0)
    int it = it_lo + gw;
    if (it < nitems) P0_LOAD(cur, it);
    while (it < nitems) {
        const int itn = it + NGW;
        if (itn < nitems) P0_LOAD(nxt, itn);
        const int e = it / ipm, r = it % ipm, kb = r / nblk, nb = r % nblk, k0 = 64 * kb, n0 = 32 * nb;
#pragma unroll
        for (int i = 0; i < 8; ++i) { const int kk = 8 * i + lr; f32x4 v = cur[i]; if (g) v = v * g[k0 + kk];
            LAS float* s = scr + kk * 33 + lc; s[0] = v[0]; s[1] = v[1]; s[2] = v[2]; s[3] = v[3]; }
        LDS_WAIT(); asm volatile("" ::: "memory");
        if constexpr (OUT8) {
            const int c = lane & 3; unsigned char* wt = (unsigned char*)WTv + (size_t)e * dst_stride;
#pragma unroll
            for (int j = 0; j < 2; ++j) { const int n = (lane >> 2) + 16 * j; const LAS float* s = scr + (16 * c) * 33 + n;
                u32x4 o; o.x = pk4_fp8(s[0 * 33] * 32.f, s[1 * 33] * 32.f, s[2 * 33] * 32.f, s[3 * 33] * 32.f); o.y = pk4_fp8(s[4 * 33] * 32.f, s[5 * 33] * 32.f, s[6 * 33] * 32.f, s[7 * 33] * 32.f);
                o.z = pk4_fp8(s[8 * 33] * 32.f, s[9 * 33] * 32.f, s[10 * 33] * 32.f, s[11 * 33] * 32.f); o.w = pk4_fp8(s[12 * 33] * 32.f, s[13 * 33] * 32.f, s[14 * 33] * 32.f, s[15 * 33] * 32.f);
                *(u32x4*)(wt + (size_t)rowmap<MAP>(n0 + n) * ldt + kdst0 + k0 + 16 * c) = o; }
        } else {
            const int c = lane & 7; bf16_t* wt = (bf16_t*)WTv + (size_t)e * dst_stride;
#pragma unroll
            for (int j = 0; j < 4; ++j) { const int n = (lane >> 3) + 8 * j; const LAS float* s = scr + (8 * c) * 33 + n;
                u32x4 o; o.x = pk2(s[0 * 33], s[1 * 33]); o.y = pk2(s[2 * 33], s[3 * 33]); o.z = pk2(s[4 * 33], s[5 * 33]); o.w = pk2(s[6 * 33], s[7 * 33]);
                *(u32x4*)(wt + (size_t)rowmap<MAP>(n0 + n) * ldt + kdst0 + k0 + 8 * c) = o; }
        }
        LDS_WAIT(); asm volatile("" ::: "memory");
#pragma unroll
        for (int i = 0; i < 8; ++i) cur[i] = nxt[i];
        it = itn;
    }
#undef P0_LOAD
}
__device__ __forceinline__ void rms_row_to_bf16(const float* xrow, const float* g, bf16_t* orow, int lane) {
    const f32x4* xr = (const f32x4*)xrow + lane; const f32x4* gr = (const f32x4*)g + lane;
    f32x4 v[4]; float s = 0.f;
#pragma unroll
    for (int j = 0; j < 4; ++j) { v[j] = xr[64 * j]; s += (v[j][0] * v[j][0] + v[j][1] * v[j][1]) + (v[j][2] * v[j][2] + v[j][3] * v[j][3]); }
    const float rstd = 1.0f / sqrtf(wave_sum(s) * (1.0f / D) + EPS);
    u32x2* o8 = (u32x2*)orow + lane;
#pragma unroll
    for (int j = 0; j < 4; ++j) { const f32x4 gg = gr[64 * j]; u32x2 w; w.x = pk2(v[j][0] * rstd * gg[0], v[j][1] * rstd * gg[1]); w.y = pk2(v[j][2] * rstd * gg[2], v[j][3] * rstd * gg[3]); o8[64 * j] = w; }
}

__device__ __forceinline__ void rms_rows_stream(const float* X, const float* g, bf16_t* O, int nrows, int gw, int NGW, int lane) {
    f32x4 cur[4], nxt[4]; const f32x4* gr = (const f32x4*)g + lane;
    int r = gw;
    if (r < nrows) { const f32x4* xr = (const f32x4*)(X + (size_t)r * D) + lane;
#pragma unroll
        for (int j = 0; j < 4; ++j) cur[j] = __builtin_nontemporal_load(xr + 64 * j); }
    while (r < nrows) {
        const int rn = r + NGW;
        if (rn < nrows) { const f32x4* xr = (const f32x4*)(X + (size_t)rn * D) + lane;
#pragma unroll
            for (int j = 0; j < 4; ++j) nxt[j] = __builtin_nontemporal_load(xr + 64 * j); }
        float s = 0.f;
#pragma unroll
        for (int j = 0; j < 4; ++j) s += (cur[j][0] * cur[j][0] + cur[j][1] * cur[j][1]) + (cur[j][2] * cur[j][2] + cur[j][3] * cur[j][3]);
        const float rstd = 1.0f / sqrtf(wave_sum(s) * (1.0f / D) + EPS);
        u32x2* o8 = (u32x2*)(O + (size_t)r * D) + lane;
#pragma unroll
        for (int j = 0; j < 4; ++j) { const f32x4 gg = gr[64 * j]; u32x2 w; w.x = pk2(cur[j][0] * rstd * gg[0], cur[j][1] * rstd * gg[1]); w.y = pk2(cur[j][2] * rstd * gg[2], cur[j][3] * rstd * gg[3]); o8[64 * j] = w; }
#pragma unroll
        for (int j = 0; j < 4; ++j) cur[j] = nxt[j];
        r = rn;
    }
}

namespace dattn {
constexpr int KP = 144, VP = 320;
constexpr int K_BYTES = 2 * 64 * KP, V_BYTES = 64 * VP;
constexpr int V_OFF = 2 * K_BYTES;
constexpr float THR = 4.0f;
__device__ __forceinline__ s16x4 vtr(const LAS unsigned char* p) { typedef short v4i16_t __attribute__((ext_vector_type(4))); return __builtin_bit_cast(s16x4, __builtin_amdgcn_ds_read_tr16_b64_v4i16((LAS v4i16_t*)p)); }
__device__ __forceinline__ void pv_tile(f32x16 (&o)[4], const bf16x8 (&pf)[4], const float alpha, const bool resc, const LAS unsigned char* vb_) {
    unsigned vbo = (unsigned)(uintptr_t)vb_; asm volatile("" : "+v"(vbo));
    const LAS unsigned char* vb = (const LAS unsigned char*)(uintptr_t)vbo;
    if (resc) {
#pragma unroll
        for (int d0 = 0; d0 < 4; ++d0) o[d0] = o[d0] * alpha;
    }
    s16x4 lo[2][4], hv[2][4];
#define PV_RD(buf, s) do { _Pragma("unroll") for (int d0 = 0; d0 < 4; ++d0) { lo[buf][d0] = vtr(vb + (s) * 16 * VP + d0 * 64); hv[buf][d0] = vtr(vb + (s) * 16 * VP + 8 * VP + d0 * 64); } } while (0)
#define PV_MM(buf, s) do { _Pragma("unroll") for (int d0 = 0; d0 < 4; ++d0) { const bf16x8 vf = (bf16x8){lo[buf][d0][0], lo[buf][d0][1], lo[buf][d0][2], lo[buf][d0][3], hv[buf][d0][0], hv[buf][d0][1], hv[buf][d0][2], hv[buf][d0][3]}; \
        o[d0] = __builtin_amdgcn_mfma_f32_32x32x16_bf16(vf, pf[s], o[d0], 0, 0, 0); } } while (0)
    PV_RD(0, 0); __builtin_amdgcn_sched_barrier(0);
    PV_RD(1, 1); __builtin_amdgcn_sched_barrier(0);
    PV_MM(0, 0); __builtin_amdgcn_sched_barrier(0);
    PV_RD(0, 2); __builtin_amdgcn_sched_barrier(0);
    PV_MM(1, 1); __builtin_amdgcn_sched_barrier(0);
    PV_RD(1, 3); __builtin_amdgcn_sched_barrier(0);
    PV_MM(0, 2); __builtin_amdgcn_sched_barrier(0);
    PV_MM(1, 3); __builtin_amdgcn_sched_barrier(0);
#undef PV_RD
#undef PV_MM
}
__device__ __forceinline__ void unit(LAS unsigned char* lds, const int wv, const bf16_t* U, bf16_t* CAT, const float* subln_g, float lam, int b, int hh, int j) {
    int tid_ = wv * 64 + lane_id(); asm volatile("" : "+v"(tid_));
    const int tid = tid_, lane = tid & 63, r32 = lane & 31, hi = lane >> 5; const int wid = __builtin_amdgcn_readfirstlane(tid >> 6);
    const int mp = wid & 1, rg = wid >> 1, grp = wid >> 2;
    const size_t tok0 = (size_t)b * SEQ;
    const int q0 = j * 128 + rg * 32;
    const int nt_all = 2 * j + 2, nt_mine = (rg < 2) ? nt_all - 1 : nt_all;
    bf16x8 qf[4];
    { const bf16_t* qp = U + (tok0 + q0 + r32) * INW + 512 + hh * 128 + mp * 64 + hi * 8;
#pragma unroll
      for (int ks = 0; ks < 4; ++ks) qf[ks] = *(const bf16x8*)(qp + ks * 16); }
    const int prow = tid >> 3, pc0 = (tid & 7) * 2;
    const bf16_t* kg = U + (tok0 + prow) * INW + 1024 + hh * 128 + pc0 * 8;
    const bf16_t* vg = U + (tok0 + prow) * INW + 1536 + hh * 128 + pc0 * 8;
    unsigned kdst[2], vdst[2];
#pragma unroll
    for (int i = 0; i < 2; ++i) { const int c16 = pc0 + i; kdst[i] = (unsigned)((c16 >> 3) * (64 * KP) + prow * KP + (c16 & 7) * 16); vdst[i] = (unsigned)(V_OFF + prow * VP + c16 * 16); }
    u32x4 kr[2], vr[2];
#define DA_LOAD(t) do { const size_t go = (size_t)(t) * 64 * INW; kr[0] = *(const u32x4*)(kg + go); kr[1] = *(const u32x4*)(kg + go + 8); vr[0] = *(const u32x4*)(vg + go); vr[1] = *(const u32x4*)(vg + go + 8); } while (0)
#define DA_WRITE(t) do { LAS unsigned char* kb_ = lds + ((t) & 1) * K_BYTES; LAS unsigned char* vb_ = lds + ((t) % 3) * V_BYTES; \
        *(LAS u32x4*)(kb_ + kdst[0]) = kr[0]; *(LAS u32x4*)(kb_ + kdst[1]) = kr[1]; *(LAS u32x4*)(vb_ + vdst[0]) = vr[0]; *(LAS u32x4*)(vb_ + vdst[1]) = vr[1]; } while (0)
    f32x16 o[4];
#pragma unroll
    for (int d0 = 0; d0 < 4; ++d0)
#pragma unroll
        for (int r = 0; r < 16; ++r) o[d0][r] = 0.f;
    float mrun = -INFINITY, lrun = 0.f, alpha = 1.f; bool resc = false;
    bf16x8 pf[4];
#pragma unroll
    for (int s = 0; s < 4; ++s) pf[s] = (bf16x8){0, 0, 0, 0, 0, 0, 0, 0};
    const int i16 = lane & 15, g16 = (lane >> 4) & 1;
    const unsigned kbase = (unsigned)(mp * (64 * KP) + r32 * KP + hi * 16);
    const unsigned vbase = (unsigned)(V_OFF + (4 * hi + (i16 >> 2)) * VP + (16 * g16 + 4 * (i16 & 3)) * 2);
    DA_LOAD(0); DA_WRITE(0);
    __syncthreads();
#pragma unroll 1
    for (int kt = 0; kt < nt_all; ++kt) {
        const bool more = (kt + 1 < nt_all);
        if (more) DA_LOAD(kt + 1);
        if (grp == 1 && kt >= 1) pv_tile(o, pf, alpha, resc, lds + vbase + ((unsigned)(kt + 2) % 3u) * (unsigned)V_BYTES);
        if (kt < nt_mine) {
            const LAS unsigned char* sb = lds + (kt & 1) * K_BYTES;
            f32x16 p0, p1;
#pragma unroll
            for (int r = 0; r < 16; ++r) { p0[r] = 0.f; p1[r] = 0.f; }
#pragma unroll
            for (int ks = 0; ks < 4; ++ks) {
                const bf16x8 k0 = *(const LAS bf16x8*)(sb + kbase + ks * 32), k1 = *(const LAS bf16x8*)(sb + kbase + 32 * KP + ks * 32);
                p0 = __builtin_amdgcn_mfma_f32_32x32x16_bf16(k0, qf[ks], p0, 0, 0, 0);
                p1 = __builtin_amdgcn_mfma_f32_32x32x16_bf16(k1, qf[ks], p1, 0, 0, 0);
            }
            float mx = fmaxf(p0[0], p1[0]);
#pragma unroll
            for (int r = 1; r < 16; ++r) mx = fmaxf(mx, fmaxf(p0[r], p1[r]));
            mx = fmaxf(mx, __shfl_xor(mx, 32));
            resc = __any(mx - mrun > THR) != 0;
            alpha = 1.f;
            if (resc) { const float mnew = fmaxf(mrun, mx); alpha = __builtin_amdgcn_exp2f(mrun - mnew); mrun = mnew; }
            p0 = p0 - mrun; p1 = p1 - mrun;
#pragma unroll
            for (int r = 0; r < 16; ++r) { p0[r] = __builtin_amdgcn_exp2f(p0[r]); p1[r] = __builtin_amdgcn_exp2f(p1[r]); }
            const f32x16 ps = p0 + p1;
            const f32x4 s4 = (__builtin_shufflevector(ps, ps, 0, 1, 2, 3) + __builtin_shufflevector(ps, ps, 4, 5, 6, 7)) + (__builtin_shufflevector(ps, ps, 8, 9, 10, 11) + __builtin_shufflevector(ps, ps, 12, 13, 14, 15));
            const float ls = (s4[0] + s4[1]) + (s4[2] + s4[3]);
            lrun = lrun * alpha + ls;
#pragma unroll
            for (int s = 0; s < 4; ++s) { u32x4 w;
                if (s < 2) { w.x = cvt_pk_bf16(p0[8 * s + 0], p0[8 * s + 1]); w.y = cvt_pk_bf16(p0[8 * s + 2], p0[8 * s + 3]); w.z = cvt_pk_bf16(p0[8 * s + 4], p0[8 * s + 5]); w.w = cvt_pk_bf16(p0[8 * s + 6], p0[8 * s + 7]); }
                else { const int s2 = s - 2; w.x = cvt_pk_bf16(p1[8 * s2 + 0], p1[8 * s2 + 1]); w.y = cvt_pk_bf16(p1[8 * s2 + 2], p1[8 * s2 + 3]); w.z = cvt_pk_bf16(p1[8 * s2 + 4], p1[8 * s2 + 5]); w.w = cvt_pk_bf16(p1[8 * s2 + 6], p1[8 * s2 + 7]); }
                pf[s] = __builtin_bit_cast(bf16x8, w); }
            if (grp == 0) pv_tile(o, pf, alpha, resc, lds + vbase + ((unsigned)kt % 3u) * (unsigned)V_BYTES);
        }
        if (more) DA_WRITE(kt + 1);
        __syncthreads();
    }
    if (grp == 1) pv_tile(o, pf, alpha, resc, lds + vbase + ((unsigned)(nt_all + 2) % 3u) * (unsigned)V_BYTES);
    __syncthreads();
#undef DA_LOAD
#undef DA_WRITE
    const float ltot = lrun + __shfl_xor(lrun, 32), inv = 1.0f / ltot;
    LAS float* X = (LAS float*)lds + rg * 4096;
    if (mp == 1) {
#pragma unroll
        for (int d0 = 0; d0 < 4; ++d0)
#pragma unroll
            for (int r = 0; r < 16; ++r) { const int dv = 32 * d0 + (r & 3) + 8 * (r >> 2) + 4 * hi; X[dv * 32 + r32] = o[d0][r] * inv; }
    }
    __syncthreads();
    if (mp == 0) {
        float ss = 0.f;
#pragma unroll
        for (int d0 = 0; d0 < 4; ++d0)
#pragma unroll
            for (int r = 0; r < 16; ++r) { const int dv = 32 * d0 + (r & 3) + 8 * (r >> 2) + 4 * hi; const float v = o[d0][r] * inv - lam * X[dv * 32 + r32]; o[d0][r] = v; ss += v * v; }
        ss += __shfl_xor(ss, 32);
        const float rstd = 0.8f / sqrtf(ss * (1.0f / 128.0f) + EPS);
        bf16_t* op = CAT + (tok0 + q0 + r32) * D + 512 + hh * 128;
#pragma unroll
        for (int d0 = 0; d0 < 4; ++d0)
#pragma unroll
            for (int r4 = 0; r4 < 4; ++r4) { const int dv = 32 * d0 + 8 * r4 + 4 * hi; const f32x4 gg = *(const f32x4*)(subln_g + dv);
                u32x2 w; w.x = cvt_pk_bf16(o[d0][4 * r4 + 0] * rstd * gg[0], o[d0][4 * r4 + 1] * rstd * gg[1]); w.y = cvt_pk_bf16(o[d0][4 * r4 + 2] * rstd * gg[2], o[d0][4 * r4 + 3] * rstd * gg[3]);
                *(u32x2*)(op + dv) = w; }
    }
    __syncthreads();
}
}

typedef const __attribute__((address_space(4))) Args* KArgsP;
__device__ __forceinline__ KArgsP kargs() { KArgsP p = (KArgsP)__builtin_amdgcn_kernarg_segment_ptr(); asm volatile("" : "+s"(p)); return p; }
#define PH_PTRS() KArgsP ap = kargs(); unsigned char* ws = ap->ws; (void)ws; int tid = wave * 64 + lane_id(); asm volatile("" : "+v"(tid)); const int lane = tid & 63; (void)lane; \
    float* cs = (float*)(ws + WS_CS); float* ssp = (float*)(ws + WS_SSP); float* rstd2 = (float*)(ws + WS_RSTD2); \
    int* tokslot = (int*)(ws + WS_TOKSLOT); int* ltok = (int*)(ws + WS_LTOK); float* lgate = (float*)(ws + WS_LGATE); \
    bf16_t* Win_t = (bf16_t*)(ws + WS_WIN); bf16_t* Wout_t = (bf16_t*)(ws + WS_WOUT); bf16_t* Wcq_t = (bf16_t*)(ws + WS_WCQ); bf16_t* Wckv_t = (bf16_t*)(ws + WS_WCKV); \
    bf16_t* Wco_t = (bf16_t*)(ws + WS_WCO); bf16_t* Wgu_t = (bf16_t*)(ws + WS_WGU); bf16_t* Wdn_t = (bf16_t*)(ws + WS_WDN); \
    bf16_t* H0 = (bf16_t*)(ws + WS_H0); bf16_t* MEMN = (bf16_t*)(ws + WS_MEMN); bf16_t* KC = (bf16_t*)(ws + WS_KC); bf16_t* VT = (bf16_t*)(ws + WS_VT); \
    bf16_t* U = (bf16_t*)(ws + WS_U); bf16_t* CAT = (bf16_t*)(ws + WS_CAT); bf16_t* X2H = (bf16_t*)(ws + WS_X1); bf16_t* X1B = (bf16_t*)(ws + WS_X1B); \
    bf16_t* QC = (bf16_t*)(ws + WS_QC); bf16_t* PC = (bf16_t*)(ws + WS_PC); bf16_t* OC = (bf16_t*)(ws + WS_OC); bf16_t* X2B = (bf16_t*)(ws + WS_X2B); \
    bf16_t* HID = (bf16_t*)(ws + WS_HID); bf16_t* YR = (bf16_t*)(ws + WS_Y); unsigned char* X1F8 = (unsigned char*)(ws + WS_X2); (void)X1F8; \
    (void)cs; (void)ssp; (void)rstd2; (void)tokslot; (void)ltok; (void)lgate; (void)Win_t; (void)Wout_t; (void)Wcq_t; (void)Wckv_t; (void)Wco_t; (void)Wgu_t; (void)Wdn_t; (void)H0; (void)MEMN; (void)KC; (void)VT; \
    (void)U; (void)CAT; (void)X2H; (void)X1B; (void)QC; (void)PC; (void)OC; (void)X2B; (void)HID; (void)YR

#define CONV_CHUNK(c) do { LAS float* scr_ = (LAS float*)(lds + wave * 16384); \
        if ((c) == 0) p0_transpose_stream<2, true>(ap->w_gu, 1024, 2048, NE, Wgu_t, 1024, 0, (size_t)2048 * 1024, ap->ffn_g, scr_, gw, NGW, lane, 0, 16384); \
        if ((c) == 1) p0_transpose_stream<2, true>(ap->w_gu, 1024, 2048, NE, Wgu_t, 1024, 0, (size_t)2048 * 1024, ap->ffn_g, scr_, gw, NGW, lane, 16384); \
        if ((c) == 2) p0_transpose_stream<0, true>(ap->w_down, 1024, 1024, NE, Wdn_t, 1024, 0, (size_t)1024 * 1024, nullptr, scr_, gw, NGW, lane); \
        __syncthreads(); } while (0)

constexpr int NWAVES = 8;
static_assert(MK_N_LAUNCHES == 1, "only the one-launch build is valid");
constexpr int NDEFER = 12288;
constexpr int N_PHASES = 10;

__global__ void __launch_bounds__(NWAVES * 64, 2) fwd_kernel(Args a) {
    extern __shared__ __attribute__((aligned(16))) unsigned char lds_raw[];
    LAS unsigned char* lds = (LAS unsigned char*)lds_raw;
    const int wave = __builtin_amdgcn_readfirstlane((int)threadIdx.x >> 6);
    const int tid = wave * 64 + lane_id(), lane = tid & 63; (void)lane;
    const int G = gridDim.x, bx = blockIdx.x;
    const int gw = bx * NWAVES + wave, NGW = G * NWAVES;
    unsigned* ctl; { unsigned char* ws0 = a.ws; ctl = (unsigned*)(ws0 + WS_CTL); }
    volatile LAS unsigned* MISC = (volatile LAS unsigned*)(lds + MISC_OFF);
    if (tid < 32) ((LAS unsigned*)(lds + MISC_OFF))[tid] = 0u;
    __syncthreads();
    XcdBarrier bar; bar.bar = ctl + CW_BAR; bar.x = 0; bar.st = nullptr;
    if (MK_N_LAUNCHES == 1) bar = xcd_barrier_post(ctl + CW_BAR, MISC + 8, tid);
    if (tid == 0) __hip_atomic_store(ctl + CW_XCC + bx, 1u + xb_xcc_id(), __ATOMIC_RELAXED, __HIP_MEMORY_SCOPE_AGENT);
    bool same_xcc = false;
    const int lo = a.ph_lo, hi = a.ph_hi;
    unsigned long long tp_lo = 0ull, tp_acc = 0ull; (void)tp_lo; (void)tp_acc;
#define IN(k) (((PMASK >> (k)) & 1) && lo <= (k) && (k) < hi)
#define SEAM(k) do { if (IN(k) && IN((k) + 1)) xcd_barrier(bar, wave * 64 + lane_id()); } while (0)

    if (TP_LO == 0) tp_lo = __builtin_amdgcn_s_memrealtime();
    if (IN(0)) for (int rep_ = 0; rep_ < REPS(0); ++rep_) { PH_PTRS();
        LAS float* scr = (LAS float*)(lds + wave * 16384);
        p0_transpose_stream<0, false>(ap->w_ckv, 1024, 2048, 1, Wckv_t, 1024, 0, 0, nullptr, scr, gw, NGW, lane);
        rms_rows_stream(ap->mem, ap->mem_g, MEMN, NMEM, gw, NGW, lane);
        xcd_barrier(bar, tid);
        { const unsigned mine = (tid < G) ? xb_ld(ctl + CW_XCC + tid) : 1u, rep0 = (tid < G) ? xb_ld(ctl + CW_XCC + (tid & 7)) : 1u;
          if (!(mine == rep0 && mine != 0u)) MISC[20] = 1u;
          __syncthreads();
          same_xcc = (G == 256) && (MISC[20] == 0u); }
        const bool kvblk = (G == 256) && ((bx & 3) == 0);
        if (kvblk || G != 256) { pg8::StaticOrder S; if (G == 256) S.init(MEMN, Wckv_t, NMEM, 2048, D, D, 64, bx >> 2); else S.init(MEMN, Wckv_t, NMEM, 2048, D, D, G, bx);
            pg8::EpiBf16 E{KC, 2048, nullptr, 1.0f};
            pg8::gemm_phase<pg8::EpiBf16, pg8::StaticOrder, true, false, false>(lds, wave, 2 * D, 2 * D, 2 * D, S, E, KREPS(0)); }
        if (!kvblk) {
        const int gw = (G == 256) ? (bx - (bx >> 2) - 1) * NWAVES + wave : bx * NWAVES + wave, NGW = (G == 256) ? 192 * NWAVES : G * NWAVES;
        p0_transpose_stream<1, false>(ap->w_in, 1024, 2048, 1, Win_t, 1024, 0, 0, nullptr, scr, gw, NGW, lane);
        p0_transpose_stream<0, false>(ap->w_out + (size_t)512 * 1024, 512, 1024, 1, Wout_t, 1024, 512, 0, nullptr, scr, gw, NGW, lane);
        p0_transpose_stream<0, false>(ap->w_co, 1024, 1024, 1, Wco_t, 1024, 0, 0, nullptr, scr, gw, NGW, lane);
        constexpr int I_WEFF = 512, I_WR = 512, I_ROPE = T * 8 / 64;
        constexpr int NITEMS = I_WEFF + I_WR + I_ROPE;
        for (int it = gw; it < 1024 * 1024 / 512; it += NGW) {
            const int idx = it * 512 + lane * 8; const f32x4 a0 = *(const f32x4*)(ap->w_cq + idx), a1 = *(const f32x4*)(ap->w_cq + idx + 4); const float gk = ap->xattn_g[idx >> 10];
            u32x4 o; o.x = pk2(a0[0] * gk, a0[1] * gk); o.y = pk2(a0[2] * gk, a0[3] * gk); o.z = pk2(a1[0] * gk, a1[1] * gk); o.w = pk2(a1[2] * gk, a1[3] * gk); *(u32x4*)(Wcq_t + idx) = o; }
        for (int rm_ = 0; rm_ < REPM; ++rm_) {
        rms_rows_stream(ap->x, ap->attn_g, H0, T, gw, NGW, lane);
        for (int it = (gw + 512) % NGW; it < NITEMS; it += NGW) {
            int r = it;
            if (r < I_WEFF) {
                const int cb = r >> 5, nb = r & 31, kk0 = cb * 32, g = kk0 >> 7, n0 = nb * 32, i = lane & 31, h = lane >> 5;
                const f32x4* wp4 = (const f32x4*)(ap->w_pool + (size_t)(kk0 + i) * 128 + 64 * h); const f32x4* sc4 = (const f32x4*)(ap->pool_scale + g * 128 + 64 * h);
                const float* wo = ap->w_out + (size_t)(g * 128 + 64 * h) * 1024 + n0 + i;
                f32x4 av[16]; float bvv[64];
#pragma unroll
                for (int q = 0; q < 16; ++q) av[q] = wp4[q] * sc4[q];
#pragma unroll
                for (int s2 = 0; s2 < 64; ++s2) bvv[s2] = wo[(size_t)s2 * 1024];
                f32x16 accw;
#pragma unroll
                for (int q = 0; q < 16; ++q) accw[q] = 0.f;
#pragma unroll
                for (int s2 = 0; s2 < 64; ++s2) accw = __builtin_amdgcn_mfma_f32_32x32x2f32(av[s2 >> 2][s2 & 3], bvv[s2], accw, 0, 0, 0);
                bf16_t* op = Wout_t + (size_t)(n0 + i) * 1024 + kk0 + 4 * h;
#pragma unroll
                for (int r4 = 0; r4 < 4; ++r4) { u32x2 w; w.x = pk2(accw[4 * r4 + 0], accw[4 * r4 + 1]); w.y = pk2(accw[4 * r4 + 2], accw[4 * r4 + 3]); *(u32x2*)(op + 8 * r4) = w; }
                continue; } r -= I_WEFF;
            if (r < I_WR) {
                const int idx = r * 64 + lane, k = idx >> 5, e = idx & 31; const float w = ap->w_router[idx] * ap->ffn_g[k];
                const unsigned hb = f2bf(w); const float wh = __builtin_bit_cast(float, hb << 16); const unsigned lb = f2bf(w - wh);
                bf16_t* wr = (bf16_t*)(ws + WS_WRH); wr[e * 1024 + k] = (bf16_t)hb; wr[32 * 1024 + e * 1024 + k] = (bf16_t)lb; continue; } r -= I_WR;
            {
                const int idx = r * 64 + lane, t = idx >> 3, i = idx & 7;
                const double inv_freq = exp2(-(double)i * (18.931568569324174 / 8.0));
                const double rev = (double)ap->pos[t] * inv_freq * 0.15915494309189535;
                const float fr = (float)(rev - floor(rev));
                cs[(size_t)idx * 2] = __builtin_amdgcn_cosf(fr); cs[(size_t)idx * 2 + 1] = __builtin_amdgcn_sinf(fr);
            }
        }
        }
        }
    }
    SEAM(0);
    if (TP_HI == 0) tp_acc = __builtin_amdgcn_s_memrealtime() - tp_lo;

    if (TP_LO == 1) tp_lo = __builtin_amdgcn_s_memrealtime();
    if (IN(1)) for (int rep_ = 0; rep_ < REPS(1); ++rep_) { PH_PTRS();
        { pg8::StaticOrder S; S.init(H0, Win_t, T, INW, D, D, G, bx); pg8::EpiInProj E{U, cs};
          pg8::gemm_phase<pg8::EpiInProj, pg8::StaticOrder, true, false, false>(lds, wave, 2 * D, 2 * D, 2 * D, S, E, KREPS(1)); }
    }
    SEAM(1);
    if (TP_HI == 1) tp_acc = __builtin_amdgcn_s_memrealtime() - tp_lo;

    if (TP_LO == 2) tp_lo = __builtin_amdgcn_s_memrealtime();
    if (IN(2)) for (int rep_ = 0; rep_ < REPS(2); ++rep_) { PH_PTRS();
        float d1 = (lane < 64) ? ap->lq1[lane] * ap->lk1[lane] : 0.f, d2 = ap->lq2[lane] * ap->lk2[lane];
        d1 = wave_sum(d1); d2 = wave_sum(d2);
        const float lam = expf(d1) - expf(d2) + 0.2f;
        for (int ra_ = 0; ra_ < REPA; ++ra_)
        for (int un = bx; un < 256; un += G) {
            const int bh = un >> 3, jp = un & 7;
            dattn::unit(lds, wave, U, CAT, ap->subln_g, lam, bh >> 2, bh & 3, jp);
            dattn::unit(lds, wave, U, CAT, ap->subln_g, lam, bh >> 2, bh & 3, 15 - jp);
        }
        for (int rb_ = 0; rb_ < REPB; ++rb_)
        for (int it = gw; it < T / 16; it += NGW) {
            const int b = it >> 7, t0 = (it & 127) * 16, g = lane >> 4, wnd = 2 << g;
            const bf16_t* up = U + ((size_t)b * SEQ + t0) * INW + lane * 8;
            u32x4 rows[32];
#pragma unroll
            for (int i = 0; i < 32; ++i) { if (i >= 16 || t0 > 0) rows[i] = *(const u32x4*)(up + (ptrdiff_t)(i - 16) * INW); else rows[i] = (u32x4){0u, 0u, 0u, 0u}; }
#define PL_ADD(a, r, sgn) do { a[0] += sgn __builtin_bit_cast(float, (r).x << 16); a[1] += sgn __builtin_bit_cast(float, (r).x & 0xffff0000u); a[2] += sgn __builtin_bit_cast(float, (r).y << 16); a[3] += sgn __builtin_bit_cast(float, (r).y & 0xffff0000u); \
            a[4] += sgn __builtin_bit_cast(float, (r).z << 16); a[5] += sgn __builtin_bit_cast(float, (r).z & 0xffff0000u); a[6] += sgn __builtin_bit_cast(float, (r).w << 16); a[7] += sgn __builtin_bit_cast(float, (r).w & 0xffff0000u); } while (0)
            float sacc[8];
#pragma unroll
            for (int q = 0; q < 8; ++q) sacc[q] = 0.f;
#pragma unroll
            for (int jj = 1; jj < 16; ++jj) { const u32x4 r = rows[16 - jj] & ((jj < wnd) ? 0xffffffffu : 0u); PL_ADD(sacc, r, +); }
            const unsigned mk0 = (g == 0) ? 0xffffffffu : 0u, mk1 = (g == 1) ? 0xffffffffu : 0u, mk2 = (g == 2) ? 0xffffffffu : 0u, mk3 = (g == 3) ? 0xffffffffu : 0u;
            bf16_t* op = CAT + ((size_t)b * SEQ + t0) * D + lane * 8;
#pragma unroll
            for (int tt = 0; tt < 16; ++tt) {
                PL_ADD(sacc, rows[16 + tt], +);
                float cur[8];
#pragma unroll
                for (int q = 0; q < 8; ++q) cur[q] = 0.f;
                PL_ADD(cur, rows[16 + tt], +);
                const int t = t0 + tt; const float ic = 1.0f / (float)((t + 1 < wnd) ? t + 1 : wnd);
                u32x4 o4; o4.x = pk2(sacc[0] * ic - cur[0], sacc[1] * ic - cur[1]); o4.y = pk2(sacc[2] * ic - cur[2], sacc[3] * ic - cur[3]);
                o4.z = pk2(sacc[4] * ic - cur[4], sacc[5] * ic - cur[5]); o4.w = pk2(sacc[6] * ic - cur[6], sacc[7] * ic - cur[7]);
                *(u32x4*)(op + (size_t)tt * D) = o4;
                const u32x4 lv = (rows[16 + tt - 1] & mk0) | (rows[16 + tt - 3] & mk1) | (rows[16 + tt - 7] & mk2) | (rows[16 + tt - 15] & mk3);
                PL_ADD(sacc, lv, -);
            }
#undef PL_ADD
        }
    }
    SEAM(2);
    if (TP_HI == 2) tp_acc = __builtin_amdgcn_s_memrealtime() - tp_lo;

    if (TP_LO == 3) tp_lo = __builtin_amdgcn_s_memrealtime();
    if (IN(3)) for (int rep_ = 0; rep_ < REPS(3); ++rep_) { PH_PTRS();
        if ((bx & 1) == 0) CONV_CHUNK(0);
        pg8::StaticOrder S; S.init(CAT, Wout_t, T, D, D, D, G, bx); pg8::EpiRes<true, true> E{ap->x, X1B, X1F8, ssp, 1.0f};
        pg8::gemm_phase<pg8::EpiRes<true, true>, pg8::StaticOrder, true, false, false>(lds, wave, 2 * D, 2 * D, 2 * D, S, E, KREPS(3));
        for (int pu = bx; pu < 256; pu += G) {
        if (pu < 128) { const int bh = pu >> 2, pn = pu & 3, b = bh >> 2, h = bh & 3;
            pg8::SingleUnit S2; S2.u = pg8::Unit{bh, pn, 0, 0, 256, 0, (const char*)(KC + (size_t)b * 256 * 2048 + h * 256), (const char*)(Wcq_t + (size_t)pn * 256 * D + h * 256)};
            pg8::EpiTile<true> E2{QC, D, nullptr, 4.0f};
            pg8::gemm_phase<pg8::EpiTile<true>, pg8::SingleUnit, false, false, false>(lds, wave, 2 * 256, 2 * 2048, 2 * D, S2, E2, KREPS(3));
        } else { const int l = pu - 128, bh = l >> 2, pm4 = l & 3, b = bh >> 2, h = bh & 3;
            pg8::SingleUnit S2; S2.u = pg8::Unit{b * 4 + pm4, h, 0, 0, 256, 0, (const char*)(Wco_t + (size_t)pm4 * 256 * D + h * 256), (const char*)(KC + (size_t)b * 256 * 2048 + 1024 + h * 256)};
            pg8::EpiTile<true> E2{OC, D, nullptr, 4.0f};
            pg8::gemm_phase<pg8::EpiTile<true>, pg8::SingleUnit, false, false, false>(lds, wave, 2 * 256, 2 * D, 2 * 2048, S2, E2, KREPS(3));
        }
        }
        if ((bx & 1) != 0) CONV_CHUNK(0);
    }
    SEAM(3);
    if (TP_HI == 3) tp_acc = __builtin_amdgcn_s_memrealtime() - tp_lo;

    if (TP_LO == 4) tp_lo = __builtin_amdgcn_s_memrealtime();
    if (IN(4)) for (int rep_ = 0; rep_ < REPS(4); ++rep_) { PH_PTRS();
        LAS float* rs = (LAS float*)(lds + XTAB_OFF);
        if ((bx & 1) != 0) CONV_CHUNK(1);
        for (int un = bx; un < 256; un += G) {
            const int pm = un >> 2, h = un & 3, b = pm >> 3;
            if (tid < 256) { const int row = pm * 256 + tid; float s = 0.f;
#pragma unroll
                for (int p = 0; p < 16; ++p) s += ssp[(size_t)p * T + row];
                rs[tid] = 1.0f / sqrtf(s * (1.0f / D) + EPS); }
            __syncthreads();
            { LAS int* ent = (LAS int*)(lds + XE_OFF); LAS int* tk = (LAS int*)(lds + TOKT_OFF);
              if (tid == 0) { ent[0] = pm; ent[1] = h; ent[4] = -1; } if (tid < 256) tk[tid] = pm * 256 + tid;
              __syncthreads();
              pg8::LdsOrder S; S.ent = ent; S.tokt = tk; S.Abase = (const char*)X1F8; S.Bbase = (const char*)QC; S.btile = (size_t)256 * D; S.bbatch = (size_t)4 * 256 * D; S.rowbytes = D;
              pg8::EpiSoftmax E{PC, D, rs, QSCALE_X * 0.25f};
              pg8::gemm_phase<pg8::EpiSoftmax, pg8::LdsOrder, false, true, true>(lds, wave, D, D, D, S, E, KREPS(4)); }
            __syncthreads();
        }
        if ((bx & 1) == 0) CONV_CHUNK(1);
    }
    SEAM(4);
    if (TP_HI == 4) tp_acc = __builtin_amdgcn_s_memrealtime() - tp_lo;

    if (TP_LO == 5) tp_lo = __builtin_amdgcn_s_memrealtime();
    if (IN(5)) for (int rep_ = 0; rep_ < REPS(5); ++rep_) { PH_PTRS();
        if ((bx & 1) == 0) CONV_CHUNK(2);
        pg8::StaticOrder S0; S0.init(PC, OC, T, D, D, D, G, bx); pg8::EpiRes<false, true> E{X1B, X2H, (unsigned char*)X2B, nullptr, 1.0f / 1024.0f};
        LAS int* ent = (LAS int*)(lds + XE_OFF); LAS int* tk = (LAS int*)(lds + TOKT_OFF);
        { pg8::Unit u0; int n = 0; for (; n < 4 && S0.next(n, u0); ++n) { if (tid == 0) { ent[4 * n] = u0.pm; ent[4 * n + 1] = u0.pn; } if (tid < 256) tk[n * 256 + tid] = u0.pm * 256 + tid; } if (tid == 0) ent[4 * n] = -1; }
        __syncthreads();
        pg8::LdsOrder S; S.ent = ent; S.tokt = tk; S.Abase = (const char*)PC; S.Bbase = (const char*)OC; S.btile = (size_t)256 * D; S.bbatch = (size_t)1024 * 1024; S.rowbytes = D;
        pg8::gemm_phase<pg8::EpiRes<false, true>, pg8::LdsOrder, true, true, true>(lds, wave, D, D, D, S, E, KREPS(5));
        if ((bx & 1) != 0) CONV_CHUNK(2);
    }
    SEAM(5);
    if (TP_HI == 5) tp_acc = __builtin_amdgcn_s_memrealtime() - tp_lo;

    if (TP_LO == 6) tp_lo = __builtin_amdgcn_s_memrealtime();
    if (IN(6)) for (int rep_ = 0; rep_ < REPS(6); ++rep_) { PH_PTRS();
        LAS int* lcnt = (LAS int*)(lds + RT_OFF);
        LAS int* sel = (LAS int*)(lds + RT_OFF + 512);
        LAS float* selg = (LAS float*)(lds + RT_OFF + 512 + 1024);
        const int wave_ = __builtin_amdgcn_readfirstlane(tid >> 6);
        const bf16_t* WRH = (const bf16_t*)(ws + WS_WRH);
        for (int tb = bx; tb < T / 64; tb += G) {
            if (tid < 32) lcnt[tid] = 0;
            const int tile = wave_ >> 2, kq = wave_ & 3, r32 = lane & 31, h = lane >> 5;
            const bf16_t* xp = X2H + (size_t)(tb * 64 + tile * 32 + r32) * D + kq * 256 + 8 * h;
            const bf16_t* wp = WRH + (size_t)r32 * 1024 + kq * 256 + 8 * h;
            f32x16 accr;
#pragma unroll
            for (int r = 0; r < 16; ++r) accr[r] = 0.f;
            float ss = 0.f;
            bf16x8 xa[16];
#pragma unroll
            for (int s = 0; s < 16; ++s) xa[s] = *(const bf16x8*)(xp + 16 * s);
#pragma unroll
            for (int s = 0; s < 16; ++s) { const bf16x8 bh_ = *(const bf16x8*)(wp + 16 * s), bl_ = *(const bf16x8*)(wp + 32 * 1024 + 16 * s);
                accr = __builtin_amdgcn_mfma_f32_32x32x16_bf16(xa[s], bh_, accr, 0, 0, 0);
                accr = __builtin_amdgcn_mfma_f32_32x32x16_bf16(xa[s], bl_, accr, 0, 0, 0);
#pragma unroll
                for (int j = 0; j < 8; ++j) { const float f = bf2f((unsigned short)xa[s][j]); ss += f * f; } }
            ss += __shfl_xor(ss, 32);
            __syncthreads();
            LAS float* PT = (LAS float*)lds + wave_ * (32 * 33);
            LAS float* PSS = (LAS float*)lds + 8 * 32 * 33;
#pragma unroll
            for (int r = 0; r < 16; ++r) PT[((r & 3) + 8 * (r >> 2) + 4 * h) * 33 + r32] = accr[r];
            if (h == 0) PSS[wave_ * 32 + r32] = ss;
            __syncthreads();
            if (tid < 64) {
                const int tl = tid & 31, tok = tb * 64 + tid; const LAS float* p0 = (LAS float*)lds + ((tid >> 5) * 4) * (32 * 33) + tl * 33; const LAS float* q0 = PSS + (tid >> 5) * 128 + tl;
                const float sq = (q0[0] + q0[32]) + (q0[64] + q0[96]);
                const float rstd = 1.0f / sqrtf(sq * (1.0f / D) + EPS);
                rstd2[tok] = rstd;
                float b0 = -INFINITY, b1 = -INFINITY, b2 = -INFINITY, b3 = -INFINITY; int i0 = 0, i1 = 0, i2 = 0, i3 = 0;
                for (int e = 0; e < 32; ++e) {
                    const float lg = ((p0[e] + p0[32 * 33 + e]) + (p0[2 * 32 * 33 + e] + p0[3 * 32 * 33 + e])) * rstd + ap->b_router[e];
                    if (lg > b3) { b3 = lg; i3 = e;
                        if (b3 > b2) { const float tf = b2; b2 = b3; b3 = tf; const int ti = i2; i2 = i3; i3 = ti; }
                        if (b2 > b1) { const float tf = b1; b1 = b2; b2 = tf; const int ti = i1; i1 = i2; i2 = ti; }
                        if (b1 > b0) { const float tf = b0; b0 = b1; b1 = tf; const int ti = i0; i0 = i1; i1 = ti; } }
                }
                const float e1 = expf(b1 - b0), e2 = expf(b2 - b0), e3 = expf(b3 - b0), isum = 1.0f / (1.0f + e1 + e2 + e3);
                int lr;
                lr = atomicAdd((int*)&lcnt[i0], 1); sel[tid * 4 + 0] = (i0 << 16) | lr; selg[tid * 4 + 0] = isum;
                lr = atomicAdd((int*)&lcnt[i1], 1); sel[tid * 4 + 1] = (i1 << 16) | lr; selg[tid * 4 + 1] = e1 * isum;
                lr = atomicAdd((int*)&lcnt[i2], 1); sel[tid * 4 + 2] = (i2 << 16) | lr; selg[tid * 4 + 2] = e2 * isum;
                lr = atomicAdd((int*)&lcnt[i3], 1); sel[tid * 4 + 3] = (i3 << 16) | lr; selg[tid * 4 + 3] = e3 * isum;
            }
            __syncthreads();
            if (tid < 32) { const int c = lcnt[tid]; lcnt[32 + tid] = (c > 0) ? (int)atomicAdd(ctl + CW_CNT + tid, (unsigned)c) : 0; }
            __syncthreads();
            if (tid < 256) { const int tl = tid >> 2, tok = tb * 64 + tl, sv = sel[tid], ee = sv >> 16, pos = lcnt[32 + ee] + (sv & 0xffff);
                ltok[ee * CAP + pos] = tok; lgate[ee * CAP + pos] = selg[tid]; tokslot[tok * 4 + (tid & 3)] = (ee << 16) | pos; }
            __syncthreads();
        }
    }
    SEAM(6);
    if (TP_HI == 6) tp_acc = __builtin_amdgcn_s_memrealtime() - tp_lo;

    LAS int* ecnt = (LAS int*)(lds + ECNT_OFF);
    LAS int* etp = (LAS int*)(lds + ECNT_OFF + 128);
    LAS int* xe = (LAS int*)(lds + XE_OFF);
    LAS int* tokt = (LAS int*)(lds + TOKT_OFF);
    if (IN(7) || IN(8) || IN(9)) {
        __syncthreads();
        const int t_ = wave * 64 + lane_id();
        if (t_ < NE) ecnt[t_] = (int)__hip_atomic_load(ctl + CW_CNT + t_, __ATOMIC_RELAXED, __HIP_MEMORY_SCOPE_AGENT);
        __syncthreads();
        if (t_ < NE) { int acc = 0, mine = 0;
#pragma unroll
            for (int o = 0; o < NE; ++o) { const int n = (ecnt[o] + 255) >> 8; acc += (o < t_) ? n : 0; mine = (o == t_) ? n : mine; }
            etp[t_] = acc; if (t_ == NE - 1) etp[NE] = acc + mine; }
        __syncthreads();
        if (t_ < NE) { const int e = t_, n = etp[e + 1] - etp[e]; int rank = 0;
            for (int o = 0; o < NE; ++o) { const int no = etp[o + 1] - etp[o]; rank += (no > n || (no == n && o < e)) ? 1 : 0; }
            const int rnd = rank >> 3, p = rank & 7, x = (rnd & 1) ? 7 - p : p; xe[x * 4 + rnd] = e; }
        __syncthreads();
    }

    if (TP_LO == 7) tp_lo = __builtin_amdgcn_s_memrealtime();
    if (IN(7)) for (int rep_ = 0; rep_ < REPS(7); ++rep_) { PH_PTRS();
        pg8::MoeOrder S; S.ecnt = ecnt; S.etp = etp; S.xe = xe; S.tokt = tokt; S.x = bx & 7; S.cl = bx >> 3; S.nloc = G >> 3; S.npn = 8;
        S.Abase = (const char*)X2B; S.Bbase = (const char*)Wgu_t; S.b_expert = (size_t)2048 * 1024; S.rowbytes = D; S.b_rowbytes = D; S.gather = true;
        int last_pm = -1, prev_pm = -1;
        { pg8::Unit u;
          for (int i = 0; i < MAXU && S.next(i, u); ++i) { prev_pm = last_pm; last_pm = u.pm; if (tid < 256) tokt[i * 256 + tid] = (tid < u.nvalid) ? ltok[u.e * CAP + u.r * 256 + tid] : 0; } }
        __syncthreads();
        pg8::EpiSwiGLU E{(unsigned char*)HID, ap->b_gu, rstd2, tokt, &S, ctl + CW_FLAG};
        pg8::gemm_phase<pg8::EpiSwiGLU, pg8::MoeOrder, true, true, true>(lds, wave, D, D, D, S, E, KREPS(7));
        if (tid == 0) { if (prev_pm >= 0) (void)xb_add(ctl + CW_FLAG + (size_t)prev_pm * FLAG_STRIDE, 1u); if (last_pm >= 0) (void)xb_add(ctl + CW_FLAG + (size_t)last_pm * FLAG_STRIDE, 1u); }
    }
    if (!same_xcc) SEAM(7);
    if (TP_HI == 7) tp_acc = __builtin_amdgcn_s_memrealtime() - tp_lo;

    if (TP_LO == 8) tp_lo = __builtin_amdgcn_s_memrealtime();
    if (IN(8)) for (int rep_ = 0; rep_ < REPS(8); ++rep_) { PH_PTRS();
        pg8::MoeOrder S; S.ecnt = ecnt; S.etp = etp; S.xe = xe; S.tokt = tokt; S.x = bx & 7; S.cl = bx >> 3; S.nloc = G >> 3; S.npn = 4;
        S.Abase = (const char*)HID; S.Bbase = (const char*)Wdn_t; S.b_expert = (size_t)1024 * 1024; S.rowbytes = D; S.b_rowbytes = D; S.gather = true;
        { int n7 = 0;
          for (int k = 0; k < 4; ++k) { const int e = xe[S.x * 4 + k]; n7 += (etp[e + 1] - etp[e]) * 8; }
          S.cl = __builtin_amdgcn_readfirstlane((S.cl + S.nloc - n7 % S.nloc) % S.nloc); }
        { pg8::Unit u;
          for (int i = 0; i < MAXU && S.next(i, u); ++i) if (tid < 256) tokt[i * 256 + tid] = u.pm * 256 + tid; }
        __syncthreads();
        { pg8::Unit u; for (int i = 0; i < 2 && S.next(i, u); ++i) hid_wait(ctl + CW_FLAG, u.pm); }
        pg8::EpiDown E{(unsigned char*)YR, ap->b_down, lgate, &S, ctl + CW_FLAG};
        pg8::gemm_phase<pg8::EpiDown, pg8::MoeOrder, true, true, true>(lds, wave, D, D, D, S, E, KREPS(8));
    }
    SEAM(8);
    if (TP_HI == 8) tp_acc = __builtin_amdgcn_s_memrealtime() - tp_lo;

    if (TP_LO == 9) tp_lo = __builtin_amdgcn_s_memrealtime();
    if (IN(9)) for (int rep_ = 0; rep_ < REPS(9); ++rep_) { PH_PTRS();
        for (int tok = gw; tok < T; tok += NGW) {
            int rowk[4];
#pragma unroll
            for (int k = 0; k < 4; ++k) { const int sv = tokslot[tok * 4 + k], ee = sv >> 16; rowk[k] = etp[ee] * 256 + (sv & 0xffff); }
            float v[2][8]; float s = 0.f;
            u32x4 xa[2]; u32x2 yv[2][4];
#pragma unroll
            for (int c = 0; c < 2; ++c) { xa[c] = *((const u32x4*)(X2H + (size_t)tok * D + 512 * c) + lane);
#pragma unroll
                for (int k = 0; k < 4; ++k) yv[c][k] = __builtin_nontemporal_load((const u32x2*)((const unsigned char*)YR + (size_t)rowk[k] * 1024 + 512 * c) + lane); }
#pragma unroll
            for (int c = 0; c < 2; ++c) {
                v[c][0] = __builtin_bit_cast(float, xa[c].x << 16); v[c][1] = __builtin_bit_cast(float, xa[c].x & 0xffff0000u); v[c][2] = __builtin_bit_cast(float, xa[c].y << 16); v[c][3] = __builtin_bit_cast(float, xa[c].y & 0xffff0000u);
                v[c][4] = __builtin_bit_cast(float, xa[c].z << 16); v[c][5] = __builtin_bit_cast(float, xa[c].z & 0xffff0000u); v[c][6] = __builtin_bit_cast(float, xa[c].w << 16); v[c][7] = __builtin_bit_cast(float, xa[c].w & 0xffff0000u);
                float ys[8];
#pragma unroll
                for (int q = 0; q < 8; ++q) ys[q] = 0.f;
#pragma unroll
                for (int k = 0; k < 4; ++k)
#pragma unroll
                    for (int q = 0; q < 2; ++q) { const int w_ = (int)yv[c][k][q]; const f32x2 lo = __builtin_amdgcn_cvt_pk_f32_fp8(w_, false), hi2 = __builtin_amdgcn_cvt_pk_f32_fp8(w_, true);
                        ys[4 * q + 0] += lo[0]; ys[4 * q + 1] += lo[1]; ys[4 * q + 2] += hi2[0]; ys[4 * q + 3] += hi2[1]; }
#pragma unroll
                for (int q = 0; q < 8; ++q) { v[c][q] += ys[q] * 0.0625f; s += v[c][q] * v[c][q]; }
            }
            const float rstd = 1.0f / sqrtf(wave_sum(s) * (1.0f / D) + EPS);
#pragma unroll
            for (int c = 0; c < 2; ++c) { f32x4* op = (f32x4*)(ap->out + (size_t)tok * D + 512 * c) + 2 * lane; const f32x4* gr = (const f32x4*)(ap->final_g + 512 * c) + 2 * lane;
#pragma unroll
                for (int q = 0; q < 2; ++q) { const f32x4 gg = gr[q]; __builtin_nontemporal_store((f32x4){v[c][4 * q] * rstd * gg[0], v[c][4 * q + 1] * rstd * gg[1], v[c][4 * q + 2] * rstd * gg[2], v[c][4 * q + 3] * rstd * gg[3]}, op + q); } }
        }
    }
    if (TP_HI == 9) tp_acc = __builtin_amdgcn_s_memrealtime() - tp_lo;
    if (TP_HI >= 0 && bx == 0 && wave == 0) { const unsigned long long t0_ = __builtin_amdgcn_s_memrealtime(); while (__builtin_amdgcn_s_memrealtime() - t0_ < tp_acc) __builtin_amdgcn_s_sleep(8); }
#undef IN
#undef SEAM
}

extern "C" void kernel_launch(void* const* d_in, const int* in_sizes, int n_in, void* d_out, int out_size, void* d_ws, size_t ws_size, hipStream_t stream) {
    static int grid = 0;
    if (grid == 0) {
        if (n_in != 26 || in_sizes[0] != T * D || out_size != T * D || ws_size < WS_END) { fprintf(stderr, "kernel_launch: unexpected shapes (n_in %d, in0 %d, out %d, ws %zu); nothing launched\n", n_in, n_in > 0 ? in_sizes[0] : -1, out_size, ws_size); grid = -1; return; }
        int dev = 0, cus = 0, per_cu = 0;
        if (hipGetDevice(&dev) != hipSuccess || hipDeviceGetAttribute(&cus, hipDeviceAttributeMultiprocessorCount, dev) != hipSuccess) { grid = -1; return; }
        if (hipFuncSetAttribute((const void*)fwd_kernel, hipFuncAttributeMaxDynamicSharedMemorySize, LDS_BYTES) != hipSuccess) { fprintf(stderr, "kernel_launch: hipFuncSetAttribute failed\n"); grid = -1; return; }
        if (hipOccupancyMaxActiveBlocksPerMultiprocessor(&per_cu, (const void*)fwd_kernel, NWAVES * 64, LDS_BYTES) != hipSuccess || per_cu < 1) { fprintf(stderr, "kernel_launch: occupancy query says %d\n", per_cu); per_cu = 1; }
        (void)hipGetLastError();
        grid = cus;
    }
    if (grid < 0) return;
    (void)hipMemsetAsync((char*)d_ws + WS_CTL, 0, CTL_BYTES, stream);
    Args a{};
    a.x = (const float*)d_in[0]; a.pos = (const int*)d_in[1]; a.mem = (const float*)d_in[2]; a.attn_g = (const float*)d_in[3]; a.w_in = (const float*)d_in[4];
    a.w_pool = (const float*)d_in[5]; a.pool_scale = (const float*)d_in[6]; a.lq1 = (const float*)d_in[7]; a.lk1 = (const float*)d_in[8]; a.lq2 = (const float*)d_in[9];
    a.lk2 = (const float*)d_in[10]; a.subln_g = (const float*)d_in[11]; a.w_out = (const float*)d_in[12]; a.xattn_g = (const float*)d_in[13]; a.mem_g = (const float*)d_in[14];
    a.w_cq = (const float*)d_in[15]; a.w_ckv = (const float*)d_in[16]; a.w_co = (const float*)d_in[17]; a.ffn_g = (const float*)d_in[18]; a.w_router = (const float*)d_in[19];
    a.b_router = (const float*)d_in[20]; a.w_gu = (const float*)d_in[21]; a.b_gu = (const float*)d_in[22]; a.w_down = (const float*)d_in[23]; a.b_down = (const float*)d_in[24];
    a.final_g = (const float*)d_in[25]; a.out = (float*)d_out; a.ws = (unsigned char*)d_ws;
    if (MK_N_LAUNCHES == 1) {
        a.ph_lo = 0; a.ph_hi = N_PHASES;
        void* args[] = {&a};
        hipError_t e = hipLaunchCooperativeKernel((const void*)fwd_kernel, dim3(grid), dim3(NWAVES * 64), args, LDS_BYTES, stream);
        if (e != hipSuccess) fprintf(stderr, "kernel_launch: cooperative launch failed: %s (grid %d)\n", hipGetErrorString(e), grid);
    } else {
        for (int p = 0; p < N_PHASES; ++p) { a.ph_lo = p; a.ph_hi = p + 1; hipLaunchKernelGGL(fwd_kernel, dim3(grid), dim3(NWAVES * 64), LDS_BYTES, stream, a); }
    }
}
```

```cpp
#include <hip/hip_runtime.h>
#include <cstdio>
#include <cstdint>

#ifndef MK_N_LAUNCHES
#define MK_N_LAUNCHES 1
#endif

#ifndef REPMASK
#define REPMASK 0
#endif
#define REPS(k) (((REPMASK >> (k)) & 1) ? 2 : 1)
#ifndef TP_LO
#define TP_LO -1
#endif
#ifndef TP_HI
#define TP_HI -1
#endif
#ifndef REPM
#define REPM 1
#endif
#ifndef REPC
#define REPC 1
#endif
#ifndef REPA
#define REPA 1
#endif
#ifndef REPB
#define REPB 1
#endif
#ifndef KREPMASK
#define KREPMASK 0
#endif
#define KREPS(k) (((KREPMASK >> (k)) & 1) ? 2 : 1)
#ifndef EPIREP_SW
#define EPIREP_SW 1
#endif
#ifndef EPIREP_DN
#define EPIREP_DN 1
#endif
#ifndef PMASK
#define PMASK 0x3ff
#endif
#define LAS __attribute__((address_space(3)))
#define GAS __attribute__((address_space(1)))

typedef unsigned short bf16_t;
typedef short bf16x8 __attribute__((ext_vector_type(8)));
typedef short s16x4 __attribute__((ext_vector_type(4)));
typedef float f32x4 __attribute__((ext_vector_type(4)));
typedef float f32x2 __attribute__((ext_vector_type(2)));
typedef float f32x16 __attribute__((ext_vector_type(16)));
typedef unsigned u32x4 __attribute__((ext_vector_type(4)));
typedef unsigned u32x2 __attribute__((ext_vector_type(2)));
typedef int i32x4 __attribute__((ext_vector_type(4)));
typedef int i32x8 __attribute__((ext_vector_type(8)));

constexpr int NB = 8, SEQ = 2048, T = NB * SEQ, D = 1024, INW = 2048, MEM = 256, NMEM = NB * MEM;
constexpr int NE = 32, TOPK = 4, CAP = 16384, MAXRT = 288;
constexpr float EPS = 1e-5f;
constexpr float LOG2E = 1.4426950408889634f;
constexpr float QSCALE_D = 0.125f * LOG2E;
constexpr float QSCALE_X = 0.0625f * LOG2E;

constexpr size_t MiB = 1u << 20;
constexpr size_t WS_CTL = 0, CTL_BYTES = 128 * 1024;
constexpr size_t WS_CS = 1 * MiB;
constexpr size_t WS_SSP = 2 * MiB;
constexpr size_t WS_RSTD2 = 3 * MiB;
constexpr size_t WS_TOKSLOT = 3 * MiB + 256 * 1024;
constexpr size_t WS_LTOK = 4 * MiB;
constexpr size_t WS_LGATE = 6 * MiB;
constexpr size_t WS_WIN = 8 * MiB;
constexpr size_t WS_WOUT = 12 * MiB;
constexpr size_t WS_WCQ = 14 * MiB;
constexpr size_t WS_WCKV = 16 * MiB;
constexpr size_t WS_WCO = 20 * MiB;
constexpr size_t WS_WRH = 22 * MiB;
constexpr size_t WS_WGU = 24 * MiB;
constexpr size_t WS_WDN = 152 * MiB;
constexpr size_t WS_H0 = 216 * MiB;
constexpr size_t WS_MEMN = 248 * MiB;
constexpr size_t WS_KC = 252 * MiB;
constexpr size_t WS_VT = 256 * MiB;
constexpr size_t WS_U = 260 * MiB;
constexpr size_t WS_CAT = 324 * MiB;
constexpr size_t WS_X1 = 356 * MiB;
constexpr size_t WS_X1B = 420 * MiB;
constexpr size_t WS_QC = 452 * MiB;
constexpr size_t WS_PC = 484 * MiB;
constexpr size_t WS_OC = 516 * MiB;
constexpr size_t WS_X2 = 548 * MiB;
constexpr size_t WS_X2B = 612 * MiB;
constexpr size_t WS_HID = 644 * MiB;
constexpr size_t WS_Y = 788 * MiB;
constexpr size_t WS_END = 932 * MiB;
constexpr int CW_CNT = 64;
constexpr int CW_BAR = 4096;
constexpr int CW_XCC = 512;
constexpr int CW_FLAG = 8192, FLAG_STRIDE = 64;
static_assert((size_t)(CW_FLAG + MAXRT * FLAG_STRIDE) * 4 <= CTL_BYTES, "control words");

constexpr int RING_BYTES = 131072;
constexpr int XTAB_OFF = RING_BYTES;
constexpr int ECNT_OFF = RING_BYTES + 1024;
constexpr int RT_OFF = RING_BYTES + 1536;
constexpr int MISC_OFF = RING_BYTES + 4096;
static_assert(RT_OFF + 2560 <= MISC_OFF, "LDS map");
constexpr int XE_OFF = MISC_OFF + 128;
constexpr int TOKT_OFF = MISC_OFF + 512;
constexpr int MAXU = 24;
constexpr int LDS_BYTES = 163840;
static_assert(TOKT_OFF + MAXU * 1024 <= LDS_BYTES, "LDS map");

#define LDS_WAIT() asm volatile("s_waitcnt lgkmcnt(0)" ::: "memory")
#define VM_WAIT() asm volatile("s_waitcnt vmcnt(0)" ::: "memory")
__device__ __forceinline__ unsigned f2bf(float f) { unsigned u = __builtin_bit_cast(unsigned, f); return (u + 0x7fffu + ((u >> 16) & 1u)) >> 16; }
__device__ __forceinline__ unsigned pk2(float lo, float hi) { return f2bf(lo) | (f2bf(hi) << 16); }
__device__ __forceinline__ float bf2f(unsigned short v) { return __builtin_bit_cast(float, (unsigned)v << 16); }
__device__ __forceinline__ unsigned cvt_pk_bf16(float lo, float hi) { unsigned r; asm volatile("v_cvt_pk_bf16_f32 %0, %1, %2" : "=v"(r) : "v"(lo), "v"(hi)); return r; }
__device__ __forceinline__ unsigned pk4_fp8(float a, float b, float c, float d) { int w = __builtin_bit_cast(int, a); w = __builtin_amdgcn_cvt_pk_fp8_f32(a, b, w, false);      w = __builtin_amdgcn_cvt_pk_fp8_f32(c, d, w, true); return (unsigned)w; }
__device__ __forceinline__ int lane_id() { int l; asm volatile("v_mbcnt_lo_u32_b32 %0, -1, 0\n\tv_mbcnt_hi_u32_b32 %0, -1, %0" : "=v"(l)); return l; }
__device__ __forceinline__ float wave_sum(float v) {
#pragma unroll
    for (int o = 1; o < 64; o <<= 1) v += __shfl_xor(v, o);
    return v;
}

#define XB_TMO      128
#define XB_XCNT(j)  (256  + 64 * (j))
#define XB_XSUB(j)  (1280 + 64 * (j))
#define XB_XGEN(j)  (2304 + 64 * (j))
#define XB_TOP      3328
#define XB_TOPGEN   3392
#define XCD_BAR_WORDS 3456
#define XB_SPIN_CAP (1u << 18)
__device__ __forceinline__ unsigned xb_ld(unsigned* p)              { return __hip_atomic_load(p, __ATOMIC_RELAXED, __HIP_MEMORY_SCOPE_AGENT); }
__device__ __forceinline__ unsigned xb_add(unsigned* p, unsigned v) { return __hip_atomic_fetch_add(p, v, __ATOMIC_RELAXED, __HIP_MEMORY_SCOPE_AGENT); }
__device__ __forceinline__ unsigned xb_xcc_id() { return (unsigned)__builtin_amdgcn_s_getreg((3 << 11) | 20) & 0xFu; }
#define XB_SPIN(cond, bar) do { unsigned _sp = 0; while (cond) { __builtin_amdgcn_s_sleep(1); \
    if ((++_sp & 255u) == 0u) { if (xb_ld(&(bar)[XB_TMO])) break; if (_sp > XB_SPIN_CAP) { atomicAdd(&(bar)[XB_TMO], 1u); break; } } } } while (0)
struct XcdBarrier { unsigned* bar; unsigned x; volatile LAS unsigned* st; };
__device__ __forceinline__ XcdBarrier xcd_barrier_post(unsigned* bar, volatile LAS unsigned* st, int tid) {
    XcdBarrier b; b.bar = bar; b.x = xb_xcc_id(); b.st = st;
    if (tid == 0) (void)xb_add(&bar[XB_XCNT(b.x)], 1u);
    return b;
}
__device__ __forceinline__ void xcd_barrier_complete(unsigned* bar, unsigned x, unsigned& nloc, unsigned& nx) {
    const unsigned G = gridDim.x * gridDim.y * gridDim.z;
    unsigned sum, cnt, mine, sp = 0u;
    for (;;) {
        sum = 0u; cnt = 0u; mine = 0u;
#pragma unroll
        for (unsigned j = 0; j < 16; ++j) { const unsigned c = xb_ld(&bar[XB_XCNT(j)]); sum += c; cnt += (c > 0u) ? 1u : 0u; mine = (j == x) ? c : mine; }
        if (sum == G) break;
        __builtin_amdgcn_s_sleep(1);
        if ((++sp & 255u) == 0u) { if (xb_ld(&bar[XB_TMO])) break; if (sp > XB_SPIN_CAP) { atomicAdd(&bar[XB_TMO], 1u); break; } }
    }
    nloc = mine > 0u ? mine : 1u; nx = cnt > 0u ? cnt : 1u;
}
__device__ __forceinline__ void xcd_barrier(const XcdBarrier& b, int tid) {
    asm volatile("s_waitcnt vmcnt(0)" ::: "memory");
    __syncthreads();
    if (tid == 0) {
        unsigned* bar = b.bar;
        __builtin_amdgcn_s_waitcnt(0);
        unsigned nloc = b.st[0], nx = b.st[1];
        if (nloc == 0u) { xcd_barrier_complete(bar, b.x, nloc, nx); b.st[0] = nloc; b.st[1] = nx; }
        const unsigned old = xb_add(&bar[XB_XSUB(b.x)], 1u);
        const unsigned gen = old / nloc;
        if (old + 1u == (gen + 1u) * nloc) {
            __builtin_amdgcn_fence(__ATOMIC_RELEASE, "agent");
            asm volatile("s_waitcnt vmcnt(0)" ::: "memory");
            const unsigned og = xb_add(&bar[XB_TOP], 1u);
            const unsigned tg = og / nx;
            if (og + 1u == (tg + 1u) * nx) xb_add(&bar[XB_TOPGEN], 1u);
            else XB_SPIN(xb_ld(&bar[XB_TOPGEN]) == tg, bar);
            __builtin_amdgcn_fence(__ATOMIC_ACQUIRE, "agent");
            xb_add(&bar[XB_XGEN(b.x)], 1u);
            asm volatile("s_waitcnt vmcnt(0)" ::: "memory");
        } else {
            XB_SPIN(xb_ld(&bar[XB_XGEN(b.x)]) == gen, bar);
            __builtin_amdgcn_fence(__ATOMIC_ACQUIRE, "agent");
            asm volatile("s_waitcnt vmcnt(0)" ::: "memory");
        }
    }
    __syncthreads();
}
__device__ __forceinline__ void hid_wait(unsigned* flags, int pm) {
    unsigned* f = flags + (size_t)pm * FLAG_STRIDE; unsigned sp = 0u;
    while (xb_ld(f) < 8u) { __builtin_amdgcn_s_sleep(1); if (++sp > XB_SPIN_CAP) break; }
}
__device__ __forceinline__ void wg_global_sync(int tid) {
    asm volatile("s_waitcnt vmcnt(0)" ::: "memory");
    __syncthreads();
    if (tid == 0) { __builtin_amdgcn_fence(__ATOMIC_ACQUIRE, "agent"); asm volatile("s_waitcnt vmcnt(0)" ::: "memory"); }
    __syncthreads();
}

namespace pg8 {
constexpr int BM = 256, BK = 64, HALF = 128, HTB = HALF * BK * 2, STAGE_BYTES = 8 * HTB, NXCD = 8, WGM = 8;
__host__ __device__ __forceinline__ int lds_byte(int r, int c) { const int st = (r >> 4) * 2 + (c >> 5), rr = r & 15, cc = c & 31, ob = rr * 64 + cc * 2; return st * 1024 + (ob ^ (((ob >> 9) & 1) << 5)); }
__host__ __device__ __forceinline__ void stage_rc(int b, int& R, int& C) { const int st = b / 1024, sb = b % 1024, swz = sb ^ (((sb >> 9) & 1) << 5); R = (st >> 1) * 16 + swz / 64; C = (st & 1) * 32 + (swz % 64) / 2; }
__host__ __device__ __forceinline__ int perm32(int rho) { const int n = rho >> 4, i = rho & 15; return 8 * (i >> 2) + 4 * n + (i & 3); }

struct Unit { int pm, pn, e, r, nvalid, ui; const char* pa; const char* pb; };

struct StaticOrder {
    int nM, nN, nwg, G, c; const char* A; const char* Bt; size_t atile, btile, bbatch = 0;
    __device__ void init(const void* A_, const void* Bt_, int M, int N, int lda, int ldb, int G_, int c_) { nM = M / BM; nN = N / BM; nwg = nM * nN; G = G_; c = c_; A = (const char*)A_; Bt = (const char*)Bt_; atile = (size_t)BM * lda * 2; btile = (size_t)BM * ldb * 2; }
    __device__ __forceinline__ bool next(int i, Unit& u) const {
        const long L = (long)i * G + c; if (L >= nwg) return false;
        int wgid = (int)L; { const int q = nwg / NXCD, r = nwg % NXCD, xcd = wgid % NXCD, off = wgid / NXCD; wgid = (xcd < r ? xcd * (q + 1) : r * (q + 1) + (xcd - r) * q) + off; }
        const int nig = WGM * nN, gid = wgid / nig, fm = gid * WGM, gsz = (nM - fm) < WGM ? (nM - fm) : WGM;
        u.pm = fm + ((wgid % nig) % gsz); u.pn = (wgid % nig) / gsz; u.e = 0; u.r = 0; u.nvalid = 256; u.ui = i;
        u.pa = A + (size_t)u.pm * atile; u.pb = Bt + (size_t)u.pn * btile + (size_t)(u.pm >> 3) * bbatch; return true;
    }
    __device__ __forceinline__ unsigned row_off(const Unit&, int) const { return 0u; }
};
struct KvOrder {
    const char* memn; const char* wkv; int G, c;
    __device__ __forceinline__ bool next(int i, Unit& u) const {
        const int L = i * G + c; if (L >= 64) return false;
        u.r = 0; u.nvalid = 256; u.ui = i;
        if (L < 32) { u.e = 0; u.pm = L >> 2; u.pn = L & 3; u.pa = memn + (size_t)u.pm * 256 * 2048; u.pb = wkv + (size_t)u.pn * 256 * 2048; }
        else { const int l = L - 32; u.e = 1; u.pm = l >> 3; u.pn = l & 7; u.pa = wkv + (size_t)(1024 + u.pm * 256) * 2048; u.pb = memn + (size_t)u.pn * 256 * 2048; }
        return true;
    }
    __device__ __forceinline__ unsigned row_off(const Unit&, int) const { return 0u; }
};
struct LdsOrder {
    const LAS int* ent; const LAS int* tokt; const char* Abase; const char* Bbase; size_t btile, bbatch; unsigned rowbytes;
    __device__ __forceinline__ bool next(int i, Unit& u) const {
        const int pm = __builtin_amdgcn_readfirstlane(ent[4 * i]); if (pm < 0) return false;
        const int pn = __builtin_amdgcn_readfirstlane(ent[4 * i + 1]);
        u.pm = pm; u.pn = pn; u.e = 0; u.r = 0; u.nvalid = 256; u.ui = i; u.pa = Abase; u.pb = Bbase + (size_t)pn * btile + (size_t)(pm >> 3) * bbatch; return true;
    }
    __device__ __forceinline__ unsigned row_off(const Unit& uu, int r) const { return (unsigned)tokt[uu.ui * 256 + r] * rowbytes; }
};
struct SingleUnit {
    Unit u;
    __device__ __forceinline__ bool next(int i, Unit& o) const { if (i != 0) return false; o = u; return true; }
    __device__ __forceinline__ unsigned row_off(const Unit&, int) const { return 0u; }
};
struct MoeOrder {
    const LAS int* ecnt; const LAS int* etp; const LAS int* xe; const LAS int* tokt;
    int x, cl, nloc, npn; const char* Abase; const char* Bbase; size_t b_expert; unsigned rowbytes, b_rowbytes; bool gather;
    __device__ __forceinline__ bool next(int i, Unit& u) const {
        int j = i * nloc + cl;
        for (int k = 0; k < 4; ++k) { const int e = __builtin_amdgcn_readfirstlane(xe[x * 4 + k]), tp0 = __builtin_amdgcn_readfirstlane(etp[e]), nrt = __builtin_amdgcn_readfirstlane(etp[e + 1]) - tp0, n = nrt * npn;
            if (j < n) { const int pn = __builtin_amdgcn_readfirstlane(j / nrt), r = j - pn * nrt; u.pm = tp0 + r; u.pn = pn; u.e = e; u.r = r; u.nvalid = min(256, __builtin_amdgcn_readfirstlane(ecnt[e]) - r * 256); u.ui = i;
                u.pa = gather ? Abase : Abase + (size_t)u.pm * 256 * rowbytes; u.pb = Bbase + (size_t)e * b_expert + (size_t)pn * 256 * b_rowbytes; return true; }
            j -= n; }
        return false;
    }
    __device__ __forceinline__ unsigned row_off(const Unit& uu, int r) const { return (unsigned)tokt[uu.ui * 256 + r] * rowbytes; }
};

template <class E, class = void> struct epi_rep { static constexpr int v = 1; };
template <class E> struct epi_rep<E, decltype((void)E::REP)> { static constexpr int v = E::REP; };
template <class Epi, class Sched, bool ALIGN_EPI, bool GATHER, bool F8>
__device__ __forceinline__ void gemm_phase(LAS unsigned char* lds, const int wv, const int KB, const int ldaB, const int ldbB, const Sched& S, const Epi& E, const int krep = 1) {
    int tid_ = wv * 64 + lane_id(); asm volatile("" : "+v"(tid_));
    const int tid = tid_, wid = __builtin_amdgcn_readfirstlane(tid >> 6), lane = tid & 63, wr = wid >> 2, wc = wid & 3, fr = lane & 15, fq = lane >> 4;
    const int nt1 = KB / 128, nt = nt1 * krep;
    Unit cur, nxt; int ui = 0;
    if (!S.next(0, cur)) return;
    unsigned voffA[GATHER ? 2 : 1][2], voffB[2];
#pragma unroll
    for (int i = 0; i < 2; ++i) { int R, C; stage_rc(tid * 16 + i * 8192, R, C); const int Rb = Epi::PERM ? ((R & ~31) + perm32(R & 31)) : R;
        if constexpr (GATHER) { voffA[0][i] = S.row_off(cur, R) + (unsigned)C * 2u; voffA[1][i] = S.row_off(cur, R + HALF) + (unsigned)C * 2u; }
        else { voffA[0][i] = (unsigned)(R * ldaB + C * 2); }
        voffB[i] = (unsigned)(Rb * ldbB + C * 2); }
    const size_t kstep = (size_t)(BK * 2);
    const size_t hstepA = GATHER ? (size_t)0 : (size_t)HALF * ldaB, hstepB = (size_t)HALF * ldbB;
    const unsigned ldsw = (unsigned)wid * 1024u;
    const int aoff = lds_byte(wr * 64 + fr, fq * 8), boff = lds_byte(wc * 32 + fr, fq * 8);
#define PG8_SA(b, h) (((b) * 2 + (h)) * HTB)
#define PG8_SB(b, h) ((4 + (b) * 2 + (h)) * HTB)
#define PG8_STAGE(bufoff, gbase, voff) do { _Pragma("unroll") for (int _i = 0; _i < 2; ++_i) \
        __builtin_amdgcn_global_load_lds((const unsigned*)((const char*)(gbase) + (voff)[_i]), (LAS unsigned*)(lds + (bufoff) + ldsw + _i * 8192), 16, 0, 0); } while (0)
#define PG8_STAGEA(bufoff, gbase, h) PG8_STAGE(bufoff, (gbase) + (h) * hstepA, voffA[GATHER ? (h) : 0])
#define PG8_STAGEB(bufoff, gbase, h) PG8_STAGE(bufoff, (gbase) + (h) * hstepB, voffB)
#define PG8_RD(off) (*(const LAS i32x4*)(lds + (off)))
#define PG8_CAT8(x0, x1) __builtin_shufflevector(x0, x1, 0, 1, 2, 3, 4, 5, 6, 7)
#define PG8_LDA(dst, b, h) do { if constexpr (F8) { _Pragma("unroll") for (int m = 0; m < 4; ++m) { const i32x4 l_ = PG8_RD(PG8_SA(b, h) + aoff + m * 2048), h_ = PG8_RD(PG8_SA(b, h) + aoff + m * 2048 + 1024); dst##8[m] = PG8_CAT8(l_, h_); } } \
        else { _Pragma("unroll") for (int m = 0; m < 4; ++m) _Pragma("unroll") for (int k = 0; k < 2; ++k) dst[m][k] = *(const LAS bf16x8*)(lds + PG8_SA(b, h) + aoff + m * 2048 + k * 1024); } } while (0)
#define PG8_LDB(dst, b, h) do { if constexpr (F8) { _Pragma("unroll") for (int n = 0; n < 2; ++n) { const i32x4 l_ = PG8_RD(PG8_SB(b, h) + boff + n * 2048), h_ = PG8_RD(PG8_SB(b, h) + boff + n * 2048 + 1024); dst##8[n] = PG8_CAT8(l_, h_); } } \
        else { _Pragma("unroll") for (int n = 0; n < 2; ++n) _Pragma("unroll") for (int k = 0; k < 2; ++k) dst[n][k] = *(const LAS bf16x8*)(lds + PG8_SB(b, h) + boff + n * 2048 + k * 1024); } } while (0)
#define PG8_MMA(ai, bj, At, Bt) do { __builtin_amdgcn_s_setprio(1); \
        if constexpr (F8) { _Pragma("unroll") for (int m = 0; m < 4; ++m) _Pragma("unroll") for (int n = 0; n < 2; ++n) \
            acc[ai][bj][m][n] = __builtin_amdgcn_mfma_scale_f32_16x16x128_f8f6f4(Bt##8[n], At##8[m], acc[ai][bj][m][n], 0, 0, 0, 0x7f7f7f7f, 0, 0x7f7f7f7f); } \
        else { _Pragma("unroll") for (int m = 0; m < 4; ++m) _Pragma("unroll") for (int n = 0; n < 2; ++n) _Pragma("unroll") for (int k = 0; k < 2; ++k) \
            acc[ai][bj][m][n] = __builtin_amdgcn_mfma_f32_16x16x32_bf16(Bt[n][k], At[m][k], acc[ai][bj][m][n], 0, 0, 0); } \
        __builtin_amdgcn_s_setprio(0); } while (0)
#define PG8_WAIT_V(n) asm volatile("s_waitcnt vmcnt(" #n ")" ::: "memory")
#define PG8_WAIT_L(n) asm volatile("s_waitcnt lgkmcnt(" #n ")" ::: "memory")
#define PG8_BAR __builtin_amdgcn_s_barrier()
#define PG8_SCHED __builtin_amdgcn_sched_barrier(0)
    f32x4 acc[2][2][4][2];
#pragma unroll
    for (int a = 0; a < 2; ++a)
#pragma unroll
        for (int b = 0; b < 2; ++b)
#pragma unroll
            for (int m = 0; m < 4; ++m)
#pragma unroll
                for (int n = 0; n < 2; ++n) acc[a][b][m][n] = (f32x4){0.f, 0.f, 0.f, 0.f};
    bf16x8 At[4][2], B0[2][2], B1[2][2]; i32x8 At8[4], B08[2], B18[2]; (void)At; (void)B0; (void)B1; (void)At8; (void)B08; (void)B18;
    const char* cA = cur.pa; const char* cB = cur.pb;
    PG8_STAGEB(PG8_SB(0, 0), cB, 0); PG8_STAGEB(PG8_SB(0, 1), cB, 1); PG8_STAGEA(PG8_SA(0, 0), cA, 0); PG8_STAGEA(PG8_SA(0, 1), cA, 1);
    if (wr == 1) PG8_BAR;
    PG8_WAIT_V(2); PG8_BAR;
    PG8_STAGEB(PG8_SB(1, 0), cB + kstep, 0); PG8_STAGEA(PG8_SA(1, 0), cA + kstep, 0); PG8_STAGEB(PG8_SB(1, 1), cB + kstep, 1);
    PG8_WAIT_V(6); PG8_BAR;
    for (;;) {
        const bool has_next = S.next(ui + 1, nxt);
        const char* nA = has_next ? nxt.pa : cA; const char* nB = has_next ? nxt.pb : cB;
#pragma unroll 1
        for (int t = 0; t < nt; t += 2) {
            const bool last = (t == nt - 2);
            const char* a1 = cA + (size_t)((t + 1) & (nt1 - 1)) * kstep;
            const char* a2 = last ? nA : cA + (size_t)((t + 2) & (nt1 - 1)) * kstep; const char* b2 = last ? nB : cB + (size_t)((t + 2) & (nt1 - 1)) * kstep;
            const char* a3 = a2 + kstep; const char* b3 = b2 + kstep;
            PG8_LDB(B0, 0, 0); PG8_LDB(B1, 0, 1); PG8_SCHED; PG8_LDA(At, 0, 0); PG8_STAGEA(PG8_SA(1, 1), a1, 1);
            if constexpr (GATHER) { if (last && has_next) {
#pragma unroll
                for (int i = 0; i < 2; ++i) { int R, C; stage_rc(tid * 16 + i * 8192, R, C); voffA[0][i] = S.row_off(nxt, R) + (unsigned)C * 2u; voffA[1][i] = S.row_off(nxt, R + HALF) + (unsigned)C * 2u; } } }
            PG8_WAIT_V(8); PG8_WAIT_L(0); PG8_BAR; PG8_MMA(0, 0, At, B0); PG8_MMA(0, 1, At, B1); PG8_BAR; PG8_SCHED;
            PG8_LDA(At, 0, 1); PG8_STAGEB(PG8_SB(0, 0), b2, 0); PG8_STAGEB(PG8_SB(0, 1), b2, 1); PG8_STAGEA(PG8_SA(0, 0), a2, 0);
            PG8_WAIT_V(8); PG8_WAIT_L(0); PG8_BAR; PG8_MMA(1, 0, At, B0); PG8_MMA(1, 1, At, B1); PG8_BAR; PG8_SCHED;
            PG8_LDB(B0, 1, 0); PG8_LDB(B1, 1, 1); PG8_SCHED; PG8_LDA(At, 1, 0); PG8_STAGEA(PG8_SA(0, 1), a2, 1);
            PG8_WAIT_V(8); PG8_WAIT_L(0); PG8_BAR; PG8_MMA(0, 0, At, B0); PG8_MMA(0, 1, At, B1); PG8_BAR; PG8_SCHED;
            PG8_LDA(At, 1, 1); PG8_STAGEB(PG8_SB(1, 0), b3, 0); PG8_STAGEB(PG8_SB(1, 1), b3, 1); PG8_STAGEA(PG8_SA(1, 0), a3, 0);
            PG8_WAIT_V(8); PG8_WAIT_L(0); PG8_BAR; PG8_MMA(1, 0, At, B0); PG8_MMA(1, 1, At, B1); PG8_BAR; PG8_SCHED;
        }
        if constexpr (ALIGN_EPI) { if (wr == 0) PG8_BAR; }
        if (krep > 1) { const float sc_ = 1.0f / (float)krep;
#pragma unroll
            for (int a = 0; a < 2; ++a)
#pragma unroll
                for (int b = 0; b < 2; ++b)
#pragma unroll
                    for (int m = 0; m < 4; ++m)
#pragma unroll
                        for (int n = 0; n < 2; ++n) acc[a][b][m][n] = acc[a][b][m][n] * sc_; }
        if constexpr (!Epi::AFTER_DRAIN) {
#pragma unroll 1
            for (int er = 0; er < epi_rep<Epi>::v; ++er) {
            int fr_ = fr, fq_ = fq; asm volatile("" : "+v"(fr_), "+v"(fq_));
            E(acc, cur, wr, wc, fr_, fq_); } }
        if (!has_next) break;
#pragma unroll
        for (int a = 0; a < 2; ++a)
#pragma unroll
            for (int b = 0; b < 2; ++b)
#pragma unroll
                for (int m = 0; m < 4; ++m)
#pragma unroll
                    for (int n = 0; n < 2; ++n) acc[a][b][m][n] = (f32x4){0.f, 0.f, 0.f, 0.f};
        cur = nxt; cA = nA; cB = nB; ++ui;
        if constexpr (ALIGN_EPI) { if (wr == 1) PG8_BAR; }
    }
    PG8_WAIT_V(0);
    if constexpr (!ALIGN_EPI) { if (wr == 0) PG8_BAR; }
    PG8_BAR;
    if constexpr (Epi::AFTER_DRAIN) { int fr_ = fr, fq_ = fq; asm volatile("" : "+v"(fr_), "+v"(fq_)); E.fused(acc, cur, wr, wc, fr_, fq_, lds, wid, lane); }
#undef PG8_SA
#undef PG8_SB
#undef PG8_STAGE
#undef PG8_STAGEA
#undef PG8_STAGEB
#undef PG8_LDA
#undef PG8_LDB
#undef PG8_MMA
#undef PG8_CAT8
#undef PG8_RD
#undef PG8_WAIT_V
#undef PG8_WAIT_L
#undef PG8_BAR
#undef PG8_SCHED
}

__device__ __forceinline__ u32x4 widen8(u32x2 X, u32x2 Y) {
    const auto r0 = __builtin_amdgcn_permlane32_swap(X.x, Y.x, false, false); const auto r1 = __builtin_amdgcn_permlane32_swap(X.y, Y.y, false, false);
    const auto s0 = __builtin_amdgcn_permlane16_swap(r0[0], r0[1], false, false); const auto s1 = __builtin_amdgcn_permlane16_swap(r1[0], r1[1], false, false);
    return (u32x4){s0[0], s1[0], s0[1], s1[1]};
}
typedef const f32x4 (&AccC)[2][2][4][2];
typedef f32x4 (&AccM)[2][2][4][2];

struct EpiInProj {
    static constexpr bool PERM = true, AFTER_DRAIN = false;
    bf16_t* U; const float* cs;
    __device__ __forceinline__ void operator()(AccC acc, const Unit& u, int wr, int wc, int fr, int fq) const {
        const int row0 = u.pm * BM + wr * 64 + fr, col0 = u.pn * BM + wc * 32 + 8 * fq;
        const bool rot = (u.pn >= 2) && (u.pn < 6) && ((wc & 1) == 0) && (fq < 2);
        const float sc = (u.pn == 2 || u.pn == 3) ? QSCALE_D : 1.f;
        f32x4 c0v[2][4], c1v[2][4]; u32x4 pk[2][4][2];
#define IP_LOAD(ai) do { _Pragma("unroll") for (int m = 0; m < 4; ++m) { const f32x4* cp = (const f32x4*)(cs + (size_t)(row0 + (ai) * HALF + m * 16) * 16 + 8 * (fq & 1)); c0v[ai][m] = cp[0]; c1v[ai][m] = cp[1]; } } while (0)
#define IP_ROT(ai) do { _Pragma("unroll") for (int m = 0; m < 4; ++m) { \
            const f32x4 c0 = rot ? c0v[ai][m] : (f32x4){1.f, 0.f, 1.f, 0.f}, c1 = rot ? c1v[ai][m] : (f32x4){1.f, 0.f, 1.f, 0.f}; \
            _Pragma("unroll") for (int bj = 0; bj < 2; ++bj) { const f32x4 v0 = acc[ai][bj][m][0], v1 = acc[ai][bj][m][1]; f32x4 w0, w1; \
                w0[0] = v0[0] * c0[0] - v0[1] * c0[1]; w0[1] = v0[1] * c0[0] + v0[0] * c0[1]; w0[2] = v0[2] * c0[2] - v0[3] * c0[3]; w0[3] = v0[3] * c0[2] + v0[2] * c0[3]; \
                w1[0] = v1[0] * c1[0] - v1[1] * c1[1]; w1[1] = v1[1] * c1[0] + v1[0] * c1[1]; w1[2] = v1[2] * c1[2] - v1[3] * c1[3]; w1[3] = v1[3] * c1[2] + v1[2] * c1[3]; \
                w0 = w0 * sc; w1 = w1 * sc; \
                u32x4 w; w.x = cvt_pk_bf16(w0[0], w0[1]); w.y = cvt_pk_bf16(w0[2], w0[3]); w.z = cvt_pk_bf16(w1[0], w1[1]); w.w = cvt_pk_bf16(w1[2], w1[3]); pk[ai][m][bj] = w; } } } while (0)
#define IP_STORE(ai) do { _Pragma("unroll") for (int m = 0; m < 4; ++m) { bf16_t* rowp = U + (size_t)(row0 + (ai) * HALF + m * 16) * INW + col0; \
            _Pragma("unroll") for (int bj = 0; bj < 2; ++bj) *(u32x4*)(rowp + bj * HALF) = pk[ai][m][bj]; } } while (0)
        IP_LOAD(0); IP_ROT(0); asm volatile("" ::: "memory");
        IP_LOAD(1); asm volatile("" ::: "memory");
        IP_STORE(0); IP_ROT(1); IP_STORE(1);
#undef IP_LOAD
#undef IP_ROT
#undef IP_STORE
    }
};
template <bool F8O> struct EpiTile {
    static constexpr bool PERM = true, AFTER_DRAIN = false;
    void* O; int ldc; const LAS float* rs; float mul;
    __device__ __forceinline__ void operator()(AccC acc, const Unit& u, int wr, int wc, int fr, int fq) const {
        const int rt0 = wr * 64 + fr, col0 = u.pn * BM + wc * 32 + 8 * fq;
        u32x2 wprev[2] = {(u32x2){0u, 0u}, (u32x2){0u, 0u}};
#pragma unroll
        for (int ai = 0; ai < 2; ++ai)
#pragma unroll
            for (int m = 0; m < 4; ++m) {
                const int rt = rt0 + ai * HALF + m * 16;
                const float s = rs ? rs[rt] * mul : mul;
                const size_t o0 = (size_t)(u.pm * BM + rt) * ldc + col0;
#pragma unroll
                for (int bj = 0; bj < 2; ++bj) { const f32x4 v0 = acc[ai][bj][m][0] * s, v1 = acc[ai][bj][m][1] * s;
                    if constexpr (F8O) { const u32x2 wv = (u32x2){pk4_fp8(v0[0], v0[1], v0[2], v0[3]), pk4_fp8(v1[0], v1[1], v1[2], v1[3])};
                        if ((m & 1) == 0) wprev[bj] = wv; else *(u32x4*)((unsigned char*)O + (size_t)(u.pm * BM + rt - 16 + (fq >> 1) * 16) * ldc + u.pn * BM + wc * 32 + (fq & 1) * 16 + bj * HALF) = widen8(wprev[bj], wv); }
                    else { u32x4 w; w.x = cvt_pk_bf16(v0[0], v0[1]); w.y = cvt_pk_bf16(v0[2], v0[3]); w.z = cvt_pk_bf16(v1[0], v1[1]); w.w = cvt_pk_bf16(v1[2], v1[3]);
                        *(u32x4*)((bf16_t*)O + o0 + bj * HALF) = w; } }
            }
    }
};
typedef EpiTile<false> EpiBf16;
struct EpiBf16Sel {
    static constexpr bool PERM = true, AFTER_DRAIN = false;
    bf16_t* O0; int ldc0; bf16_t* O1; int ldc1;
    __device__ __forceinline__ void operator()(AccC acc, const Unit& u, int wr, int wc, int fr, int fq) const {
        bf16_t* O = u.e ? O1 : O0; const int ldc = u.e ? ldc1 : ldc0;
        const int rt0 = wr * 64 + fr, col0 = u.pn * BM + wc * 32 + 8 * fq;
#pragma unroll
        for (int ai = 0; ai < 2; ++ai)
#pragma unroll
            for (int m = 0; m < 4; ++m) {
                const int rt = rt0 + ai * HALF + m * 16;
                bf16_t* rowp = O + (size_t)(u.pm * BM + rt) * ldc + col0;
#pragma unroll
                for (int bj = 0; bj < 2; ++bj) { const f32x4 v0 = acc[ai][bj][m][0], v1 = acc[ai][bj][m][1];
                    u32x4 w; w.x = cvt_pk_bf16(v0[0], v0[1]); w.y = cvt_pk_bf16(v0[2], v0[3]); w.z = cvt_pk_bf16(v1[0], v1[1]); w.w = cvt_pk_bf16(v1[2], v1[3]);
                    *(u32x4*)(rowp + bj * HALF) = w; }
            }
    }
};
template <bool RF32, bool F8OUT> struct EpiRes {
    static constexpr bool PERM = true, AFTER_DRAIN = false;
    const void* resid; bf16_t* xb; unsigned char* x8; float* ssp; float amul;
    __device__ __forceinline__ void operator()(AccC acc, const Unit& u, int wr, int wc, int fr, int fq) const {
        const int row0 = u.pm * BM + wr * 64 + fr, col0 = u.pn * BM + wc * 32 + 8 * fq;
        f32x4 v[4][2][2][2];
        u32x2 p8[2] = {(u32x2){0u, 0u}, (u32x2){0u, 0u}}; const int cb8 = u.pn * BM + wc * 32 + (fq & 1) * 16;
#define ER_ROW(b, mm) (row0 + ((b) >> 1) * HALF + (((b) & 1) * 2 + (mm)) * 16)
#define ER_LOAD(b) do { _Pragma("unroll") for (int mm = 0; mm < 2; ++mm) _Pragma("unroll") for (int bj = 0; bj < 2; ++bj) { const size_t o2 = (size_t)ER_ROW(b, mm) * D + col0 + bj * HALF; \
            if constexpr (RF32) { v[b][mm][bj][0] = *(const f32x4*)((const float*)resid + o2); v[b][mm][bj][1] = *(const f32x4*)((const float*)resid + o2 + 4); } \
            else { const u32x4 r = *(const u32x4*)((const bf16_t*)resid + o2); \
                v[b][mm][bj][0] = (f32x4){__builtin_bit_cast(float, r.x << 16), __builtin_bit_cast(float, r.x & 0xffff0000u), __builtin_bit_cast(float, r.y << 16), __builtin_bit_cast(float, r.y & 0xffff0000u)}; \
                v[b][mm][bj][1] = (f32x4){__builtin_bit_cast(float, r.z << 16), __builtin_bit_cast(float, r.z & 0xffff0000u), __builtin_bit_cast(float, r.w << 16), __builtin_bit_cast(float, r.w & 0xffff0000u)}; } } } while (0)
#define ER_SUM(b) do { _Pragma("unroll") for (int mm = 0; mm < 2; ++mm) _Pragma("unroll") for (int bj = 0; bj < 2; ++bj) _Pragma("unroll") for (int n = 0; n < 2; ++n) { \
            v[b][mm][bj][n] = v[b][mm][bj][n] + acc[(b) >> 1][bj][((b) & 1) * 2 + mm][n] * amul; asm volatile("" : "+v"(v[b][mm][bj][n])); } } while (0)
#define ER_STORE(b) do { _Pragma("unroll") for (int mm = 0; mm < 2; ++mm) { const int row = ER_ROW(b, mm); float ss = 0.f; \
            _Pragma("unroll") for (int bj = 0; bj < 2; ++bj) { const size_t o2 = (size_t)row * D + col0 + bj * HALF; const f32x4 x0 = v[b][mm][bj][0], x1 = v[b][mm][bj][1]; \
                ss += ((x0[0] * x0[0] + x0[1] * x0[1]) + (x0[2] * x0[2] + x0[3] * x0[3])) + ((x1[0] * x1[0] + x1[1] * x1[1]) + (x1[2] * x1[2] + x1[3] * x1[3])); \
                u32x4 w; w.x = cvt_pk_bf16(x0[0], x0[1]); w.y = cvt_pk_bf16(x0[2], x0[3]); w.z = cvt_pk_bf16(x1[0], x1[1]); w.w = cvt_pk_bf16(x1[2], x1[3]); *(u32x4*)(xb + o2) = w; \
                if constexpr (F8OUT) { const u32x2 wv = (u32x2){pk4_fp8(x0[0], x0[1], x0[2], x0[3]), pk4_fp8(x1[0], x1[1], x1[2], x1[3])}; \
                    if (mm == 0) p8[bj] = wv; else *(u32x4*)(x8 + (size_t)(row - 16 + (fq >> 1) * 16) * D + cb8 + bj * HALF) = widen8(p8[bj], wv); } } \
            if (ssp) { ss += __shfl_xor(ss, 16); ss += __shfl_xor(ss, 32); if (fq == 0) ssp[(size_t)(u.pn * 4 + wc) * T + row] = ss; } } } while (0)
#define ER_FENCE() asm volatile("" ::: "memory")
        ER_LOAD(0); ER_SUM(0); ER_FENCE();
        ER_LOAD(1); ER_FENCE(); ER_STORE(0); ER_SUM(1); ER_FENCE();
        ER_LOAD(2); ER_FENCE(); ER_STORE(1); ER_SUM(2); ER_FENCE();
        ER_LOAD(3); ER_FENCE(); ER_STORE(2); ER_SUM(3); ER_FENCE();
        ER_STORE(3);
#undef ER_ROW
#undef ER_LOAD
#undef ER_SUM
#undef ER_STORE
#undef ER_FENCE
    }
};
struct EpiSoftmax {
    static constexpr bool PERM = true, AFTER_DRAIN = true;
    bf16_t* O; int ldc; const LAS float* rs; float mul;
    __device__ __forceinline__ void fused(AccM acc, const Unit& u, int wr, int wc, int fr, int fq, LAS unsigned char* lds, int wid, int lane) const {
        LAS float* PM = (LAS float*)lds; LAS float* PS = (LAS float*)(lds + 4096);
#pragma unroll
        for (int ai = 0; ai < 2; ++ai)
#pragma unroll
            for (int m = 0; m < 4; ++m) { const float s_ = rs[ai * HALF + wr * 64 + m * 16 + fr] * mul;
#pragma unroll
                for (int bj = 0; bj < 2; ++bj)
#pragma unroll
                    for (int n = 0; n < 2; ++n) acc[ai][bj][m][n] = acc[ai][bj][m][n] * s_; }
#pragma unroll
        for (int ai = 0; ai < 2; ++ai)
#pragma unroll
            for (int m = 0; m < 4; ++m) { float v = -INFINITY;
#pragma unroll
                for (int bj = 0; bj < 2; ++bj)
#pragma unroll
                    for (int n = 0; n < 2; ++n) { const f32x4 x = acc[ai][bj][m][n]; v = fmaxf(v, fmaxf(fmaxf(x[0], x[1]), fmaxf(x[2], x[3]))); }
                v = fmaxf(v, __shfl_xor(v, 16)); v = fmaxf(v, __shfl_xor(v, 32));
                if (fq == 0) PM[(ai * HALF + wr * 64 + m * 16 + fr) * 4 + wc] = v; }
        LDS_WAIT(); __builtin_amdgcn_s_barrier(); asm volatile("" ::: "memory");
#pragma unroll
        for (int ai = 0; ai < 2; ++ai)
#pragma unroll
            for (int m = 0; m < 4; ++m) { const int rt = ai * HALF + wr * 64 + m * 16 + fr; const f32x4 q = *(const LAS f32x4*)(PM + rt * 4);
                const float mx = fmaxf(fmaxf(q[0], q[1]), fmaxf(q[2], q[3])); float s = 0.f;
#pragma unroll
                for (int bj = 0; bj < 2; ++bj)
#pragma unroll
                    for (int n = 0; n < 2; ++n) { f32x4 x = acc[ai][bj][m][n];
                        x = x - mx; x[0] = __builtin_amdgcn_exp2f(x[0]); x[1] = __builtin_amdgcn_exp2f(x[1]); x[2] = __builtin_amdgcn_exp2f(x[2]); x[3] = __builtin_amdgcn_exp2f(x[3]);
                        s += (x[0] + x[1]) + (x[2] + x[3]); acc[ai][bj][m][n] = x; }
                s += __shfl_xor(s, 16); s += __shfl_xor(s, 32);
                if (fq == 0) PS[rt * 4 + wc] = s; }
        LDS_WAIT(); __builtin_amdgcn_s_barrier(); asm volatile("" ::: "memory");
        const int col0 = u.pn * BM + wc * 32 + 8 * fq;
        u32x2 wprev[2] = {(u32x2){0u, 0u}, (u32x2){0u, 0u}};
#pragma unroll
        for (int ai = 0; ai < 2; ++ai)
#pragma unroll
            for (int m = 0; m < 4; ++m) { const int rt = ai * HALF + wr * 64 + m * 16 + fr; const f32x4 q = *(const LAS f32x4*)(PS + rt * 4);
                const float inv = 1.0f / ((q[0] + q[1]) + (q[2] + q[3]));
                unsigned char* rowp = (unsigned char*)O + (size_t)(u.pm * BM + rt - 16 + (fq >> 1) * 16) * ldc + col0 - 8 * fq + (fq & 1) * 16;
#pragma unroll
                for (int bj = 0; bj < 2; ++bj) { const f32x4 v0 = acc[ai][bj][m][0] * (inv * 256.0f), v1 = acc[ai][bj][m][1] * (inv * 256.0f);
                    const u32x2 wv = (u32x2){pk4_fp8(v0[0], v0[1], v0[2], v0[3]), pk4_fp8(v1[0], v1[1], v1[2], v1[3])};
                    if ((m & 1) == 0) wprev[bj] = wv; else *(u32x4*)(rowp + bj * HALF) = widen8(wprev[bj], wv); }
            }
        LDS_WAIT(); __builtin_amdgcn_s_barrier(); asm volatile("" ::: "memory");
    }
};
#define SW_STAGE(x) asm volatile("" : "+v"(x[0]), "+v"(x[1]), "+v"(x[2]), "+v"(x[3]))
struct EpiSwiGLU {
    static constexpr bool PERM = true, AFTER_DRAIN = false; static constexpr int REP = EPIREP_SW;
    unsigned char* H; const float* bgu; const float* rstd; const LAS int* tokt; const MoeOrder* S; unsigned* flags;
    __device__ __forceinline__ void operator()(AccC acc, const Unit& u, int wr, int wc, int fr, int fq) const {
        if (u.ui > 1 && (wr | wc) == 0) { Unit pv; (void)S->next(u.ui - 2, pv); if ((fr | fq) == 0) (void)xb_add(flags + (size_t)pv.pm * FLAG_STRIDE, 1u); }
        const int rt0 = wr * 64 + fr, c0 = u.pn * HALF + wc * 32 + 8 * fq; const float* bg_ = bgu + (size_t)u.e * 2048;
        constexpr float CP = 1.702f * LOG2E, ICP = 1.0f / CP;
        f32x4 tb[2], ub[2];
#pragma unroll
        for (int n = 0; n < 2; ++n) { tb[n] = *(const f32x4*)(bg_ + c0 + 4 * n) * (-CP); ub[n] = (*(const f32x4*)(bg_ + 1024 + c0 + 4 * n) * 4.0f + 4.0f) * (-ICP); }
        u32x2 wprev = (u32x2){0u, 0u};
        float rsv[2][4];
#pragma unroll
        for (int ai = 0; ai < 2; ++ai)
#pragma unroll
            for (int m = 0; m < 4; ++m) rsv[ai][m] = rstd[tokt[u.ui * 256 + rt0 + ai * HALF + m * 16]];
        asm volatile("s_waitcnt vmcnt(0)" ::: "memory");
        const int cb = u.pn * HALF + wc * 32 + (fq & 1) * 16, rsel = (fq >> 1) * 16;
#pragma unroll
        for (int ai = 0; ai < 2; ++ai)
#pragma unroll
            for (int m = 0; m < 4; ++m) {
                const int rt = rt0 + ai * HALF + m * 16;
                const float rst = rsv[ai][m] * (-CP * 0.03125f), rsu = rsv[ai][m] * (-4.0f * ICP * 0.03125f);
                unsigned w[2];
                f32x2 t[4], ut[4], d[4];
#pragma unroll
                for (int n = 0; n < 2; ++n) { const f32x4 t4 = acc[ai][0][m][n] * rst + tb[n], u4 = acc[ai][1][m][n] * rsu + ub[n];
#pragma unroll
                    for (int j = 0; j < 2; ++j) {
                        t[2 * n + j] = __builtin_elementwise_max((f32x2){t4[2 * j], t4[2 * j + 1]}, (f32x2){-7.0f * CP, -7.0f * CP});
                        const f32x2 uu = __builtin_elementwise_min(__builtin_elementwise_max((f32x2){u4[2 * j], u4[2 * j + 1]}, (f32x2){-32.0f * ICP, -32.0f * ICP}), (f32x2){24.0f * ICP, 24.0f * ICP});
                        ut[2 * n + j] = uu * t[2 * n + j]; } }
#pragma unroll
                for (int k = 0; k < 4; ++k) { d[k].x = __builtin_amdgcn_exp2f(t[k].x); d[k].y = __builtin_amdgcn_exp2f(t[k].y); }
                SW_STAGE(d);
#pragma unroll
                for (int k = 0; k < 4; ++k) d[k] = d[k] + 1.0f;
                SW_STAGE(d);
#pragma unroll
                for (int k = 0; k < 4; ++k) { d[k].x = __builtin_amdgcn_rcpf(d[k].x); d[k].y = __builtin_amdgcn_rcpf(d[k].y); }
                SW_STAGE(d);
#pragma unroll
                for (int k = 0; k < 4; ++k) d[k] = ut[k] * d[k];
                w[0] = pk4_fp8(d[0].x, d[0].y, d[1].x, d[1].y); w[1] = pk4_fp8(d[2].x, d[2].y, d[3].x, d[3].y);
                if ((m & 1) == 0) { wprev = (u32x2){w[0], w[1]}; }
                else { const u32x4 ww = widen8(wprev, (u32x2){w[0], w[1]}); *(u32x4*)(H + (size_t)(u.pm * BM + rt - 16 + rsel) * 1024 + cb) = ww; }
            }
    }
};
struct EpiDown {
    static constexpr bool PERM = true, AFTER_DRAIN = false; static constexpr int REP = EPIREP_DN;
    unsigned char* Y; const float* bd; const float* gates; const MoeOrder* S; unsigned* flags;
    __device__ __forceinline__ void operator()(AccC acc, const Unit& u, int wr, int wc, int fr, int fq) const {
        const int rt0 = wr * 64 + fr, col0 = u.pn * BM + wc * 32 + 8 * fq; const float* bd_ = bd + (size_t)u.e * 1024; const float* gt_ = gates + (size_t)u.e * CAP + u.r * 256;
        f32x4 bv[2][2];
#pragma unroll
        for (int bj = 0; bj < 2; ++bj)
#pragma unroll
            for (int n = 0; n < 2; ++n) bv[bj][n] = *(const f32x4*)(bd_ + col0 + bj * HALF + 4 * n);
        u32x2 wprev[2] = {(u32x2){0u, 0u}, (u32x2){0u, 0u}};
        float gv[2][4];
#pragma unroll
        for (int ai = 0; ai < 2; ++ai)
#pragma unroll
            for (int m = 0; m < 4; ++m) gv[ai][m] = gt_[rt0 + ai * HALF + m * 16];
        asm volatile("" ::: "memory");
        unsigned fv2 = 8u; int pm2 = 0;
        if ((wr | wc) == 0) { Unit n2; const bool h2 = S->next(u.ui + 2, n2); pm2 = h2 ? n2.pm : u.pm; fv2 = xb_ld(flags + (size_t)pm2 * FLAG_STRIDE); }
#pragma unroll
        for (int ai = 0; ai < 2; ++ai)
#pragma unroll
            for (int m = 0; m < 4; ++m) {
                const int rt = rt0 + ai * HALF + m * 16;
                const float g = gv[ai][m] * 16.0f;
                unsigned char* rowp = Y + (size_t)(u.pm * BM + rt - 16 + (fq >> 1) * 16) * 1024 + u.pn * BM + wc * 32 + (fq & 1) * 16;
#pragma unroll
                for (int bj = 0; bj < 2; ++bj) { const f32x4 v0 = (acc[ai][bj][m][0] * 0.0078125f + bv[bj][0]) * g, v1 = (acc[ai][bj][m][1] * 0.0078125f + bv[bj][1]) * g;
                    const u32x2 wv = (u32x2){pk4_fp8(v0[0], v0[1], v0[2], v0[3]), pk4_fp8(v1[0], v1[1], v1[2], v1[3])};
                    if ((m & 1) == 0) wprev[bj] = wv; else *(u32x4*)(rowp + bj * HALF) = widen8(wprev[bj], wv); }
            }
        if (fv2 < 8u) hid_wait(flags, pm2);
    }
};
}

struct Args {
    const float* x; const int* pos; const float* mem; const float* attn_g; const float* w_in; const float* w_pool; const float* pool_scale;
    const float* lq1; const float* lk1; const float* lq2; const float* lk2; const float* subln_g; const float* w_out; const float* xattn_g; const float* mem_g;
    const float* w_cq; const float* w_ckv; const float* w_co; const float* ffn_g; const float* w_router; const float* b_router; const float* w_gu; const float* b_gu;
    const float* w_down; const float* b_down; const float* final_g;
    float* out; unsigned char* ws; int ph_lo, ph_hi;
};

template <int MAP>
__device__ __forceinline__ int rowmap(int c) {
    if (MAP == 1) { if (c >= 512 && c < 1536) { const int d = c & 63; if (d < 16) return (c & ~63) + ((d < 8) ? 2 * d : 2 * (d - 8) + 1); } return c; }
    if (MAP == 2) { const int j = c & 1023; return ((j >> 7) << 8) + ((c >> 10) << 7) + (j & 127); }
    return c;
}
template <int MAP, bool OUT8>
__device__ __forceinline__ void p0_transpose_stream(const float* W, int K, int N, int nmat, void* WTv, int ldt, int kdst0, size_t dst_stride, const float* g, LAS float* scr, int gw, int NGW, int lane, int it_lo = 0, int it_hi = 0x7fffffff) {
    const int nblk = N / 32, ipm = (K / 64) * nblk, nitems = min(nmat * ipm, it_hi);
    const int lr = lane >> 3, lc = (lane & 7) * 4;
    f32x4 cur[8], nxt[8];
#define P0_LOAD(dst, it) do { const int e_ = (it) / ipm, r_ = (it) % ipm, kb_ = r_ / nblk, nb_ = r_ % nblk; const float* p_ = W + ((size_t)e_ * K + 64 * kb_ + lr) * N + 32 * nb_ + lc; \
        _Pragma("unroll") for (int i_ = 0; i_ < 8; ++i_) dst[i_] = __builtin_nontemporal_load((const f32x4*)(p_ + (size_t)(8 * i_) * N)); } while (0)
    int it = it_lo + gw;
    if (it < nitems) P0_LOAD(cur, it);
    while (it < nitems) {
        const int itn = it + NGW;
        if (itn < nitems) P0_LOAD(nxt, itn);
        const int e = it / ipm, r = it % ipm, kb = r / nblk, nb = r % nblk, k0 = 64 * kb, n0 = 32 * nb;
#pragma unroll
        for (int i = 0; i < 8; ++i) { const int kk = 8 * i + lr; f32x4 v = cur[i]; if (g) v = v * g[k0 + kk];
            LAS float* s = scr + kk * 33 + lc; s[0] = v[0]; s[1] = v[1]; s[2] = v[2]; s[3] = v[3]; }
        LDS_WAIT(); asm volatile("" ::: "memory");
        if constexpr (OUT8) {
            const int c = lane & 3; unsigned char* wt = (unsigned char*)WTv + (size_t)e * dst_stride;
#pragma unroll
            for (int j = 0; j < 2; ++j) { const int n = (lane >> 2) + 16 * j; const LAS float* s = scr + (16 * c) * 33 + n;
                u32x4 o; o.x = pk4_fp8(s[0 * 33] * 32.f, s[1 * 33] * 32.f, s[2 * 33] * 32.f, s[3 * 33] * 32.f); o.y = pk4_fp8(s[4 * 33] * 32.f, s[5 * 33] * 32.f, s[6 * 33] * 32.f, s[7 * 33] * 32.f);
                o.z = pk4_fp8(s[8 * 33] * 32.f, s[9 * 33] * 32.f, s[10 * 33] * 32.f, s[11 * 33] * 32.f); o.w = pk4_fp8(s[12 * 33] * 32.f, s[13 * 33] * 32.f, s[14 * 33] * 32.f, s[15 * 33] * 32.f);
                *(u32x4*)(wt + (size_t)rowmap<MAP>(n0 + n) * ldt + kdst0 + k0 + 16 * c) = o; }
        } else {
            const int c = lane & 7; bf16_t* wt = (bf16_t*)WTv + (size_t)e * dst_stride;
#pragma unroll
            for (int j = 0; j < 4; ++j) { const int n = (lane >> 3) + 8 * j; const LAS float* s = scr + (8 * c) * 33 + n;
                u32x4 o; o.x = pk2(s[0 * 33], s[1 * 33]); o.y = pk2(s[2 * 33], s[3 * 33]); o.z = pk2(s[4 * 33], s[5 * 33]); o.w = pk2(s[6 * 33], s[7 * 33]);
                *(u32x4*)(wt + (size_t)rowmap<MAP>(n0 + n) * ldt + kdst0 + k0 + 8 * c) = o; }
        }
        LDS_WAIT(); asm volatile("" ::: "memory");
#pragma unroll
        for (int i = 0; i < 8; ++i) cur[i] = nxt[i];
        it = itn;
    }
#undef P0_LOAD
}
__device__ __forceinline__ void rms_row_to_bf16(const float* xrow, const float* g, bf16_t* orow, int lane) {
    const f32x4* xr = (const f32x4*)xrow + lane; const f32x4* gr = (const f32x4*)g + lane;
    f32x4 v[4]; float s = 0.f;
#pragma unroll
    for (int j = 0; j < 4; ++j) { v[j] = xr[64 * j]; s += (v[j][0] * v[j][0] + v[j][1] * v[j][1]) + (v[j][2] * v[j][2] + v[j][3] * v[j][3]); }
    const float rstd = 1.0f / sqrtf(wave_sum(s) * (1.0f / D) + EPS);
    u32x2* o8 = (u32x2*)orow + lane;
#pragma unroll
    for (int j = 0; j < 4; ++j) { const f32x4 gg = gr[64 * j]; u32x2 w; w.x = pk2(v[j][0] * rstd * gg[0], v[j][1] * rstd * gg[1]); w.y = pk2(v[j][2] * rstd * gg[2], v[j][3] * rstd * gg[3]); o8[64 * j] = w; }
}

__device__ __forceinline__ void rms_rows_stream(const float* X, const float* g, bf16_t* O, int nrows, int gw, int NGW, int lane) {
    f32x4 cur[4], nxt[4]; const f32x4* gr = (const f32x4*)g + lane;
    int r = gw;
    if (r < nrows) { const f32x4* xr = (const f32x4*)(X + (size_t)r * D) + lane;
#pragma unroll
        for (int j = 0; j < 4; ++j) cur[j] = __builtin_nontemporal_load(xr + 64 * j); }
    while (r < nrows) {
        const int rn = r + NGW;
        if (rn < nrows) { const f32x4* xr = (const f32x4*)(X + (size_t)rn * D) + lane;
#pragma unroll
            for (int j = 0; j < 4; ++j) nxt[j] = __builtin_nontemporal_load(xr + 64 * j); }
        float s = 0.f;
#pragma unroll
        for (int j = 0; j < 4; ++j) s += (cur[j][0] * cur[j][0] + cur[j][1] * cur[j][1]) + (cur[j][2] * cur[j][2] + cur[j][3] * cur[j][3]);
        const float rstd = 1.0f / sqrtf(wave_sum(s) * (1.0f / D) + EPS);
        u32x2* o8 = (u32x2*)(O + (size_t)r * D) + lane;
#pragma unroll
        for (int j = 0; j < 4; ++j) { const f32x4 gg = gr[64 * j]; u32x2 w; w.x = pk2(cur[j][0] * rstd * gg[0], cur[j][1] * rstd * gg[1]); w.y = pk2(cur[j][2] * rstd * gg[2], cur[j][3] * rstd * gg[3]); o8[64 * j] = w; }
#pragma unroll
        for (int j = 0; j < 4; ++j) cur[j] = nxt[j];
        r = rn;
    }
}

namespace dattn {
constexpr int KP = 144, VP = 320;
constexpr int K_BYTES = 2 * 64 * KP, V_BYTES = 64 * VP;
constexpr int V_OFF = 2 * K_BYTES;
constexpr float THR = 4.0f;
__device__ __forceinline__ s16x4 vtr(const LAS unsigned char* p) { typedef short v4i16_t __attribute__((ext_vector_type(4))); return __builtin_bit_cast(s16x4, __builtin_amdgcn_ds_read_tr16_b64_v4i16((LAS v4i16_t*)p)); }
__device__ __forceinline__ void pv_tile(f32x16 (&o)[4], const bf16x8 (&pf)[4], const float alpha, const bool resc, const LAS unsigned char* vb_) {
    unsigned vbo = (unsigned)(uintptr_t)vb_; asm volatile("" : "+v"(vbo));
    const LAS unsigned char* vb = (const LAS unsigned char*)(uintptr_t)vbo;
    if (resc) {
#pragma unroll
        for (int d0 = 0; d0 < 4; ++d0) o[d0] = o[d0] * alpha;
    }
    s16x4 lo[2][4], hv[2][4];
#define PV_RD(buf, s) do { _Pragma("unroll") for (int d0 = 0; d0 < 4; ++d0) { lo[buf][d0] = vtr(vb + (s) * 16 * VP + d0 * 64); hv[buf][d0] = vtr(vb + (s) * 16 * VP + 8 * VP + d0 * 64); } } while (0)
#define PV_MM(buf, s) do { _Pragma("unroll") for (int d0 = 0; d0 < 4; ++d0) { const bf16x8 vf = (bf16x8){lo[buf][d0][0], lo[buf][d0][1], lo[buf][d0][2], lo[buf][d0][3], hv[buf][d0][0], hv[buf][d0][1], hv[buf][d0][2], hv[buf][d0][3]}; \
        o[d0] = __builtin_amdgcn_mfma_f32_32x32x16_bf16(vf, pf[s], o[d0], 0, 0, 0); } } while (0)
    PV_RD(0, 0); __builtin_amdgcn_sched_barrier(0);
    PV_RD(1, 1); __builtin_amdgcn_sched_barrier(0);
    PV_MM(0, 0); __builtin_amdgcn_sched_barrier(0);
    PV_RD(0, 2); __builtin_amdgcn_sched_barrier(0);
    PV_MM(1, 1); __builtin_amdgcn_sched_barrier(0);
    PV_RD(1, 3); __builtin_amdgcn_sched_barrier(0);
    PV_MM(0, 2); __builtin_amdgcn_sched_barrier(0);
    PV_MM(1, 3); __builtin_amdgcn_sched_barrier(0);
#undef PV_RD
#undef PV_MM
}
__device__ __forceinline__ void unit(LAS unsigned char* lds, const int wv, const bf16_t* U, bf16_t* CAT, const float* subln_g, float lam, int b, int hh, int j) {
    int tid_ = wv * 64 + lane_id(); asm volatile("" : "+v"(tid_));
    const int tid = tid_, lane = tid & 63, r32 = lane & 31, hi = lane >> 5; const int wid = __builtin_amdgcn_readfirstlane(tid >> 6);
    const int mp = wid & 1, rg = wid >> 1, grp = wid >> 2;
    const size_t tok0 = (size_t)b * SEQ;
    const int q0 = j * 128 + rg * 32;
    const int nt_all = 2 * j + 2, nt_mine = (rg < 2) ? nt_all - 1 : nt_all;
    bf16x8 qf[4];
    { const bf16_t* qp = U + (tok0 + q0 + r32) * INW + 512 + hh * 128 + mp * 64 + hi * 8;
#pragma unroll
      for (int ks = 0; ks < 4; ++ks) qf[ks] = *(const bf16x8*)(qp + ks * 16); }
    const int prow = tid >> 3, pc0 = (tid & 7) * 2;
    const bf16_t* kg = U + (tok0 + prow) * INW + 1024 + hh * 128 + pc0 * 8;
    const bf16_t* vg = U + (tok0 + prow) * INW + 1536 + hh * 128 + pc0 * 8;
    unsigned kdst[2], vdst[2];
#pragma unroll
    for (int i = 0; i < 2; ++i) { const int c16 = pc0 + i; kdst[i] = (unsigned)((c16 >> 3) * (64 * KP) + prow * KP + (c16 & 7) * 16); vdst[i] = (unsigned)(V_OFF + prow * VP + c16 * 16); }
    u32x4 kr[2], vr[2];
#define DA_LOAD(t) do { const size_t go = (size_t)(t) * 64 * INW; kr[0] = *(const u32x4*)(kg + go); kr[1] = *(const u32x4*)(kg + go + 8); vr[0] = *(const u32x4*)(vg + go); vr[1] = *(const u32x4*)(vg + go + 8); } while (0)
#define DA_WRITE(t) do { LAS unsigned char* kb_ = lds + ((t) & 1) * K_BYTES; LAS unsigned char* vb_ = lds + ((t) % 3) * V_BYTES; \
        *(LAS u32x4*)(kb_ + kdst[0]) = kr[0]; *(LAS u32x4*)(kb_ + kdst[1]) = kr[1]; *(LAS u32x4*)(vb_ + vdst[0]) = vr[0]; *(LAS u32x4*)(vb_ + vdst[1]) = vr[1]; } while (0)
    f32x16 o[4];
#pragma unroll
    for (int d0 = 0; d0 < 4; ++d0)
#pragma unroll
        for (int r = 0; r < 16; ++r) o[d0][r] = 0.f;
    float mrun = -INFINITY, lrun = 0.f, alpha = 1.f; bool resc = false;
    bf16x8 pf[4];
#pragma unroll
    for (int s = 0; s < 4; ++s) pf[s] = (bf16x8){0, 0, 0, 0, 0, 0, 0, 0};
    const int i16 = lane & 15, g16 = (lane >> 4) & 1;
    const unsigned kbase = (unsigned)(mp * (64 * KP) + r32 * KP + hi * 16);
    const unsigned vbase = (unsigned)(V_OFF + (4 * hi + (i16 >> 2)) * VP + (16 * g16 + 4 * (i16 & 3)) * 2);
    DA_LOAD(0); DA_WRITE(0);
    __syncthreads();
#pragma unroll 1
    for (int kt = 0; kt < nt_all; ++kt) {
        const bool more = (kt + 1 < nt_all);
        if (more) DA_LOAD(kt + 1);
        if (grp == 1 && kt >= 1) pv_tile(o, pf, alpha, resc, lds + vbase + ((unsigned)(kt + 2) % 3u) * (unsigned)V_BYTES);
        if (kt < nt_mine) {
            const LAS unsigned char* sb = lds + (kt & 1) * K_BYTES;
            f32x16 p0, p1;
#pragma unroll
            for (int r = 0; r < 16; ++r) { p0[r] = 0.f; p1[r] = 0.f; }
#pragma unroll
            for (int ks = 0; ks < 4; ++ks) {
                const bf16x8 k0 = *(const LAS bf16x8*)(sb + kbase + ks * 32), k1 = *(const LAS bf16x8*)(sb + kbase + 32 * KP + ks * 32);
                p0 = __builtin_amdgcn_mfma_f32_32x32x16_bf16(k0, qf[ks], p0, 0, 0, 0);
                p1 = __builtin_amdgcn_mfma_f32_32x32x16_bf16(k1, qf[ks], p1, 0, 0, 0);
            }
            float mx = fmaxf(p0[0], p1[0]);
#pragma unroll
            for (int r = 1; r < 16; ++r) mx = fmaxf(mx, fmaxf(p0[r], p1[r]));
            mx = fmaxf(mx, __shfl_xor(mx, 32));
            resc = __any(mx - mrun > THR) != 0;
            alpha = 1.f;
            if (resc) { const float mnew = fmaxf(mrun, mx); alpha = __builtin_amdgcn_exp2f(mrun - mnew); mrun = mnew; }
            p0 = p0 - mrun; p1 = p1 - mrun;
#pragma unroll
            for (int r = 0; r < 16; ++r) { p0[r] = __builtin_amdgcn_exp2f(p0[r]); p1[r] = __builtin_amdgcn_exp2f(p1[r]); }
            const f32x16 ps = p0 + p1;
            const f32x4 s4 = (__builtin_shufflevector(ps, ps, 0, 1, 2, 3) + __builtin_shufflevector(ps, ps, 4, 5, 6, 7)) + (__builtin_shufflevector(ps, ps, 8, 9, 10, 11) + __builtin_shufflevector(ps, ps, 12, 13, 14, 15));
            const float ls = (s4[0] + s4[1]) + (s4[2] + s4[3]);
            lrun = lrun * alpha + ls;
#pragma unroll
            for (int s = 0; s < 4; ++s) { u32x4 w;
                if (s < 2) { w.x = cvt_pk_bf16(p0[8 * s + 0], p0[8 * s + 1]); w.y = cvt_pk_bf16(p0[8 * s + 2], p0[8 * s + 3]); w.z = cvt_pk_bf16(p0[8 * s + 4], p0[8 * s + 5]); w.w = cvt_pk_bf16(p0[8 * s + 6], p0[8 * s + 7]); }
                else { const int s2 = s - 2; w.x = cvt_pk_bf16(p1[8 * s2 + 0], p1[8 * s2 + 1]); w.y = cvt_pk_bf16(p1[8 * s2 + 2], p1[8 * s2 + 3]); w.z = cvt_pk_bf16(p1[8 * s2 + 4], p1[8 * s2 + 5]); w.w = cvt_pk_bf16(p1[8 * s2 + 6], p1[8 * s2 + 7]); }
                pf[s] = __builtin_bit_cast(bf16x8, w); }
            if (grp == 0) pv_tile(o, pf, alpha, resc, lds + vbase + ((unsigned)kt % 3u) * (unsigned)V_BYTES);
        }
        if (more) DA_WRITE(kt + 1);
        __syncthreads();
    }
    if (grp == 1) pv_tile(o, pf, alpha, resc, lds + vbase + ((unsigned)(nt_all + 2) % 3u) * (unsigned)V_BYTES);
    __syncthreads();
#undef DA_LOAD
#undef DA_WRITE
    const float ltot = lrun + __shfl_xor(lrun, 32), inv = 1.0f / ltot;
    LAS float* X = (LAS float*)lds + rg * 4096;
    if (mp == 1) {
#pragma unroll
        for (int d0 = 0; d0 < 4; ++d0)
#pragma unroll
            for (int r = 0; r < 16; ++r) { const int dv = 32 * d0 + (r & 3) + 8 * (r >> 2) + 4 * hi; X[dv * 32 + r32] = o[d0][r] * inv; }
    }
    __syncthreads();
    if (mp == 0) {
        float ss = 0.f;
#pragma unroll
        for (int d0 = 0; d0 < 4; ++d0)
#pragma unroll
            for (int r = 0; r < 16; ++r) { const int dv = 32 * d0 + (r & 3) + 8 * (r >> 2) + 4 * hi; const float v = o[d0][r] * inv - lam * X[dv * 32 + r32]; o[d0][r] = v; ss += v * v; }
        ss += __shfl_xor(ss, 32);
        const float rstd = 0.8f / sqrtf(ss * (1.0f / 128.0f) + EPS);
        bf16_t* op = CAT + (tok0 + q0 + r32) * D + 512 + hh * 128;
#pragma unroll
        for (int d0 = 0; d0 < 4; ++d0)
#pragma unroll
            for (int r4 = 0; r4 < 4; ++r4) { const int dv = 32 * d0 + 8 * r4 + 4 * hi; const f32x4 gg = *(const f32x4*)(subln_g + dv);
                u32x2 w; w.x = cvt_pk_bf16(o[d0][4 * r4 + 0] * rstd * gg[0], o[d0][4 * r4 + 1] * rstd * gg[1]); w.y = cvt_pk_bf16(o[d0][4 * r4 + 2] * rstd * gg[2], o[d0][4 * r4 + 3] * rstd * gg[3]);
                *(u32x2*)(op + dv) = w; }
    }
    __syncthreads();
}
}

typedef const __attribute__((address_space(4))) Args* KArgsP;
__device__ __forceinline__ KArgsP kargs() { KArgsP p = (KArgsP)__builtin_amdgcn_kernarg_segment_ptr(); asm volatile("" : "+s"(p)); return p; }
#define PH_PTRS() KArgsP ap = kargs(); unsigned char* ws = ap->ws; (void)ws; int tid = wave * 64 + lane_id(); asm volatile("" : "+v"(tid)); const int lane = tid & 63; (void)lane; \
    float* cs = (float*)(ws + WS_CS); float* ssp = (float*)(ws + WS_SSP); float* rstd2 = (float*)(ws + WS_RSTD2); \
    int* tokslot = (int*)(ws + WS_TOKSLOT); int* ltok = (int*)(ws + WS_LTOK); float* lgate = (float*)(ws + WS_LGATE); \
    bf16_t* Win_t = (bf16_t*)(ws + WS_WIN); bf16_t* Wout_t = (bf16_t*)(ws + WS_WOUT); bf16_t* Wcq_t = (bf16_t*)(ws + WS_WCQ); bf16_t* Wckv_t = (bf16_t*)(ws + WS_WCKV); \
    bf16_t* Wco_t = (bf16_t*)(ws + WS_WCO); bf16_t* Wgu_t = (bf16_t*)(ws + WS_WGU); bf16_t* Wdn_t = (bf16_t*)(ws + WS_WDN); \
    bf16_t* H0 = (bf16_t*)(ws + WS_H0); bf16_t* MEMN = (bf16_t*)(ws + WS_MEMN); bf16_t* KC = (bf16_t*)(ws + WS_KC); bf16_t* VT = (bf16_t*)(ws + WS_VT); \
    bf16_t* U = (bf16_t*)(ws + WS_U); bf16_t* CAT = (bf16_t*)(ws + WS_CAT); bf16_t* X2H = (bf16_t*)(ws + WS_X1); bf16_t* X1B = (bf16_t*)(ws + WS_X1B); \
    bf16_t* QC = (bf16_t*)(ws + WS_QC); bf16_t* PC = (bf16_t*)(ws + WS_PC); bf16_t* OC = (bf16_t*)(ws + WS_OC); bf16_t* X2B = (bf16_t*)(ws + WS_X2B); \
    bf16_t* HID = (bf16_t*)(ws + WS_HID); bf16_t* YR = (bf16_t*)(ws + WS_Y); unsigned char* X1F8 = (unsigned char*)(ws + WS_X2); (void)X1F8; \
    (void)cs; (void)ssp; (void)rstd2; (void)tokslot; (void)ltok; (void)lgate; (void)Win_t; (void)Wout_t; (void)Wcq_t; (void)Wckv_t; (void)Wco_t; (void)Wgu_t; (void)Wdn_t; (void)H0; (void)MEMN; (void)KC; (void)VT; \
    (void)U; (void)CAT; (void)X2H; (void)X1B; (void)QC; (void)PC; (void)OC; (void)X2B; (void)HID; (void)YR

#define CONV_CHUNK(c) do { LAS float* scr_ = (LAS float*)(lds + wave * 16384); \
        if ((c) == 0) p0_transpose_stream<2, true>(ap->w_gu, 1024, 2048, NE, Wgu_t, 1024, 0, (size_t)2048 * 1024, ap->ffn_g, scr_, gw, NGW, lane, 0, 16384); \
        if ((c) == 1) p0_transpose_stream<2, true>(ap->w_gu, 1024, 2048, NE, Wgu_t, 1024, 0, (size_t)2048 * 1024, ap->ffn_g, scr_, gw, NGW, lane, 16384); \
        if ((c) == 2) p0_transpose_stream<0, true>(ap->w_down, 1024, 1024, NE, Wdn_t, 1024, 0, (size_t)1024 * 1024, nullptr, scr_, gw, NGW, lane); \
        __syncthreads(); } while (0)

constexpr int NWAVES = 8;
static_assert(MK_N_LAUNCHES == 1, "only the one-launch build is valid");
constexpr int NDEFER = 12288;
constexpr int N_PHASES = 10;

__global__ void __launch_bounds__(NWAVES * 64, 2) fwd_kernel(Args a) {
    extern __shared__ __attribute__((aligned(16))) unsigned char lds_raw[];
    LAS unsigned char* lds = (LAS unsigned char*)lds_raw;
    const int wave = __builtin_amdgcn_readfirstlane((int)threadIdx.x >> 6);
    const int tid = wave * 64 + lane_id(), lane = tid & 63; (void)lane;
    const int G = gridDim.x, bx = blockIdx.x;
    const int gw = bx * NWAVES + wave, NGW = G * NWAVES;
    unsigned* ctl; { unsigned char* ws0 = a.ws; ctl = (unsigned*)(ws0 + WS_CTL); }
    volatile LAS unsigned* MISC = (volatile LAS unsigned*)(lds + MISC_OFF);
    if (tid < 32) ((LAS unsigned*)(lds + MISC_OFF))[tid] = 0u;
    __syncthreads();
    XcdBarrier bar; bar.bar = ctl + CW_BAR; bar.x = 0; bar.st = nullptr;
    if (MK_N_LAUNCHES == 1) bar = xcd_barrier_post(ctl + CW_BAR, MISC + 8, tid);
    if (tid == 0) __hip_atomic_store(ctl + CW_XCC + bx, 1u + xb_xcc_id(), __ATOMIC_RELAXED, __HIP_MEMORY_SCOPE_AGENT);
    bool same_xcc = false;
    const int lo = a.ph_lo, hi = a.ph_hi;
    unsigned long long tp_lo = 0ull, tp_acc = 0ull; (void)tp_lo; (void)tp_acc;
#define IN(k) (((PMASK >> (k)) & 1) && lo <= (k) && (k) < hi)
#define SEAM(k) do { if (IN(k) && IN((k) + 1)) xcd_barrier(bar, wave * 64 + lane_id()); } while (0)

    if (TP_LO == 0) tp_lo = __builtin_amdgcn_s_memrealtime();
    if (IN(0)) for (int rep_ = 0; rep_ < REPS(0); ++rep_) { PH_PTRS();
        LAS float* scr = (LAS float*)(lds + wave * 16384);
        p0_transpose_stream<0, false>(ap->w_ckv, 1024, 2048, 1, Wckv_t, 1024, 0, 0, nullptr, scr, gw, NGW, lane);
        rms_rows_stream(ap->mem, ap->mem_g, MEMN, NMEM, gw, NGW, lane);
        xcd_barrier(bar, tid);
        { const unsigned mine = (tid < G) ? xb_ld(ctl + CW_XCC + tid) : 1u, rep0 = (tid < G) ? xb_ld(ctl + CW_XCC + (tid & 7)) : 1u;
          if (!(mine == rep0 && mine != 0u)) MISC[20] = 1u;
          __syncthreads();
          same_xcc = (G == 256) && (MISC[20] == 0u); }
        const bool kvblk = (G == 256) && ((bx & 3) == 0);
        if (kvblk || G != 256) { pg8::StaticOrder S; if (G == 256) S.init(MEMN, Wckv_t, NMEM, 2048, D, D, 64, bx >> 2); else S.init(MEMN, Wckv_t, NMEM, 2048, D, D, G, bx);
            pg8::EpiBf16 E{KC, 2048, nullptr, 1.0f};
            pg8::gemm_phase<pg8::EpiBf16, pg8::StaticOrder, true, false, false>(lds, wave, 2 * D, 2 * D, 2 * D, S, E, KREPS(0)); }
        if (!kvblk) {
        const int gw = (G == 256) ? (bx - (bx >> 2) - 1) * NWAVES + wave : bx * NWAVES + wave, NGW = (G == 256) ? 192 * NWAVES : G * NWAVES;
        p0_transpose_stream<1, false>(ap->w_in, 1024, 2048, 1, Win_t, 1024, 0, 0, nullptr, scr, gw, NGW, lane);
        p0_transpose_stream<0, false>(ap->w_out + (size_t)512 * 1024, 512, 1024, 1, Wout_t, 1024, 512, 0, nullptr, scr, gw, NGW, lane);
        p0_transpose_stream<0, false>(ap->w_co, 1024, 1024, 1, Wco_t, 1024, 0, 0, nullptr, scr, gw, NGW, lane);
        constexpr int I_WEFF = 512, I_WR = 512, I_ROPE = T * 8 / 64;
        constexpr int NITEMS = I_WEFF + I_WR + I_ROPE;
        for (int it = gw; it < 1024 * 1024 / 512; it += NGW) {
            const int idx = it * 512 + lane * 8; const f32x4 a0 = *(const f32x4*)(ap->w_cq + idx), a1 = *(const f32x4*)(ap->w_cq + idx + 4); const float gk = ap->xattn_g[idx >> 10];
            u32x4 o; o.x = pk2(a0[0] * gk, a0[1] * gk); o.y = pk2(a0[2] * gk, a0[3] * gk); o.z = pk2(a1[0] * gk, a1[1] * gk); o.w = pk2(a1[2] * gk, a1[3] * gk); *(u32x4*)(Wcq_t + idx) = o; }
        for (int rm_ = 0; rm_ < REPM; ++rm_) {
        rms_rows_stream(ap->x, ap->attn_g, H0, T, gw, NGW, lane);
        for (int it = (gw + 512) % NGW; it < NITEMS; it += NGW) {
            int r = it;
            if (r < I_WEFF) {
                const int cb = r >> 5, nb = r & 31, kk0 = cb * 32, g = kk0 >> 7, n0 = nb * 32, i = lane & 31, h = lane >> 5;
                const f32x4* wp4 = (const f32x4*)(ap->w_pool + (size_t)(kk0 + i) * 128 + 64 * h); const f32x4* sc4 = (const f32x4*)(ap->pool_scale + g * 128 + 64 * h);
                const float* wo = ap->w_out + (size_t)(g * 128 + 64 * h) * 1024 + n0 + i;
                f32x4 av[16]; float bvv[64];
#pragma unroll
                for (int q = 0; q < 16; ++q) av[q] = wp4[q] * sc4[q];
#pragma unroll
                for (int s2 = 0; s2 < 64; ++s2) bvv[s2] = wo[(size_t)s2 * 1024];
                f32x16 accw;
#pragma unroll
                for (int q = 0; q < 16; ++q) accw[q] = 0.f;
#pragma unroll
                for (int s2 = 0; s2 < 64; ++s2) accw = __builtin_amdgcn_mfma_f32_32x32x2f32(av[s2 >> 2][s2 & 3], bvv[s2], accw, 0, 0, 0);
                bf16_t* op = Wout_t + (size_t)(n0 + i) * 1024 + kk0 + 4 * h;
#pragma unroll
                for (int r4 = 0; r4 < 4; ++r4) { u32x2 w; w.x = pk2(accw[4 * r4 + 0], accw[4 * r4 + 1]); w.y = pk2(accw[4 * r4 + 2], accw[4 * r4 + 3]); *(u32x2*)(op + 8 * r4) = w; }
                continue; } r -= I_WEFF;
            if (r < I_WR) {
                const int idx = r * 64 + lane, k = idx >> 5, e = idx & 31; const float w = ap->w_router[idx] * ap->ffn_g[k];
                const unsigned hb = f2bf(w); const float wh = __builtin_bit_cast(float, hb << 16); const unsigned lb = f2bf(w - wh);
                bf16_t* wr = (bf16_t*)(ws + WS_WRH); wr[e * 1024 + k] = (bf16_t)hb; wr[32 * 1024 + e * 1024 + k] = (bf16_t)lb; continue; } r -= I_WR;
            {
                const int idx = r * 64 + lane, t = idx >> 3, i = idx & 7;
                const double inv_freq = exp2(-(double)i * (18.931568569324174 / 8.0));
                const double rev = (double)ap->pos[t] * inv_freq * 0.15915494309189535;
                const float fr = (float)(rev - floor(rev));
                cs[(size_t)idx * 2] = __builtin_amdgcn_cosf(fr); cs[(size_t)idx * 2 + 1] = __builtin_amdgcn_sinf(fr);
            }
        }
        }
        }
    }
    SEAM(0);
    if (TP_HI == 0) tp_acc = __builtin_amdgcn_s_memrealtime() - tp_lo;

    if (TP_LO == 1) tp_lo = __builtin_amdgcn_s_memrealtime();
    if (IN(1)) for (int rep_ = 0; rep_ < REPS(1); ++rep_) { PH_PTRS();
        { pg8::StaticOrder S; S.init(H0, Win_t, T, INW, D, D, G, bx); pg8::EpiInProj E{U, cs};
          pg8::gemm_phase<pg8::EpiInProj, pg8::StaticOrder, true, false, false>(lds, wave, 2 * D, 2 * D, 2 * D, S, E, KREPS(1)); }
    }
    SEAM(1);
    if (TP_HI == 1) tp_acc = __builtin_amdgcn_s_memrealtime() - tp_lo;

    if (TP_LO == 2) tp_lo = __builtin_amdgcn_s_memrealtime();
    if (IN(2)) for (int rep_ = 0; rep_ < REPS(2); ++rep_) { PH_PTRS();
        float d1 = (lane < 64) ? ap->lq1[lane] * ap->lk1[lane] : 0.f, d2 = ap->lq2[lane] * ap->lk2[lane];
        d1 = wave_sum(d1); d2 = wave_sum(d2);
        const float lam = expf(d1) - expf(d2) + 0.2f;
        for (int ra_ = 0; ra_ < REPA; ++ra_)
        for (int un = bx; un < 256; un += G) {
            const int bh = un >> 3, jp = un & 7;
            dattn::unit(lds, wave, U, CAT, ap->subln_g, lam, bh >> 2, bh & 3, jp);
            dattn::unit(lds, wave, U, CAT, ap->subln_g, lam, bh >> 2, bh & 3, 15 - jp);
        }
        for (int rb_ = 0; rb_ < REPB; ++rb_)
        for (int it = gw; it < T / 16; it += NGW) {
            const int b = it >> 7, t0 = (it & 127) * 16, g = lane >> 4, wnd = 2 << g;
            const bf16_t* up = U + ((size_t)b * SEQ + t0) * INW + lane * 8;
            u32x4 rows[32];
#pragma unroll
            for (int i = 0; i < 32; ++i) { if (i >= 16 || t0 > 0) rows[i] = *(const u32x4*)(up + (ptrdiff_t)(i - 16) * INW); else rows[i] = (u32x4){0u, 0u, 0u, 0u}; }
#define PL_ADD(a, r, sgn) do { a[0] += sgn __builtin_bit_cast(float, (r).x << 16); a[1] += sgn __builtin_bit_cast(float, (r).x & 0xffff0000u); a[2] += sgn __builtin_bit_cast(float, (r).y << 16); a[3] += sgn __builtin_bit_cast(float, (r).y & 0xffff0000u); \
            a[4] += sgn __builtin_bit_cast(float, (r).z << 16); a[5] += sgn __builtin_bit_cast(float, (r).z & 0xffff0000u); a[6] += sgn __builtin_bit_cast(float, (r).w << 16); a[7] += sgn __builtin_bit_cast(float, (r).w & 0xffff0000u); } while (0)
            float sacc[8];
#pragma unroll
            for (int q = 0; q < 8; ++q) sacc[q] = 0.f;
#pragma unroll
            for (int jj = 1; jj < 16; ++jj) { const u32x4 r = rows[16 - jj] & ((jj < wnd) ? 0xffffffffu : 0u); PL_ADD(sacc, r, +); }
            const unsigned mk0 = (g == 0) ? 0xffffffffu : 0u, mk1 = (g == 1) ? 0xffffffffu : 0u, mk2 = (g == 2) ? 0xffffffffu : 0u, mk3 = (g == 3) ? 0xffffffffu : 0u;
            bf16_t* op = CAT + ((size_t)b * SEQ + t0) * D + lane * 8;
#pragma unroll
            for (int tt = 0; tt < 16; ++tt) {
                PL_ADD(sacc, rows[16 + tt], +);
                float cur[8];
#pragma unroll
                for (int q = 0; q < 8; ++q) cur[q] = 0.f;
                PL_ADD(cur, rows[16 + tt], +);
                const int t = t0 + tt; const float ic = 1.0f / (float)((t + 1 < wnd) ? t + 1 : wnd);
                u32x4 o4; o4.x = pk2(sacc[0] * ic - cur[0], sacc[1] * ic - cur[1]); o4.y = pk2(sacc[2] * ic - cur[2], sacc[3] * ic - cur[3]);
                o4.z = pk2(sacc[4] * ic - cur[4], sacc[5] * ic - cur[5]); o4.w = pk2(sacc[6] * ic - cur[6], sacc[7] * ic - cur[7]);
                *(u32x4*)(op + (size_t)tt * D) = o4;
                const u32x4 lv = (rows[16 + tt - 1] & mk0) | (rows[16 + tt - 3] & mk1) | (rows[16 + tt - 7] & mk2) | (rows[16 + tt - 15] & mk3);
                PL_ADD(sacc, lv, -);
            }
#undef PL_ADD
        }
    }
    SEAM(2);
    if (TP_HI == 2) tp_acc = __builtin_amdgcn_s_memrealtime() - tp_lo;

    if (TP_LO == 3) tp_lo = __builtin_amdgcn_s_memrealtime();
    if (IN(3)) for (int rep_ = 0; rep_ < REPS(3); ++rep_) { PH_PTRS();
        if ((bx & 1) == 0) CONV_CHUNK(0);
        pg8::StaticOrder S; S.init(CAT, Wout_t, T, D, D, D, G, bx); pg8::EpiRes<true, true> E{ap->x, X1B, X1F8, ssp, 1.0f};
        pg8::gemm_phase<pg8::EpiRes<true, true>, pg8::StaticOrder, true, false, false>(lds, wave, 2 * D, 2 * D, 2 * D, S, E, KREPS(3));
        for (int pu = bx; pu < 256; pu += G) {
        if (pu < 128) { const int bh = pu >> 2, pn = pu & 3, b = bh >> 2, h = bh & 3;
            pg8::SingleUnit S2; S2.u = pg8::Unit{bh, pn, 0, 0, 256, 0, (const char*)(KC + (size_t)b * 256 * 2048 + h * 256), (const char*)(Wcq_t + (size_t)pn * 256 * D + h * 256)};
            pg8::EpiTile<true> E2{QC, D, nullptr, 4.0f};
            pg8::gemm_phase<pg8::EpiTile<true>, pg8::SingleUnit, false, false, false>(lds, wave, 2 * 256, 2 * 2048, 2 * D, S2, E2, KREPS(3));
        } else { const int l = pu - 128, bh = l >> 2, pm4 = l & 3, b = bh >> 2, h = bh & 3;
            pg8::SingleUnit S2; S2.u = pg8::Unit{b * 4 + pm4, h, 0, 0, 256, 0, (const char*)(Wco_t + (size_t)pm4 * 256 * D + h * 256), (const char*)(KC + (size_t)b * 256 * 2048 + 1024 + h * 256)};
            pg8::EpiTile<true> E2{OC, D, nullptr, 4.0f};
            pg8::gemm_phase<pg8::EpiTile<true>, pg8::SingleUnit, false, false, false>(lds, wave, 2 * 256, 2 * D, 2 * 2048, S2, E2, KREPS(3));
        }
        }
        if ((bx & 1) != 0) CONV_CHUNK(0);
    }
    SEAM(3);
    if (TP_HI == 3) tp_acc = __builtin_amdgcn_s_memrealtime() - tp_lo;

    if (TP_LO == 4) tp_lo = __builtin_amdgcn_s_memrealtime();
    if (IN(4)) for (int rep_ = 0; rep_ < REPS(4); ++rep_) { PH_PTRS();
        LAS float* rs = (LAS float*)(lds + XTAB_OFF);
        if ((bx & 1) != 0) CONV_CHUNK(1);
        for (int un = bx; un < 256; un += G) {
            const int pm = un >> 2, h = un & 3, b = pm >> 3;
            if (tid < 256) { const int row = pm * 256 + tid; float s = 0.f;
#pragma unroll
                for (int p = 0; p < 16; ++p) s += ssp[(size_t)p * T + row];
                rs[tid] = 1.0f / sqrtf(s * (1.0f / D) + EPS); }
            __syncthreads();
            { LAS int* ent = (LAS int*)(lds + XE_OFF); LAS int* tk = (LAS int*)(lds + TOKT_OFF);
              if (tid == 0) { ent[0] = pm; ent[1] = h; ent[4] = -1; } if (tid < 256) tk[tid] = pm * 256 + tid;
              __syncthreads();
              pg8::LdsOrder S; S.ent = ent; S.tokt = tk; S.Abase = (const char*)X1F8; S.Bbase = (const char*)QC; S.btile = (size_t)256 * D; S.bbatch = (size_t)4 * 256 * D; S.rowbytes = D;
              pg8::EpiSoftmax E{PC, D, rs, QSCALE_X * 0.25f};
              pg8::gemm_phase<pg8::EpiSoftmax, pg8::LdsOrder, false, true, true>(lds, wave, D, D, D, S, E, KREPS(4)); }
            __syncthreads();
        }
        if ((bx & 1) == 0) CONV_CHUNK(1);
    }
    SEAM(4);
    if (TP_HI == 4) tp_acc = __builtin_amdgcn_s_memrealtime() - tp_lo;

    if (TP_LO == 5) tp_lo = __builtin_amdgcn_s_memrealtime();
    if (IN(5)) for (int rep_ = 0; rep_ < REPS(5); ++rep_) { PH_PTRS();
        if ((bx & 1) == 0) CONV_CHUNK(2);
        pg8::StaticOrder S0; S0.init(PC, OC, T, D, D, D, G, bx); pg8::EpiRes<false, true> E{X1B, X2H, (unsigned char*)X2B, nullptr, 1.0f / 1024.0f};
        LAS int* ent = (LAS int*)(lds + XE_OFF); LAS int* tk = (LAS int*)(lds + TOKT_OFF);
        { pg8::Unit u0; int n = 0; for (; n < 4 && S0.next(n, u0); ++n) { if (tid == 0) { ent[4 * n] = u0.pm; ent[4 * n + 1] = u0.pn; } if (tid < 256) tk[n * 256 + tid] = u0.pm * 256 + tid; } if (tid == 0) ent[4 * n] = -1; }
        __syncthreads();
        pg8::LdsOrder S; S.ent = ent; S.tokt = tk; S.Abase = (const char*)PC; S.Bbase = (const char*)OC; S.btile = (size_t)256 * D; S.bbatch = (size_t)1024 * 1024; S.rowbytes = D;
        pg8::gemm_phase<pg8::EpiRes<false, true>, pg8::LdsOrder, true, true, true>(lds, wave, D, D, D, S, E, KREPS(5));
        if ((bx & 1) != 0) CONV_CHUNK(2);
    }
    SEAM(5);
    if (TP_HI == 5) tp_acc = __builtin_amdgcn_s_memrealtime() - tp_lo;

    if (TP_LO == 6) tp_lo = __builtin_amdgcn_s_memrealtime();
    if (IN(6)) for (int rep_ = 0; rep_ < REPS(6); ++rep_) { PH_PTRS();
        LAS int* lcnt = (LAS int*)(lds + RT_OFF);
        LAS int* sel = (LAS int*)(lds + RT_OFF + 512);
        LAS float* selg = (LAS float*)(lds + RT_OFF + 512 + 1024);
        const int wave_ = __builtin_amdgcn_readfirstlane(tid >> 6);
        const bf16_t* WRH = (const bf16_t*)(ws + WS_WRH);
        for (int tb = bx; tb < T / 64; tb += G) {
            if (tid < 32) lcnt[tid] = 0;
            const int tile = wave_ >> 2, kq = wave_ & 3, r32 = lane & 31, h = lane >> 5;
            const bf16_t* xp = X2H + (size_t)(tb * 64 + tile * 32 + r32) * D + kq * 256 + 8 * h;
            const bf16_t* wp = WRH + (size_t)r32 * 1024 + kq * 256 + 8 * h;
            f32x16 accr;
#pragma unroll
            for (int r = 0; r < 16; ++r) accr[r] = 0.f;
            float ss = 0.f;
            bf16x8 xa[16];
#pragma unroll
            for (int s = 0; s < 16; ++s) xa[s] = *(const bf16x8*)(xp + 16 * s);
#pragma unroll
            for (int s = 0; s < 16; ++s) { const bf16x8 bh_ = *(const bf16x8*)(wp + 16 * s), bl_ = *(const bf16x8*)(wp + 32 * 1024 + 16 * s);
                accr = __builtin_amdgcn_mfma_f32_32x32x16_bf16(xa[s], bh_, accr, 0, 0, 0);
                accr = __builtin_amdgcn_mfma_f32_32x32x16_bf16(xa[s], bl_, accr, 0, 0, 0);
#pragma unroll
                for (int j = 0; j < 8; ++j) { const float f = bf2f((unsigned short)xa[s][j]); ss += f * f; } }
            ss += __shfl_xor(ss, 32);
            __syncthreads();
            LAS float* PT = (LAS float*)lds + wave_ * (32 * 33);
            LAS float* PSS = (LAS float*)lds + 8 * 32 * 33;
#pragma unroll
            for (int r = 0; r < 16; ++r) PT[((r & 3) + 8 * (r >> 2) + 4 * h) * 33 + r32] = accr[r];
            if (h == 0) PSS[wave_ * 32 + r32] = ss;
            __syncthreads();
            if (tid < 64) {
                const int tl = tid & 31, tok = tb * 64 + tid; const LAS float* p0 = (LAS float*)lds + ((tid >> 5) * 4) * (32 * 33) + tl * 33; const LAS float* q0 = PSS + (tid >> 5) * 128 + tl;
                const float sq = (q0[0] + q0[32]) + (q0[64] + q0[96]);
                const float rstd = 1.0f / sqrtf(sq * (1.0f / D) + EPS);
                rstd2[tok] = rstd;
                float b0 = -INFINITY, b1 = -INFINITY, b2 = -INFINITY, b3 = -INFINITY; int i0 = 0, i1 = 0, i2 = 0, i3 = 0;
                for (int e = 0; e < 32; ++e) {
                    const float lg = ((p0[e] + p0[32 * 33 + e]) + (p0[2 * 32 * 33 + e] + p0[3 * 32 * 33 + e])) * rstd + ap->b_router[e];
                    if (lg > b3) { b3 = lg; i3 = e;
                        if (b3 > b2) { const float tf = b2; b2 = b3; b3 = tf; const int ti = i2; i2 = i3; i3 = ti; }
                        if (b2 > b1) { const float tf = b1; b1 = b2; b2 = tf; const int ti = i1; i1 = i2; i2 = ti; }
                        if (b1 > b0) { const float tf = b0; b0 = b1; b1 = tf; const int ti = i0; i0 = i1; i1 = ti; } }
                }
                const float e1 = expf(b1 - b0), e2 = expf(b2 - b0), e3 = expf(b3 - b0), isum = 1.0f / (1.0f + e1 + e2 + e3);
                int lr;
                lr = atomicAdd((int*)&lcnt[i0], 1); sel[tid * 4 + 0] = (i0 << 16) | lr; selg[tid * 4 + 0] = isum;
                lr = atomicAdd((int*)&lcnt[i1], 1); sel[tid * 4 + 1] = (i1 << 16) | lr; selg[tid * 4 + 1] = e1 * isum;
                lr = atomicAdd((int*)&lcnt[i2], 1); sel[tid * 4 + 2] = (i2 << 16) | lr; selg[tid * 4 + 2] = e2 * isum;
                lr = atomicAdd((int*)&lcnt[i3], 1); sel[tid * 4 + 3] = (i3 << 16) | lr; selg[tid * 4 + 3] = e3 * isum;
            }
            __syncthreads();
            if (tid < 32) { const int c = lcnt[tid]; lcnt[32 + tid] = (c > 0) ? (int)atomicAdd(ctl + CW_CNT + tid, (unsigned)c) : 0; }
            __syncthreads();
            if (tid < 256) { const int tl = tid >> 2, tok = tb * 64 + tl, sv = sel[tid], ee = sv >> 16, pos = lcnt[32 + ee] + (sv & 0xffff);
                ltok[ee * CAP + pos] = tok; lgate[ee * CAP + pos] = selg[tid]; tokslot[tok * 4 + (tid & 3)] = (ee << 16) | pos; }
            __syncthreads();
        }
    }
    SEAM(6);
    if (TP_HI == 6) tp_acc = __builtin_amdgcn_s_memrealtime() - tp_lo;

    LAS int* ecnt = (LAS int*)(lds + ECNT_OFF);
    LAS int* etp = (LAS int*)(lds + ECNT_OFF + 128);
    LAS int* xe = (LAS int*)(lds + XE_OFF);
    LAS int* tokt = (LAS int*)(lds + TOKT_OFF);
    if (IN(7) || IN(8) || IN(9)) {
        __syncthreads();
        const int t_ = wave * 64 + lane_id();
        if (t_ < NE) ecnt[t_] = (int)__hip_atomic_load(ctl + CW_CNT + t_, __ATOMIC_RELAXED, __HIP_MEMORY_SCOPE_AGENT);
        __syncthreads();
        if (t_ < NE) { int acc = 0, mine = 0;
#pragma unroll
            for (int o = 0; o < NE; ++o) { const int n = (ecnt[o] + 255) >> 8; acc += (o < t_) ? n : 0; mine = (o == t_) ? n : mine; }
            etp[t_] = acc; if (t_ == NE - 1) etp[NE] = acc + mine; }
        __syncthreads();
        if (t_ < NE) { const int e = t_, n = etp[e + 1] - etp[e]; int rank = 0;
            for (int o = 0; o < NE; ++o) { const int no = etp[o + 1] - etp[o]; rank += (no > n || (no == n && o < e)) ? 1 : 0; }
            const int rnd = rank >> 3, p = rank & 7, x = (rnd & 1) ? 7 - p : p; xe[x * 4 + rnd] = e; }
        __syncthreads();
    }

    if (TP_LO == 7) tp_lo = __builtin_amdgcn_s_memrealtime();
    if (IN(7)) for (int rep_ = 0; rep_ < REPS(7); ++rep_) { PH_PTRS();
        pg8::MoeOrder S; S.ecnt = ecnt; S.etp = etp; S.xe = xe; S.tokt = tokt; S.x = bx & 7; S.cl = bx >> 3; S.nloc = G >> 3; S.npn = 8;
        S.Abase = (const char*)X2B; S.Bbase = (const char*)Wgu_t; S.b_expert = (size_t)2048 * 1024; S.rowbytes = D; S.b_rowbytes = D; S.gather = true;
        int last_pm = -1, prev_pm = -1;
        { pg8::Unit u;
          for (int i = 0; i < MAXU && S.next(i, u); ++i) { prev_pm = last_pm; last_pm = u.pm; if (tid < 256) tokt[i * 256 + tid] = (tid < u.nvalid) ? ltok[u.e * CAP + u.r * 256 + tid] : 0; } }
        __syncthreads();
        pg8::EpiSwiGLU E{(unsigned char*)HID, ap->b_gu, rstd2, tokt, &S, ctl + CW_FLAG};
        pg8::gemm_phase<pg8::EpiSwiGLU, pg8::MoeOrder, true, true, true>(lds, wave, D, D, D, S, E, KREPS(7));
        if (tid == 0) { if (prev_pm >= 0) (void)xb_add(ctl + CW_FLAG + (size_t)prev_pm * FLAG_STRIDE, 1u); if (last_pm >= 0) (void)xb_add(ctl + CW_FLAG + (size_t)last_pm * FLAG_STRIDE, 1u); }
    }
    if (!same_xcc) SEAM(7);
    if (TP_HI == 7) tp_acc = __builtin_amdgcn_s_memrealtime() - tp_lo;

    if (TP_LO == 8) tp_lo = __builtin_amdgcn_s_memrealtime();
    if (IN(8)) for (int rep_ = 0; rep_ < REPS(8); ++rep_) { PH_PTRS();
        pg8::MoeOrder S; S.ecnt = ecnt; S.etp = etp; S.xe = xe; S.tokt = tokt; S.x = bx & 7; S.cl = bx >> 3; S.nloc = G >> 3; S.npn = 4;
        S.Abase = (const char*)HID; S.Bbase = (const char*)Wdn_t; S.b_expert = (size_t)1024 * 1024; S.rowbytes = D; S.b_rowbytes = D; S.gather = true;
        { int n7 = 0;
          for (int k = 0; k < 4; ++k) { const int e = xe[S.x * 4 + k]; n7 += (etp[e + 1] - etp[e]) * 8; }
          S.cl = __builtin_amdgcn_readfirstlane((S.cl + S.nloc - n7 % S.nloc) % S.nloc); }
        { pg8::Unit u;
          for (int i = 0; i < MAXU && S.next(i, u); ++i) if (tid < 256) tokt[i * 256 + tid] = u.pm * 256 + tid; }
        __syncthreads();
        { pg8::Unit u; for (int i = 0; i < 2 && S.next(i, u); ++i) hid_wait(ctl + CW_FLAG, u.pm); }
        pg8::EpiDown E{(unsigned char*)YR, ap->b_down, lgate, &S, ctl + CW_FLAG};
        pg8::gemm_phase<pg8::EpiDown, pg8::MoeOrder, true, true, true>(lds, wave, D, D, D, S, E, KREPS(8));
    }
    SEAM(8);
    if (TP_HI == 8) tp_acc = __builtin_amdgcn_s_memrealtime() - tp_lo;

    if (TP_LO == 9) tp_lo = __builtin_amdgcn_s_memrealtime();
    if (IN(9)) for (int rep_ = 0; rep_ < REPS(9); ++rep_) { PH_PTRS();
        for (int tok = gw; tok < T; tok += NGW) {
            int rowk[4];
#pragma unroll
            for (int k = 0; k < 4; ++k) { const int sv = tokslot[tok * 4 + k], ee = sv >> 16; rowk[k] = etp[ee] * 256 + (sv & 0xffff); }
            float v[2][8]; float s = 0.f;
            u32x4 xa[2]; u32x2 yv[2][4];
#pragma unroll
            for (int c = 0; c < 2; ++c) { xa[c] = *((const u32x4*)(X2H + (size_t)tok * D + 512 * c) + lane);
#pragma unroll
                for (int k = 0; k < 4; ++k) yv[c][k] = __builtin_nontemporal_load((const u32x2*)((const unsigned char*)YR + (size_t)rowk[k] * 1024 + 512 * c) + lane); }
#pragma unroll
            for (int c = 0; c < 2; ++c) {
                v[c][0] = __builtin_bit_cast(float, xa[c].x << 16); v[c][1] = __builtin_bit_cast(float, xa[c].x & 0xffff0000u); v[c][2] = __builtin_bit_cast(float, xa[c].y << 16); v[c][3] = __builtin_bit_cast(float, xa[c].y & 0xffff0000u);
                v[c][4] = __builtin_bit_cast(float, xa[c].z << 16); v[c][5] = __builtin_bit_cast(float, xa[c].z & 0xffff0000u); v[c][6] = __builtin_bit_cast(float, xa[c].w << 16); v[c][7] = __builtin_bit_cast(float, xa[c].w & 0xffff0000u);
                float ys[8];
#pragma unroll
                for (int q = 0; q < 8; ++q) ys[q] = 0.f;
#pragma unroll
                for (int k = 0; k < 4; ++k)
#pragma unroll
                    for (int q = 0; q < 2; ++q) { const int w_ = (int)yv[c][k][q]; const f32x2 lo = __builtin_amdgcn_cvt_pk_f32_fp8(w_, false), hi2 = __builtin_amdgcn_cvt_pk_f32_fp8(w_, true);
                        ys[4 * q + 0] += lo[0]; ys[4 * q + 1] += lo[1]; ys[4 * q + 2] += hi2[0]; ys[4 * q + 3] += hi2[1]; }
#pragma unroll
                for (int q = 0; q < 8; ++q) { v[c][q] += ys[q] * 0.0625f; s += v[c][q] * v[c][q]; }
            }
            const float rstd = 1.0f / sqrtf(wave_sum(s) * (1.0f / D) + EPS);
#pragma unroll
            for (int c = 0; c < 2; ++c) { f32x4* op = (f32x4*)(ap->out + (size_t)tok * D + 512 * c) + 2 * lane; const f32x4* gr = (const f32x4*)(ap->final_g + 512 * c) + 2 * lane;
#pragma unroll
                for (int q = 0; q < 2; ++q) { const f32x4 gg = gr[q]; __builtin_nontemporal_store((f32x4){v[c][4 * q] * rstd * gg[0], v[c][4 * q + 1] * rstd * gg[1], v[c][4 * q + 2] * rstd * gg[2], v[c][4 * q + 3] * rstd * gg[3]}, op + q); } }
        }
    }
    if (TP_HI == 9) tp_acc = __builtin_amdgcn_s_memrealtime() - tp_lo;
    if (TP_HI >= 0 && bx == 0 && wave == 0) { const unsigned long long t0_ = __builtin_amdgcn_s_memrealtime(); while (__builtin_amdgcn_s_memrealtime() - t0_ < tp_acc) __builtin_amdgcn_s_sleep(8); }
#undef IN
#undef SEAM
}

extern "C" void kernel_launch(void* const* d_in, const int* in_sizes, int n_in, void* d_out, int out_size, void* d_ws, size_t ws_size, hipStream_t stream) {
    static int grid = 0;
    if (grid == 0) {
        if (n_in != 26 || in_sizes[0] != T * D || out_size != T * D || ws_size < WS_END) { fprintf(stderr, "kernel_launch: unexpected shapes (n_in %d, in0 %d, out %d, ws %zu); nothing launched\n", n_in, n_in > 0 ? in_sizes[0] : -1, out_size, ws_size); grid = -1; return; }
        int dev = 0, cus = 0, per_cu = 0;
        if (hipGetDevice(&dev) != hipSuccess || hipDeviceGetAttribute(&cus, hipDeviceAttributeMultiprocessorCount, dev) != hipSuccess) { grid = -1; return; }
        if (hipFuncSetAttribute((const void*)fwd_kernel, hipFuncAttributeMaxDynamicSharedMemorySize, LDS_BYTES) != hipSuccess) { fprintf(stderr, "kernel_launch: hipFuncSetAttribute failed\n"); grid = -1; return; }
        if (hipOccupancyMaxActiveBlocksPerMultiprocessor(&per_cu, (const void*)fwd_kernel, NWAVES * 64, LDS_BYTES) != hipSuccess || per_cu < 1) { fprintf(stderr, "kernel_launch: occupancy query says %d\n", per_cu); per_cu = 1; }
        (void)hipGetLastError();
        grid = cus;
    }
    if (grid < 0) return;
    (void)hipMemsetAsync((char*)d_ws + WS_CTL, 0, CTL_BYTES, stream);
    Args a{};
    a.x = (const float*)d_in[0]; a.pos = (const int*)d_in[1]; a.mem = (const float*)d_in[2]; a.attn_g = (const float*)d_in[3]; a.w_in = (const float*)d_in[4];
    a.w_pool = (const float*)d_in[5]; a.pool_scale = (const float*)d_in[6]; a.lq1 = (const float*)d_in[7]; a.lk1 = (const float*)d_in[8]; a.lq2 = (const float*)d_in[9];
    a.lk2 = (const float*)d_in[10]; a.subln_g = (const float*)d_in[11]; a.w_out = (const float*)d_in[12]; a.xattn_g = (const float*)d_in[13]; a.mem_g = (const float*)d_in[14];
    a.w_cq = (const float*)d_in[15]; a.w_ckv = (const float*)d_in[16]; a.w_co = (const float*)d_in[17]; a.ffn_g = (const float*)d_in[18]; a.w_router = (const float*)d_in[19];
    a.b_router = (const float*)d_in[20]; a.w_gu = (const float*)d_in[21]; a.b_gu = (const float*)d_in[22]; a.w_down = (const float*)d_in[23]; a.b_down = (const float*)d_in[24];
    a.final_g = (const float*)d_in[25]; a.out = (float*)d_out; a.ws = (unsigned char*)d_ws;
    if (MK_N_LAUNCHES == 1) {
        a.ph_lo = 0; a.ph_hi = N_PHASES;
        void* args[] = {&a};
        hipError_t e = hipLaunchCooperativeKernel((const void*)fwd_kernel, dim3(grid), dim3(NWAVES * 64), args, LDS_BYTES, stream);
        if (e != hipSuccess) fprintf(stderr, "kernel_launch: cooperative launch failed: %s (grid %d)\n", hipGetErrorString(e), grid);
    } else {
        for (int p = 0; p < N_PHASES; ++p) { a.ph_lo = p; a.ph_hi = p + 1; hipLaunchKernelGGL(fwd_kernel, dim3(grid), dim3(NWAVES * 64), LDS_BYTES, stream, a); }
    }
}
```
